# Optimizing an MI355X kernel written in HIP

```python
import jax, jax.numpy as jnp
from jax import lax
import numpy as np

D_MODEL = 1024
BATCH = 16
SEQ = 2048
DEPTH = 2

MIX_WIDTH = D_MODEL
GM_HEADS = 4
GM_WIDTH = MIX_WIDTH // 2
GM_HEAD_DIM = GM_WIDTH // GM_HEADS
GM_CHUNK = 128
GLA_HEADS = 4
GLA_WIDTH = MIX_WIDTH - GM_WIDTH
GLA_DV = GLA_WIDTH // GLA_HEADS
GLA_KEY_WIDTH = GLA_WIDTH // 2
GLA_DK = GLA_KEY_WIDTH // GLA_HEADS
GLA_GATE_RANK = 16
GLA_TAU = 16.0
GLA_CHUNK = 64
IN_COLS = 2 * GM_WIDTH + 2 * GLA_KEY_WIDTH + 2 * GLA_WIDTH + GLA_GATE_RANK
D_FF = 2816
N_EXPERTS = 8
TOP_K = 2
D_FF_EXPERT = 3584
N_DENSE = (DEPTH + 1) // 2
N_MOE = DEPTH // 2
LN_EPS = 1e-5
RMS_EPS = 1e-6
DEEPNORM_ALPHA = (2 * DEPTH) ** 0.25
DEEPNORM_BETA = (8 * DEPTH) ** -0.25

kernel_name = 'hybrid_gmlp_gla_deepnorm_moe'


def layer_norm(x, g, b):
    xf = x.astype(jnp.float32)
    mu = jnp.mean(xf, axis=-1, keepdims=True)
    var = jnp.mean(jnp.square(xf - mu), axis=-1, keepdims=True)
    y = (xf - mu) * lax.rsqrt(var + LN_EPS) * g.astype(jnp.float32) + b.astype(jnp.float32)
    return y.astype(x.dtype)


def chunked_spatial_gating(u, v, w_s, b_s, ln_g, ln_b):
    B, S, _ = u.shape
    n = S // GM_CHUNK
    v = layer_norm(v.reshape(B, S, GM_HEADS, GM_HEAD_DIM),
                   ln_g.reshape(GM_HEADS, GM_HEAD_DIM), ln_b.reshape(GM_HEADS, GM_HEAD_DIM))
    v = v.reshape(B, n, GM_CHUNK, GM_HEADS, GM_HEAD_DIM)
    causal = jnp.tril(jnp.ones((GM_CHUNK, GM_CHUNK), dtype=bool))
    w = jnp.where(causal[None], w_s, 0)
    s = jnp.einsum('hts,bnshc->bnthc', w, v) + b_s.T[None, None, :, :, None]
    return u * s.reshape(B, S, GM_WIDTH)


def gla_chunked(q, k, v, log_a):
    B, S, H, dk = q.shape
    dv = v.shape[-1]
    n = S // GLA_CHUNK

    def to_chunks(t):
        return t.astype(jnp.float32).reshape(B, n, GLA_CHUNK, H, t.shape[-1]).transpose(1, 0, 3, 2, 4)

    q, k, v, log_a = to_chunks(q), to_chunks(k), to_chunks(v), to_chunks(log_a)
    q = q * (dk ** -0.5)
    b = jnp.cumsum(log_a, axis=3)
    b_last = b[:, :, :, -1:, :]
    q_dec = q * jnp.exp(b)
    k_inv = k * jnp.exp(-b)
    k_dec = k * jnp.exp(b_last - b)
    causal = jnp.tril(jnp.ones((GLA_CHUNK, GLA_CHUNK), dtype=bool))
    scores = jnp.where(causal, jnp.einsum('nbhid,nbhjd->nbhij', q_dec, k_inv), 0.0)
    o_intra = jnp.einsum('nbhij,nbhje->nbhie', scores, v)

    def step(state, inp):
        q_c, k_c, v_c, decay_c = inp
        o = jnp.einsum('bhid,bhde->bhie', q_c, state)
        state = state * decay_c[..., 0, :, None] + jnp.einsum('bhjd,bhje->bhde', k_c, v_c)
        return state, o

    state0 = jnp.zeros((B, H, dk, dv), jnp.float32)
    _, o_inter = lax.scan(step, state0, (q_dec, k_dec, v, jnp.exp(b_last)))
    o = o_intra + o_inter
    return o.transpose(1, 0, 3, 2, 4).reshape(B, S, H, dv)


def hybrid_mixer(x, w_in, gm_ws, gm_bs, gm_ln_g, gm_ln_b, gla_wa2, gla_ba, gla_norm_g, w_out):
    B, S, _ = x.shape
    proj = x @ w_in
    o1 = GM_WIDTH
    o2 = o1 + GM_WIDTH
    o3 = o2 + GLA_KEY_WIDTH
    o4 = o3 + GLA_KEY_WIDTH
    o5 = o4 + GLA_WIDTH
    o6 = o5 + GLA_WIDTH
    gm_u, gm_v, q, k, v, g, a_lr = jnp.split(proj, [o1, o2, o3, o4, o5, o6], axis=-1)
    gm_u = jax.nn.gelu(gm_u, approximate=False)
    gm_v = jax.nn.gelu(gm_v, approximate=False)
    out_a = chunked_spatial_gating(gm_u, gm_v, gm_ws, gm_bs, gm_ln_g, gm_ln_b)
    log_a = jax.nn.log_sigmoid((a_lr @ gla_wa2 + gla_ba).astype(jnp.float32)) / GLA_TAU
    o = gla_chunked(q.reshape(B, S, GLA_HEADS, GLA_DK), k.reshape(B, S, GLA_HEADS, GLA_DK),
                    v.reshape(B, S, GLA_HEADS, GLA_DV), log_a.reshape(B, S, GLA_HEADS, GLA_DK))
    o = o * lax.rsqrt(jnp.mean(jnp.square(o), axis=-1, keepdims=True) + RMS_EPS)
    o = o * gla_norm_g.reshape(GLA_HEADS, GLA_DV).astype(jnp.float32)
    out_b = o.reshape(B, S, GLA_WIDTH).astype(x.dtype) * jax.nn.silu(g)
    return jnp.concatenate([out_a, out_b], axis=-1) @ w_out


def swiglu(x, w_gate, w_up, w_down):
    return (jax.nn.silu(x @ w_gate) * (x @ w_up)) @ w_down


def moe_swiglu(x, w_router, e_gate, e_up, e_down):
    B, S, D = x.shape
    t = x.reshape(B * S, D)
    logits = (t @ w_router).astype(jnp.float32)
    top_val, top_idx = lax.top_k(logits, TOP_K)
    top_w = jax.nn.softmax(top_val, axis=-1)
    gates = jnp.sum(jax.nn.one_hot(top_idx, N_EXPERTS, dtype=jnp.float32) * top_w[..., None], axis=1)
    gates = gates.astype(t.dtype)
    out = jnp.zeros_like(t)
    for e in range(N_EXPERTS):
        out = out + gates[:, e:e + 1] * swiglu(t, e_gate[e], e_up[e], e_down[e])
    return out.reshape(B, S, D)


def setup_inputs(seed: int = 0) -> dict:
    key = jax.random.key(seed)
    ks = jax.random.split(key, 22)
    nrm = jax.random.normal
    f32 = jnp.float32
    D = D_MODEL
    return {
        'x': nrm(ks[0], (BATCH, SEQ, D), f32),
        'w_in': nrm(ks[1], (DEPTH, D, IN_COLS), f32) * D ** -0.5,
        'gm_ws': nrm(ks[2], (DEPTH, GM_HEADS, GM_CHUNK, GM_CHUNK), f32) * GM_CHUNK ** -0.5,
        'gm_bs': 1.0 + 0.1 * nrm(ks[3], (DEPTH, GM_HEADS, GM_CHUNK), f32),
        'gm_ln_g': 1.0 + 0.1 * nrm(ks[4], (DEPTH, GM_WIDTH), f32),
        'gm_ln_b': 0.02 * nrm(ks[5], (DEPTH, GM_WIDTH), f32),
        'gla_wa2': nrm(ks[6], (DEPTH, GLA_GATE_RANK, GLA_KEY_WIDTH), f32) * GLA_GATE_RANK ** -0.5,
        'gla_ba': 0.1 * nrm(ks[7], (DEPTH, GLA_KEY_WIDTH), f32),
        'gla_norm_g': 1.0 + 0.1 * nrm(ks[8], (DEPTH, GLA_WIDTH), f32),
        'w_out': nrm(ks[9], (DEPTH, MIX_WIDTH, D), f32) * MIX_WIDTH ** -0.5 * DEEPNORM_BETA,
        'ln_mix_g': 1.0 + 0.1 * nrm(ks[10], (DEPTH, D), f32),
        'ln_mix_b': 0.02 * nrm(ks[11], (DEPTH, D), f32),
        'ffn_w_gate': nrm(ks[12], (N_DENSE, D, D_FF), f32) * D ** -0.5,
        'ffn_w_up': nrm(ks[13], (N_DENSE, D, D_FF), f32) * D ** -0.5,
        'ffn_w_down': nrm(ks[14], (N_DENSE, D_FF, D), f32) * D_FF ** -0.5 * DEEPNORM_BETA,
        'router_w': nrm(ks[15], (N_MOE, D, N_EXPERTS), f32) * D ** -0.5,
        'exp_w_gate': nrm(ks[16], (N_MOE, N_EXPERTS, D, D_FF_EXPERT), f32) * D ** -0.5,
        'exp_w_up': nrm(ks[17], (N_MOE, N_EXPERTS, D, D_FF_EXPERT), f32) * D ** -0.5,
        'exp_w_down': nrm(ks[18], (N_MOE, N_EXPERTS, D_FF_EXPERT, D), f32) * D_FF_EXPERT ** -0.5 * DEEPNORM_BETA,
        'ln_ffn_g': 1.0 + 0.1 * nrm(ks[19], (DEPTH, D), f32),
        'ln_ffn_b': 0.02 * nrm(ks[20], (DEPTH, D), f32),
    }


def reference(x, w_in, gm_ws, gm_bs, gm_ln_g, gm_ln_b, gla_wa2, gla_ba, gla_norm_g, w_out,
              ln_mix_g, ln_mix_b, ffn_w_gate, ffn_w_up, ffn_w_down, router_w,
              exp_w_gate, exp_w_up, exp_w_down, ln_ffn_g, ln_ffn_b):
    for layer in range(DEPTH):
        h = hybrid_mixer(x, w_in[layer], gm_ws[layer], gm_bs[layer], gm_ln_g[layer], gm_ln_b[layer],
                         gla_wa2[layer], gla_ba[layer], gla_norm_g[layer], w_out[layer])
        x = layer_norm(DEEPNORM_ALPHA * x + h, ln_mix_g[layer], ln_mix_b[layer])
        i = layer // 2
        if layer % 2 == 0:
            f = swiglu(x, ffn_w_gate[i], ffn_w_up[i], ffn_w_down[i])
        else:
            f = moe_swiglu(x, router_w[i], exp_w_gate[i], exp_w_up[i], exp_w_down[i])
        x = layer_norm(DEEPNORM_ALPHA * x + f, ln_ffn_g[layer], ln_ffn_b[layer])
    return x
```

```cpp
#include <hip/hip_runtime.h>
#include <cstdio>
#include <cstdint>

#ifndef ABL
#define ABL 0
#endif
#ifndef GLA_DBG
#define GLA_DBG 0
#endif
#ifndef MK_PER_PHASE
#define MK_PER_PHASE 0
#endif

namespace pg8 {
#define PG8_LAS __attribute__((address_space(3)))
typedef unsigned short bf16_t;
typedef short bf16x8 __attribute__((ext_vector_type(8)));
typedef float f32x4 __attribute__((ext_vector_type(4)));
typedef float f32x2 __attribute__((ext_vector_type(2)));
typedef unsigned u32x4 __attribute__((ext_vector_type(4)));
typedef unsigned u32x2 __attribute__((ext_vector_type(2)));
constexpr int BM = 256, BK = 64, HALF = 128, HTB = HALF * BK * 2  , STAGE_BYTES = 8 * HTB, NXCD = 8, WGM = 8;

__host__ __device__ __forceinline__ int lds_byte(int r, int c) { const int st = (r >> 4) * 2 + (c >> 5), rr = r & 15, cc = c & 31, ob = rr * 64 + cc * 2; return st * 1024 + (ob ^ (((ob >> 9) & 1) << 5)); }
__host__ __device__ __forceinline__ void stage_rc(int b, int& R, int& C) { const int st = b / 1024, sb = b % 1024, swz = sb ^ (((sb >> 9) & 1) << 5); R = (st >> 1) * 16 + swz / 64; C = (st & 1) * 32 + (swz % 64) / 2; }
__host__ __device__ __forceinline__ int perm32(int rho) { const int n = rho >> 4, i = rho & 15; return 8 * (i >> 2) + 4 * n + (i & 3); }

struct Unit { int pm, pn; };

struct Order {
    int nM, nN, nwg, G, c, pm0;
    const char* A; const char* B; size_t a_t, b_t, b_e; int a_pm0, grouped; int pend[8];
    __device__ __forceinline__ void init(int nM_, int nN_, int G_, int c_, int pm0_) { nM = nM_; nN = nN_; nwg = nM * nN; G = G_; c = c_; pm0 = pm0_; grouped = 0; b_e = 0; a_pm0 = 0;
#pragma unroll
        for (int j = 0; j < 8; ++j) pend[j] = 0; }
    __device__ __forceinline__ bool next(int i, Unit& u) const {
        const long L = (long)i * G + c; if (L >= nwg) return false;
        int wgid = (int)L; { const int q = nwg / NXCD, r = nwg % NXCD, xcd = wgid % NXCD, off = wgid / NXCD; wgid = (xcd < r ? xcd * (q + 1) : r * (q + 1) + (xcd - r) * q) + off; }
        const int nig = WGM * nN, gid = wgid / nig, fm = gid * WGM, gsz = (nM - fm) < WGM ? (nM - fm) : WGM;
        u.pm = pm0 + fm + ((wgid % nig) % gsz); u.pn = (wgid % nig) / gsz; return true;
    }
    __device__ __forceinline__ const char* a_base(const Unit& u) const { return A + (size_t)(u.pm - a_pm0) * a_t; }
    __device__ __forceinline__ const char* b_base(const Unit& u) const {
        size_t off = (size_t)u.pn * b_t;
        if (grouped) { int e = 0;
#pragma unroll
            for (int j = 0; j < 7; ++j) e += (u.pm >= pend[j]) ? 1 : 0;
            off += (size_t)e * b_e; }
        return B + off;
    }
};

typedef __bf16 bf16x2_t __attribute__((ext_vector_type(2)));
__device__ __forceinline__ unsigned cvt_pk_bf16(float lo, float hi) { const f32x2 v = {lo, hi}; return __builtin_bit_cast(unsigned, __builtin_convertvector(v, bf16x2_t)); }
__device__ __forceinline__ f32x2 gelu_pk(f32x2 v) {
    const f32x2 av = __builtin_elementwise_abs(v), d = av * 0.2316418882f + 1.0f;
    f32x2 t; t.x = __builtin_amdgcn_rcpf(d.x); t.y = __builtin_amdgcn_rcpf(d.y);
    f32x2 q = t * 0.5307027145f + (-0.7265760135f); q = q * t + 0.7107068705f; q = q * t + (-0.142248368f); q = q * t + 0.127414796f; q = q * t;
    const f32x2 s = (v * v) * (-0.72134752044f);
    f32x2 e; e.x = __builtin_amdgcn_exp2f(s.x); e.y = __builtin_amdgcn_exp2f(s.y);
    const f32x2 m = v * (q * e), r = v - m;
    f32x2 o; o.x = v.x < 0.f ? m.x : r.x; o.y = v.y < 0.f ? m.y : r.y; return o;
}
__device__ __forceinline__ float silu_f(float x) { return x * __builtin_amdgcn_rcpf(1.0f + __expf(-x)); }

struct EpiProj {
    static constexpr bool PERM = true, AFTER_DRAIN = false;
    bf16_t* O; int ldc; int gelu_tiles;
    __device__ __forceinline__ void operator()(const f32x4 (&acc)[2][2][4][2], const Unit& u, int wr, int wc, int fr, int fq) const {
        const int row0 = u.pm * BM + wr * 64 + fr, col0 = u.pn * BM + wc * 32 + 8 * fq; const bool act = u.pn < gelu_tiles;
#pragma unroll
        for (int ai = 0; ai < 2; ++ai)
#pragma unroll
            for (int m = 0; m < 4; ++m) { bf16_t* rowp = O + (size_t)(row0 + ai * HALF + m * 16) * ldc + col0;
#pragma unroll
                for (int bj = 0; bj < 2; ++bj) { f32x4 v0 = acc[ai][bj][m][0], v1 = acc[ai][bj][m][1];
                    if (act) { f32x2 a = gelu_pk((f32x2){v0[0], v0[1]}), b = gelu_pk((f32x2){v0[2], v0[3]}), c = gelu_pk((f32x2){v1[0], v1[1]}), d = gelu_pk((f32x2){v1[2], v1[3]});
                        v0 = (f32x4){a.x, a.y, b.x, b.y}; v1 = (f32x4){c.x, c.y, d.x, d.y}; }
                    u32x4 w; w.x = cvt_pk_bf16(v0[0], v0[1]); w.y = cvt_pk_bf16(v0[2], v0[3]); w.z = cvt_pk_bf16(v1[0], v1[1]); w.w = cvt_pk_bf16(v1[2], v1[3]);
                    *(u32x4*)(rowp + bj * HALF) = w; } }
    }
};
template <bool RES_F32> struct EpiRes {
    static constexpr bool PERM = false, AFTER_DRAIN = false;
    float* Y; const void* res; float alpha;
    __device__ __forceinline__ void operator()(const f32x4 (&acc)[2][2][4][2], const Unit& u, int wr, int wc, int fr, int fq) const {
        const int row0 = u.pm * BM + wr * 64 + fr, col0 = u.pn * BM + wc * 32 + 4 * fq;
#pragma unroll
        for (int ai = 0; ai < 2; ++ai)
#pragma unroll
            for (int m = 0; m < 4; ++m) { const size_t off = (size_t)(row0 + ai * HALF + m * 16) * 1024 + col0;
#pragma unroll
                for (int bj = 0; bj < 2; ++bj)
#pragma unroll
                    for (int n = 0; n < 2; ++n) { const size_t c = off + bj * HALF + n * 16; f32x4 r4;
                        if (RES_F32) r4 = *(const f32x4*)((const float*)res + c);
                        else { const u32x2 w = *(const u32x2*)((const bf16_t*)res + c); r4 = (f32x4){__uint_as_float(w.x << 16), __uint_as_float(w.x & 0xffff0000u), __uint_as_float(w.y << 16), __uint_as_float(w.y & 0xffff0000u)}; }
                        *(f32x4*)(Y + c) = r4 * alpha + acc[ai][bj][m][n]; } }
    }
};
struct EpiSwiGLU {
    static constexpr bool PERM = true, AFTER_DRAIN = false;
    bf16_t* H; int ldh; int pm_off;
    __device__ __forceinline__ void operator()(const f32x4 (&acc)[2][2][4][2], const Unit& u, int wr, int wc, int fr, int fq) const {
        const int row0 = (u.pm - pm_off) * BM + wr * 64 + fr, col0 = u.pn * HALF + wc * 32 + 8 * fq;
#pragma unroll
        for (int ai = 0; ai < 2; ++ai)
#pragma unroll
            for (int m = 0; m < 4; ++m) { bf16_t* rowp = H + (size_t)(row0 + ai * HALF + m * 16) * ldh + col0;
                const f32x4 g0 = acc[ai][0][m][0], g1 = acc[ai][0][m][1], u0 = acc[ai][1][m][0], u1 = acc[ai][1][m][1];
                u32x4 w; w.x = cvt_pk_bf16(silu_f(g0[0]) * u0[0], silu_f(g0[1]) * u0[1]); w.y = cvt_pk_bf16(silu_f(g0[2]) * u0[2], silu_f(g0[3]) * u0[3]);
                w.z = cvt_pk_bf16(silu_f(g1[0]) * u1[0], silu_f(g1[1]) * u1[1]); w.w = cvt_pk_bf16(silu_f(g1[2]) * u1[2], silu_f(g1[3]) * u1[3]);
                if (((ABL >> 4) & 1) && ldh == 2816) w = (u32x4){0u, 0u, 0u, 0u};
                *(u32x4*)rowp = w; }
    }
};
struct EpiMoeDown {
    static constexpr bool PERM = true, AFTER_DRAIN = false;
    bf16_t* YP; const int* row_pair; const float* row_w;
    __device__ __forceinline__ void operator()(const f32x4 (&acc)[2][2][4][2], const Unit& u, int wr, int wc, int fr, int fq) const {
        const int row0 = u.pm * BM + wr * 64 + fr, col0 = u.pn * BM + wc * 32 + 8 * fq;
#pragma unroll
        for (int ai = 0; ai < 2; ++ai)
#pragma unroll
            for (int m = 0; m < 4; ++m) { const int r = row0 + ai * HALF + m * 16; const int p = row_pair[r];
                if (p >= 0) { const float gw = ((ABL >> 5) & 1) ? 0.f : row_w[r]; bf16_t* rowp = YP + (size_t)p * 1024 + col0;
#pragma unroll
                    for (int bj = 0; bj < 2; ++bj) { const f32x4 v0 = acc[ai][bj][m][0] * gw, v1 = acc[ai][bj][m][1] * gw;
                        u32x4 w; w.x = cvt_pk_bf16(v0[0], v0[1]); w.y = cvt_pk_bf16(v0[2], v0[3]); w.z = cvt_pk_bf16(v1[0], v1[1]); w.w = cvt_pk_bf16(v1[2], v1[3]);
                        *(u32x4*)(rowp + bj * HALF) = w; } } }
    }
};

template <class Epi, class Sched, bool ALIGN_EPI = false, bool SP2 = false>
__device__ __forceinline__ void gemm_phase(PG8_LAS unsigned char* lds, const int K, const Sched& S, const Epi& E) {
    int tid_ = threadIdx.x; asm volatile("" : "+v"(tid_));
    const int tid = tid_, wid = __builtin_amdgcn_readfirstlane(tid >> 6), lane = tid & 63, wr = wid >> 2, wc = wid & 3, fr = lane & 15, fq = lane >> 4;
    const int nt = K / BK;
    unsigned voffA[2], voffB[2];
#pragma unroll
    for (int i = 0; i < 2; ++i) { int R, C; stage_rc(tid * 16 + i * 8192, R, C); const int Rb = Epi::PERM ? ((R & ~31) + perm32(R & 31)) : R;
        voffA[i] = (unsigned)(R * K + C) * 2u; voffB[i] = (unsigned)(Rb * K + C) * 2u; }
    const size_t kstep = (size_t)(BK * 2);
    const size_t hstep = (size_t)HALF * K * 2;
    const unsigned ldsw = (unsigned)wid * 1024u;
    const int aoff = lds_byte(wr * 64 + fr, fq * 8), boff = lds_byte(wc * 32 + fr, fq * 8);
#define PG8_SA(b, h) (((b) * 2 + (h)) * HTB)
#define PG8_SB(b, h) ((4 + (b) * 2 + (h)) * HTB)
#define PG8_STAGE(bufoff, gbase, voff) do { _Pragma("unroll") for (int _i = 0; _i < 2; ++_i) \
        __builtin_amdgcn_global_load_lds((const unsigned*)((const char*)(gbase) + (voff)[_i]), (PG8_LAS unsigned*)(lds + (bufoff) + ldsw + _i * 8192), 16, 0, 0); } while (0)
#define PG8_LDA(dst, b, h) do { _Pragma("unroll") for (int m = 0; m < 4; ++m) _Pragma("unroll") for (int k = 0; k < 2; ++k) dst[m][k] = *(const PG8_LAS bf16x8*)(lds + PG8_SA(b, h) + aoff + m * 2048 + k * 1024); } while (0)
#define PG8_LDB(dst, b, h) do { _Pragma("unroll") for (int n = 0; n < 2; ++n) _Pragma("unroll") for (int k = 0; k < 2; ++k) dst[n][k] = *(const PG8_LAS bf16x8*)(lds + PG8_SB(b, h) + boff + n * 2048 + k * 1024); } while (0)
#define PG8_MMA(ai, bj, At, Bt) do { __builtin_amdgcn_s_setprio(1); _Pragma("unroll") for (int m = 0; m < 4; ++m) _Pragma("unroll") for (int n = 0; n < 2; ++n) _Pragma("unroll") for (int k = 0; k < 2; ++k) \
        acc[ai][bj][m][n] = __builtin_amdgcn_mfma_f32_16x16x32_bf16(Bt[n][k], At[m][k], acc[ai][bj][m][n], 0, 0, 0); __builtin_amdgcn_s_setprio(0); } while (0)
#define PG8_WAIT_V(n) asm volatile("s_waitcnt vmcnt(" #n ")" ::: "memory")
#define PG8_WAIT_L(n) asm volatile("s_waitcnt lgkmcnt(" #n ")" ::: "memory")
#define PG8_BAR __builtin_amdgcn_s_barrier()
#define PG8_SCHED __builtin_amdgcn_sched_barrier(0)
    Unit cur, nxt; int ui = 0;
    if (!S.next(0, cur)) return;
    f32x4 acc[2][2][4][2];
#pragma unroll
    for (int a = 0; a < 2; ++a)
#pragma unroll
        for (int b = 0; b < 2; ++b)
#pragma unroll
            for (int m = 0; m < 4; ++m)
#pragma unroll
                for (int n = 0; n < 2; ++n) acc[a][b][m][n] = (f32x4){0.f, 0.f, 0.f, 0.f};
    bf16x8 At[4][2], B0[2][2], B1[2][2];
    const char* cA = S.a_base(cur); const char* cB = S.b_base(cur);
    if constexpr (SP2) {
        PG8_STAGE(PG8_SB(0, 0), cB, voffB); PG8_STAGE(PG8_SB(0, 1), cB + hstep, voffB); PG8_STAGE(PG8_SA(0, 0), cA, voffA); PG8_STAGE(PG8_SA(0, 1), cA + hstep, voffA);
        if (wr == 1) PG8_BAR;
        PG8_WAIT_V(2); PG8_BAR;
        PG8_STAGE(PG8_SB(1, 0), cB + kstep, voffB); PG8_STAGE(PG8_SA(1, 0), cA + kstep, voffA); PG8_STAGE(PG8_SB(1, 1), cB + hstep + kstep, voffB);
        PG8_WAIT_V(6); PG8_BAR;
    } else {
        PG8_STAGE(PG8_SB(0, 0), cB, voffB); PG8_STAGE(PG8_SA(0, 0), cA, voffA); PG8_STAGE(PG8_SB(0, 1), cB + hstep, voffB); PG8_STAGE(PG8_SA(0, 1), cA + hstep, voffA);
        if (wr == 1) PG8_BAR;
        PG8_WAIT_V(4); PG8_BAR;
        PG8_STAGE(PG8_SB(1, 0), cB + kstep, voffB); PG8_STAGE(PG8_SA(1, 0), cA + kstep, voffA); PG8_STAGE(PG8_SB(1, 1), cB + hstep + kstep, voffB);
        PG8_WAIT_V(6); PG8_BAR;
    }
    for (;;) {
        const bool has_next = S.next(ui + 1, nxt);
        const char* nA = has_next ? S.a_base(nxt) : cA; const char* nB = has_next ? S.b_base(nxt) : cB;
        for (int t = 0; t < nt; t += 2) {
            const bool last = (t == nt - 2);
            const char* a1 = cA + (size_t)(t + 1) * kstep;
            const char* a2 = last ? nA : cA + (size_t)(t + 2) * kstep; const char* b2 = last ? nB : cB + (size_t)(t + 2) * kstep;
            const char* a3 = a2 + kstep; const char* b3 = b2 + kstep;
            if constexpr (SP2) {
            PG8_LDB(B0, 0, 0); PG8_LDB(B1, 0, 1); PG8_SCHED; PG8_LDA(At, 0, 0); PG8_STAGE(PG8_SA(1, 1), a1 + hstep, voffA);
            PG8_WAIT_V(8); PG8_WAIT_L(0); PG8_BAR; PG8_MMA(0, 0, At, B0); PG8_MMA(0, 1, At, B1); PG8_BAR; PG8_SCHED;
            PG8_LDA(At, 0, 1); PG8_STAGE(PG8_SB(0, 0), b2, voffB); PG8_STAGE(PG8_SB(0, 1), b2 + hstep, voffB); PG8_STAGE(PG8_SA(0, 0), a2, voffA);
            PG8_WAIT_V(8); PG8_WAIT_L(0); PG8_BAR; PG8_MMA(1, 0, At, B0); PG8_MMA(1, 1, At, B1); PG8_BAR; PG8_SCHED;
            PG8_LDB(B0, 1, 0); PG8_LDB(B1, 1, 1); PG8_SCHED; PG8_LDA(At, 1, 0); PG8_STAGE(PG8_SA(0, 1), a2 + hstep, voffA);
            PG8_WAIT_V(8); PG8_WAIT_L(0); PG8_BAR; PG8_MMA(0, 0, At, B0); PG8_MMA(0, 1, At, B1); PG8_BAR; PG8_SCHED;
            PG8_LDA(At, 1, 1); PG8_STAGE(PG8_SB(1, 0), b3, voffB); PG8_STAGE(PG8_SB(1, 1), b3 + hstep, voffB); PG8_STAGE(PG8_SA(1, 0), a3, voffA);
            PG8_WAIT_V(8); PG8_WAIT_L(0); PG8_BAR; PG8_MMA(1, 0, At, B0); PG8_MMA(1, 1, At, B1); PG8_BAR; PG8_SCHED;
            } else {
            PG8_LDB(B0, 0, 0); PG8_SCHED; PG8_LDA(At, 0, 0); PG8_STAGE(PG8_SA(1, 1), a1 + hstep, voffA);
            PG8_WAIT_L(8); PG8_BAR; PG8_WAIT_L(0); PG8_MMA(0, 0, At, B0); PG8_BAR; PG8_SCHED;
            PG8_LDB(B1, 0, 1); PG8_STAGE(PG8_SB(0, 0), b2, voffB);
            PG8_BAR; PG8_WAIT_L(0); PG8_MMA(0, 1, At, B1); PG8_BAR;
            PG8_LDA(At, 0, 1); PG8_STAGE(PG8_SA(0, 0), a2, voffA);
            PG8_BAR; PG8_WAIT_L(0); PG8_MMA(1, 0, At, B0); PG8_BAR; PG8_SCHED;
            PG8_STAGE(PG8_SB(0, 1), b2 + hstep, voffB);
            PG8_WAIT_V(6); PG8_BAR; PG8_MMA(1, 1, At, B1); PG8_BAR;
            PG8_LDB(B0, 1, 0); PG8_SCHED; PG8_LDA(At, 1, 0); PG8_STAGE(PG8_SA(0, 1), a2 + hstep, voffA);
            PG8_WAIT_L(8); PG8_BAR; PG8_WAIT_L(0); PG8_MMA(0, 0, At, B0); PG8_BAR; PG8_SCHED;
            PG8_LDB(B1, 1, 1); PG8_STAGE(PG8_SB(1, 0), b3, voffB);
            PG8_BAR; PG8_WAIT_L(0); PG8_MMA(0, 1, At, B1); PG8_BAR;
            PG8_LDA(At, 1, 1); PG8_STAGE(PG8_SA(1, 0), a3, voffA);
            PG8_BAR; PG8_WAIT_L(0); PG8_MMA(1, 0, At, B0); PG8_BAR; PG8_SCHED;
            PG8_STAGE(PG8_SB(1, 1), b3 + hstep, voffB);
            PG8_WAIT_V(6); PG8_BAR; PG8_MMA(1, 1, At, B1); PG8_BAR;
            }
        }
        if constexpr (ALIGN_EPI) { if (wr == 0) PG8_BAR; }
        E(acc, cur, wr, wc, fr, fq);
        if (!has_next) break;
#pragma unroll
        for (int a = 0; a < 2; ++a)
#pragma unroll
            for (int b = 0; b < 2; ++b)
#pragma unroll
                for (int m = 0; m < 4; ++m)
#pragma unroll
                    for (int n = 0; n < 2; ++n) acc[a][b][m][n] = (f32x4){0.f, 0.f, 0.f, 0.f};
        cur = nxt; cA = nA; cB = nB; ++ui;
        if constexpr (ALIGN_EPI) { if (wr == 1) PG8_BAR; }
    }
    PG8_WAIT_V(0);
    if constexpr (!ALIGN_EPI) { if (wr == 0) PG8_BAR; }
    PG8_BAR;
#undef PG8_SA
#undef PG8_SB
#undef PG8_STAGE
#undef PG8_LDA
#undef PG8_LDB
#undef PG8_MMA
#undef PG8_WAIT_V
#undef PG8_WAIT_L
#undef PG8_BAR
#undef PG8_SCHED
}
}

constexpr int NWAVES = 8;
constexpr int BATCH = 16, SEQ = 2048, D = 1024, T = BATCH * SEQ;
constexpr int LDP = 2816;
constexpr int IN_COLS = 2576;
constexpr int C_U = 0, C_V = 512, C_Q = 1024, C_K = 1280, C_VV = 1536, C_G = 2048, C_A = 2560;
constexpr int DFF = 2816, DFE = 3584, NE = 8;
constexpr float LN_EPS = 1e-5f, RMS_EPS = 1e-6f, ALPHA = 1.41421356237f;
constexpr int RMAX = 2 * T + NE * 256;
constexpr int SLAB_P = 64;
constexpr int NSLAB = 5;
constexpr int NPHASE = 24;

constexpr size_t MiB = 1u << 20;
constexpr size_t WS_CTL = 0, CTL_ZERO_BYTES = 64 * 1024;
constexpr size_t WS_TOKE = 1 * MiB;
constexpr size_t WS_TOKW = WS_TOKE + 256 * 1024;
constexpr size_t WS_RPAIR = 2 * MiB;
constexpr size_t WS_RW = WS_RPAIR + 512 * 1024;
constexpr size_t WS_WM = 3 * MiB;
constexpr size_t WS_WIN = 4 * MiB;
constexpr size_t WS_WOUT = 15 * MiB;
constexpr size_t WS_WGU = 19 * MiB;
constexpr size_t WS_WDN = 30 * MiB;
constexpr size_t WS_EGU = 36 * MiB;
constexpr size_t WS_EDN = 148 * MiB;
constexpr size_t WS_XB = 204 * MiB;
constexpr size_t WS_BIG = 268 * MiB;
constexpr size_t WS_PROJ = WS_BIG;
constexpr size_t WS_CAT = 444 * MiB;
constexpr size_t WS_HID = WS_BIG;
constexpr size_t WS_XG = WS_BIG;
constexpr size_t WS_HSLAB = 400 * MiB;
constexpr size_t WS_END = 512 * MiB;
constexpr int CW_TMO = 0;
constexpr int CW_CNT = 64;
constexpr int CW_CUR = 128;
constexpr int CW_BAR = 4096;

constexpr int RING_BYTES = 131072;
constexpr int LDSCTL_OFF = RING_BYTES, MISC_OFF = LDSCTL_OFF + 320;
constexpr int LDS_BYTES = 147456;

#define GAS __attribute__((address_space(1)))
#define LAS __attribute__((address_space(3)))
typedef unsigned short bf16;
typedef unsigned v4u __attribute__((ext_vector_type(4)));
typedef unsigned v2u __attribute__((ext_vector_type(2)));
typedef float f32x4 __attribute__((ext_vector_type(4)));
typedef float f32x2 __attribute__((ext_vector_type(2)));
typedef short bf16x8 __attribute__((ext_vector_type(8)));
#define RLX_AGENT __ATOMIC_RELAXED, __HIP_MEMORY_SCOPE_AGENT
#define LDS_WAIT() asm volatile("s_waitcnt lgkmcnt(0)" ::: "memory")
__device__ __forceinline__ float bflo(unsigned w) { return __uint_as_float(w << 16); }
__device__ __forceinline__ float bfhi(unsigned w) { return __uint_as_float(w & 0xffff0000u); }
__device__ __forceinline__ float bf2f(unsigned short h) { return __uint_as_float(((unsigned)h) << 16); }
__device__ __forceinline__ unsigned pk2(float lo, float hi) { return pg8::cvt_pk_bf16(lo, hi); }

#define XB_TMO      128
#define XB_XCNT(j)  (256  + 64 * (j))
#define XB_XSUB(j)  (1280 + 64 * (j))
#define XB_XGEN(j)  (2304 + 64 * (j))
#define XB_TOP      3328
#define XB_TOPGEN   3392
#define XCD_BAR_WORDS 3456
#define XB_SPIN_CAP (1u << 18)
__device__ __forceinline__ unsigned xb_ld(unsigned* p)              { return __hip_atomic_load(p, __ATOMIC_RELAXED, __HIP_MEMORY_SCOPE_AGENT); }
__device__ __forceinline__ unsigned xb_add(unsigned* p, unsigned v) { return __hip_atomic_fetch_add(p, v, __ATOMIC_RELAXED, __HIP_MEMORY_SCOPE_AGENT); }
__device__ __forceinline__ unsigned xb_xcc_id() { return (unsigned)__builtin_amdgcn_s_getreg((3 << 11) | 20) & 0xFu; }
#define XB_SPIN(cond, bar) do { unsigned _sp = 0; while (cond) { __builtin_amdgcn_s_sleep(1); \
    if ((++_sp & 255u) == 0u) { if (xb_ld(&(bar)[XB_TMO])) break; if (_sp > XB_SPIN_CAP) { atomicAdd(&(bar)[XB_TMO], 1u); break; } } } } while (0)
struct XcdBarrier { unsigned* bar; unsigned x; volatile LAS unsigned* st; };
__device__ __forceinline__ XcdBarrier xcd_barrier_post(unsigned* bar, volatile LAS unsigned* st) {
    XcdBarrier b; b.bar = bar; b.x = xb_xcc_id(); b.st = st;
    if (threadIdx.x == 0) (void)xb_add(&bar[XB_XCNT(b.x)], 1u);
    return b;
}
__device__ __forceinline__ void xcd_barrier_complete(unsigned* bar, unsigned x, unsigned& nloc, unsigned& nx) {
    const unsigned G = gridDim.x * gridDim.y * gridDim.z;
    unsigned sum, cnt, mine, sp = 0u;
    for (;;) {
        sum = 0u; cnt = 0u; mine = 0u;
#pragma unroll
        for (unsigned j = 0; j < 16; ++j) { const unsigned c = xb_ld(&bar[XB_XCNT(j)]); sum += c; cnt += (c > 0u) ? 1u : 0u; mine = (j == x) ? c : mine; }
        if (sum == G) break;
        __builtin_amdgcn_s_sleep(1);
        if ((++sp & 255u) == 0u) { if (xb_ld(&bar[XB_TMO])) break; if (sp > XB_SPIN_CAP) { atomicAdd(&bar[XB_TMO], 1u); break; } }
    }
    nloc = mine > 0u ? mine : 1u; nx = cnt > 0u ? cnt : 1u;
}
__device__ __forceinline__ void xcd_barrier(const XcdBarrier& b) {
    asm volatile("s_waitcnt vmcnt(0)" ::: "memory");
    __syncthreads();
    if (threadIdx.x == 0) {
        unsigned* bar = b.bar;
        __builtin_amdgcn_s_waitcnt(0);
        unsigned nloc = b.st[0], nx = b.st[1];
        if (nloc == 0u) { xcd_barrier_complete(bar, b.x, nloc, nx); b.st[0] = nloc; b.st[1] = nx; }
        const unsigned old = xb_add(&bar[XB_XSUB(b.x)], 1u);
        const unsigned gen = old / nloc;
        if (old + 1u == (gen + 1u) * nloc) {
            __builtin_amdgcn_fence(__ATOMIC_RELEASE, "agent");
            asm volatile("s_waitcnt vmcnt(0)" ::: "memory");
            const unsigned og = xb_add(&bar[XB_TOP], 1u);
            const unsigned tg = og / nx;
            if (og + 1u == (tg + 1u) * nx) xb_add(&bar[XB_TOPGEN], 1u);
            else XB_SPIN(xb_ld(&bar[XB_TOPGEN]) == tg, bar);
            __builtin_amdgcn_fence(__ATOMIC_ACQUIRE, "agent");
            xb_add(&bar[XB_XGEN(b.x)], 1u);
            asm volatile("s_waitcnt vmcnt(0)" ::: "memory");
        } else {
            XB_SPIN(xb_ld(&bar[XB_XGEN(b.x)]) == gen, bar);
            __builtin_amdgcn_fence(__ATOMIC_ACQUIRE, "agent");
            asm volatile("s_waitcnt vmcnt(0)" ::: "memory");
        }
    }
    __syncthreads();
}

struct Args { const float* in[21]; float* out; unsigned char* ws; int ph_lo, ph_hi; };
struct Frame {
    LAS unsigned char* lds;
    volatile LAS unsigned* MISC;
    unsigned* ctl;
    int tid, lane, wave, G;
    unsigned char* ws; float* out;
};
#define LOCAL_IDS int tid = threadIdx.x; asm volatile("" : "+v"(tid)); const int lane = tid & 63; const int wave = __builtin_amdgcn_readfirstlane(tid >> 6); (void)lane; (void)wave
__device__ __forceinline__ float wave_sum(float v) {
#pragma unroll
    for (int o = 1; o < 64; o <<= 1) v += __shfl_xor(v, o);
    return v;
}

__device__ __forceinline__ void tr_block(const float* W, int Nsrc, int K, int k0, int n0, bf16* WT, int drow, LAS float* scr, int lane) {
    const int n = n0 + (lane & 31); const bool ok = n < Nsrc;
#pragma unroll 8
    for (int i = 0; i < 32; ++i) { const int kk = 2 * i + (lane >> 5); scr[kk * 33 + (lane & 31)] = ok ? W[(size_t)(k0 + kk) * Nsrc + n] : 0.f; }
    LDS_WAIT(); asm volatile("" ::: "memory");
    const int c = lane & 7;
#pragma unroll
    for (int j = 0; j < 4; ++j) { const int nn = (lane >> 3) + 8 * j; const LAS float* s = scr + (8 * c) * 33 + nn;
        v4u o; o.x = pk2(s[0 * 33], s[1 * 33]); o.y = pk2(s[2 * 33], s[3 * 33]); o.z = pk2(s[4 * 33], s[5 * 33]); o.w = pk2(s[6 * 33], s[7 * 33]);
        *(GAS v4u*)(WT + (size_t)(drow + nn) * K + k0 + 8 * c) = o; }
    LDS_WAIT(); asm volatile("" ::: "memory");
}
__device__ __forceinline__ void tr_plain(const float* W, int K, int Nsrc, int nblk, bf16* WT, int item, LAS float* scr, int lane) {
    const int kb = item / nblk, nb = item % nblk; tr_block(W, Nsrc, K, 64 * kb, 32 * nb, WT, 32 * nb, scr, lane);
}
__device__ __forceinline__ void tr_gu(const float* W, int K, int Nsrc, int nblk, bf16* WT, int add, int item, LAS float* scr, int lane) {
    const int kb = item / nblk, nb = item % nblk, n0 = 32 * nb; tr_block(W, Nsrc, K, 64 * kb, n0, WT, (n0 >> 7) * 256 + (n0 & 127) + add, scr, lane);
}
__device__ __forceinline__ void p0_prologue(Frame& F, const Args& a) {
    LOCAL_IDS;
    LAS float* scr = (LAS float*)(F.lds + wave * 16384);
    const int gw = blockIdx.x * NWAVES + wave, NGW = F.G * NWAVES;
    bf16* Win = (bf16*)(F.ws + WS_WIN); bf16* Wout = (bf16*)(F.ws + WS_WOUT); bf16* Wgu = (bf16*)(F.ws + WS_WGU); bf16* Wdn = (bf16*)(F.ws + WS_WDN);
    bf16* Egu = (bf16*)(F.ws + WS_EGU); bf16* Edn = (bf16*)(F.ws + WS_EDN);
    constexpr int I_IN = 16 * 88, I_OUT = 16 * 32, I_G = 16 * 88, I_DN = 44 * 32, I_EG = 16 * 112, I_ED = 56 * 32;
    constexpr int NITEMS = 2 * I_IN + 2 * I_OUT + 2 * I_G + I_DN + 16 * I_EG + 8 * I_ED;
    for (int it = gw; it < NITEMS; it += NGW) {
        int r = it;
        if (r < 2 * I_IN) { const int l = r / I_IN; tr_plain(a.in[1] + (size_t)l * D * IN_COLS, D, IN_COLS, 88, Win + (size_t)l * LDP * D, r % I_IN, scr, lane); continue; } r -= 2 * I_IN;
        if (r < 2 * I_OUT) { const int l = r / I_OUT; tr_plain(a.in[9] + (size_t)l * D * D, D, D, 32, Wout + (size_t)l * D * D, r % I_OUT, scr, lane); continue; } r -= 2 * I_OUT;
        if (r < I_G) { tr_gu(a.in[12], D, DFF, 88, Wgu, 0, r, scr, lane); continue; } r -= I_G;
        if (r < I_G) { tr_gu(a.in[13], D, DFF, 88, Wgu, 128, r, scr, lane); continue; } r -= I_G;
        if (r < I_DN) { tr_plain(a.in[14], DFF, D, 32, Wdn, r, scr, lane); continue; } r -= I_DN;
        if (r < 8 * I_EG) { const int e = r / I_EG; tr_gu(a.in[16] + (size_t)e * D * DFE, D, DFE, 112, Egu + (size_t)e * 2 * DFE * D, 0, r % I_EG, scr, lane); continue; } r -= 8 * I_EG;
        if (r < 8 * I_EG) { const int e = r / I_EG; tr_gu(a.in[17] + (size_t)e * D * DFE, D, DFE, 112, Egu + (size_t)e * 2 * DFE * D, 128, r % I_EG, scr, lane); continue; } r -= 8 * I_EG;
        { const int e = r / I_ED; tr_plain(a.in[18] + (size_t)e * DFE * D, DFE, D, 32, Edn + (size_t)e * D * DFE, r % I_ED, scr, lane); }
    }
    const size_t gt = (size_t)blockIdx.x * 512 + tid, NT = (size_t)F.G * 512;
    { const f32x4* x4 = (const f32x4*)a.in[0]; v4u* o = (v4u*)(F.ws + WS_XB);
      for (size_t i = gt; i < (size_t)T * D / 8; i += NT) { const f32x4 p = x4[2 * i], q = x4[2 * i + 1]; v4u w; w.x = pk2(p[0], p[1]); w.y = pk2(p[2], p[3]); w.z = pk2(q[0], q[1]); w.w = pk2(q[2], q[3]); o[i] = w; } }
    { const float* w = a.in[2]; bf16* o = (bf16*)(F.ws + WS_WM);
      for (size_t i = gt; i < (size_t)2 * 4 * 128 * 128; i += NT) { const int s = (int)(i & 127), t = (int)((i >> 7) & 127); o[i] = (bf16)(pk2(s <= t ? w[i] : 0.f, 0.f) & 0xffffu); } }
}

__device__ __forceinline__ void gmlp_item(Frame& F, const Args& a, int layer, int item) {
    const int bb = item >> 6, c = (item >> 2) & 15, h = item & 3; const int r0 = bb * SEQ + c * 128;
    const bf16* P = (const bf16*)(F.ws + WS_PROJ); bf16* CAT = (bf16*)(F.ws + WS_CAT);
    const bf16* Wm = (const bf16*)(F.ws + WS_WM) + (size_t)(layer * 4 + h) * 128 * 128;
    const float* lng = a.in[4] + layer * 512 + h * 128; const float* lnb = a.in[5] + layer * 512 + h * 128; const float* bs = a.in[3] + (layer * 4 + h) * 128;
    LAS unsigned char* VTA = F.lds;
    LOCAL_IDS; const int w = wave, fr = lane & 15, fq = lane >> 4;
    {
        const int s = tid >> 2, q4 = tid & 3; const bf16* vp = P + (size_t)(r0 + s) * LDP + C_V + h * 128 + q4 * 8;
        float x[4][8]; float sum = 0.f;
#pragma unroll
        for (int j = 0; j < 4; ++j) { const v4u wv = *(const v4u*)(vp + 32 * j); x[j][0] = bflo(wv.x); x[j][1] = bfhi(wv.x); x[j][2] = bflo(wv.y); x[j][3] = bfhi(wv.y); x[j][4] = bflo(wv.z); x[j][5] = bfhi(wv.z); x[j][6] = bflo(wv.w); x[j][7] = bfhi(wv.w);
#pragma unroll
            for (int e = 0; e < 8; ++e) sum += x[j][e]; }
        sum += __shfl_xor(sum, 1); sum += __shfl_xor(sum, 2);
        const float mean = sum * (1.f / 128.f); float q = 0.f;
#pragma unroll
        for (int j = 0; j < 4; ++j)
#pragma unroll
            for (int e = 0; e < 8; ++e) { x[j][e] -= mean; q += x[j][e] * x[j][e]; }
        q += __shfl_xor(q, 1); q += __shfl_xor(q, 2);
        const float rstd = 1.0f / sqrtf(q * (1.f / 128.f) + LN_EPS);
#pragma unroll
        for (int j = 0; j < 4; ++j) { const int ch0 = q4 * 8 + 32 * j; const f32x4 g0 = *(const f32x4*)(lng + ch0), g1 = *(const f32x4*)(lng + ch0 + 4), b0 = *(const f32x4*)(lnb + ch0), b1 = *(const f32x4*)(lnb + ch0 + 4);
#pragma unroll
            for (int e = 0; e < 8; ++e) { const float gg = e < 4 ? g0[e & 3] : g1[e & 3], be = e < 4 ? b0[e & 3] : b1[e & 3]; const float y = x[j][e] * rstd * gg + be;
                *(LAS bf16*)(VTA + (ch0 + e) * 272 + s * 2) = (bf16)(pk2(y, 0.f) & 0xffffu); } }
    }
    __syncthreads();
    {
        bf16x8 aV[4];
#pragma unroll
        for (int ks = 0; ks < 4; ++ks) aV[ks] = *(const LAS bf16x8*)(VTA + (16 * w + fr) * 272 + (32 * ks + 8 * fq) * 2);
#pragma unroll
        for (int tt = 0; tt < 8; ++tt) { f32x4 acc = (f32x4){0.f, 0.f, 0.f, 0.f}; const int t = 16 * tt + fr;
#pragma unroll
            for (int ks = 0; ks < 4; ++ks) if (ks <= tt / 2) { const bf16x8 bW = *(const bf16x8*)(Wm + (size_t)t * 128 + 32 * ks + 8 * fq); acc = __builtin_amdgcn_mfma_f32_16x16x32_bf16(aV[ks], bW, acc, 0, 0, 0); }
            const float bst = bs[t]; const size_t row = (size_t)(r0 + t); const v2u uu = *(const v2u*)(P + row * LDP + C_U + h * 128 + 16 * w + 4 * fq);
            v2u o; o.x = pk2(bflo(uu.x) * (acc[0] + bst), bfhi(uu.x) * (acc[1] + bst)); o.y = pk2(bflo(uu.y) * (acc[2] + bst), bfhi(uu.y) * (acc[3] + bst));
            if ((ABL >> layer) & 1) { o.x = 0u; o.y = 0u; }
            *(v2u*)(CAT + row * D + h * 128 + 16 * w + 4 * fq) = o; }
    }
    __syncthreads();
}

constexpr int G_QD = 0, G_KI = 9216, G_SC = 18432, G_KDT = 27648, G_VT = 36864, G_ST = 55296, G_ALR = 73728, G_PART = 75776, G_DEC = 77824, G_SS = 78080, G_RQ = 80128, G_RK = 88320, G_RV = 96512, G_END = 112896;
__device__ __forceinline__ void gla_item(Frame& F, const Args& a, int layer, int item) {
    const int bb = item >> 2, h = item & 3;
    const bf16* P = (const bf16*)(F.ws + WS_PROJ) + (size_t)bb * SEQ * LDP; bf16* CAT = (bf16*)(F.ws + WS_CAT) + (size_t)bb * SEQ * D;
    LAS unsigned char* L = F.lds;
    LOCAL_IDS; const int w = wave, fr = lane & 15, fq = lane >> 4, d = lane;
    const int ve = (w & 1) * 64 + lane, vjg = w >> 1;
    float wcol[16];
#pragma unroll
    for (int m = 0; m < 16; ++m) wcol[m] = a.in[6][(size_t)layer * 16 * 256 + m * 256 + h * 64 + d];
    const float bad = a.in[7][layer * 256 + h * 64 + d];
    const f32x4 ng = *(const f32x4*)(a.in[8] + layer * 512 + h * 128 + 16 * w + 4 * fq);
    for (int i = tid; i < (18432 + 9216) / 4; i += 512) { if (i < 18432 / 4) ((LAS unsigned*)(L + G_ST))[i] = 0u; else ((LAS unsigned*)(L + G_SC))[i - 18432 / 4] = 0u; }
    f32x4 sacc[4];
#pragma unroll
    for (int dt = 0; dt < 4; ++dt) sacc[dt] = (f32x4){0.f, 0.f, 0.f, 0.f};
    const unsigned oq = (unsigned)((tid >> 3) * LDP + C_Q + h * 64 + (tid & 7) * 8), ok_ = (unsigned)((tid >> 3) * LDP + C_K + h * 64 + (tid & 7) * 8);
    const unsigned ov = (unsigned)((tid >> 4) * LDP + C_VV + h * 128 + (tid & 15) * 8), oa = (unsigned)(((tid & 127) >> 1) * LDP + C_A + (tid & 1) * 8);
    const unsigned og = (unsigned)(fr * LDP + C_G + h * 128 + 16 * w + 4 * fq);
    v4u rq, rk, rv0, rv1, ra = (v4u){0u, 0u, 0u, 0u};
    { rq = *(const v4u*)(P + oq); rk = *(const v4u*)(P + ok_); rv0 = *(const v4u*)(P + ov); rv1 = *(const v4u*)(P + ov + 32 * LDP); if (tid < 128) ra = *(const v4u*)(P + oa); }
    __syncthreads();
    for (int n = 0; n < 32; ++n) {
        const bf16* R = P + (size_t)n * 64 * LDP;
        *(LAS v4u*)(L + G_RQ + tid * 16) = rq; *(LAS v4u*)(L + G_RK + tid * 16) = rk; *(LAS v4u*)(L + G_RV + tid * 16) = rv0; *(LAS v4u*)(L + G_RV + 8192 + tid * 16) = rv1;
        if (tid < 128) *(LAS v4u*)(L + G_ALR + tid * 16) = ra;
        __syncthreads();
        if (n + 1 < 32) { const bf16* Rn = R + (size_t)64 * LDP; rq = *(const v4u*)(Rn + oq); rk = *(const v4u*)(Rn + ok_); rv0 = *(const v4u*)(Rn + ov); rv1 = *(const v4u*)(Rn + ov + 32 * LDP); if (tid < 128) ra = *(const v4u*)(Rn + oa); }
        v2u gate[4];
#pragma unroll
        for (int it = 0; it < 4; ++it) gate[it] = *(const v2u*)(R + og + (size_t)(16 * it) * LDP);
        { unsigned short vv[16];
#pragma unroll
          for (int jj = 0; jj < 16; ++jj) vv[jj] = *(const LAS unsigned short*)(L + G_RV + (16 * vjg + jj) * 256 + ve * 2);
          v4u p0, p1; p0.x = vv[0] | ((unsigned)vv[1] << 16); p0.y = vv[2] | ((unsigned)vv[3] << 16); p0.z = vv[4] | ((unsigned)vv[5] << 16); p0.w = vv[6] | ((unsigned)vv[7] << 16);
          p1.x = vv[8] | ((unsigned)vv[9] << 16); p1.y = vv[10] | ((unsigned)vv[11] << 16); p1.z = vv[12] | ((unsigned)vv[13] << 16); p1.w = vv[14] | ((unsigned)vv[15] << 16);
          *(LAS v4u*)(L + G_VT + ve * 144 + vjg * 32) = p0; *(LAS v4u*)(L + G_VT + ve * 144 + vjg * 32 + 16) = p1; }
        float cs[8]; float run = 0.f;
#pragma unroll
        for (int ii = 0; ii < 8; ++ii) { const v4u a0 = *(const LAS v4u*)(L + G_ALR + (8 * w + ii) * 32), a1 = *(const LAS v4u*)(L + G_ALR + (8 * w + ii) * 32 + 16);
            float z = bad;
            z += bflo(a0.x) * wcol[0] + bfhi(a0.x) * wcol[1] + bflo(a0.y) * wcol[2] + bfhi(a0.y) * wcol[3] + bflo(a0.z) * wcol[4] + bfhi(a0.z) * wcol[5] + bflo(a0.w) * wcol[6] + bfhi(a0.w) * wcol[7];
            z += bflo(a1.x) * wcol[8] + bfhi(a1.x) * wcol[9] + bflo(a1.y) * wcol[10] + bfhi(a1.y) * wcol[11] + bflo(a1.z) * wcol[12] + bfhi(a1.z) * wcol[13] + bflo(a1.w) * wcol[14] + bfhi(a1.w) * wcol[15];
            const float ls = fminf(z, 0.f) - __logf(1.0f + __expf(-fabsf(z)));
            run += ((GLA_DBG == 2 || GLA_DBG == 3) ? 0.f : ls * 0.0625f); cs[ii] = run; }
        *(LAS float*)(L + G_PART + (w * 64 + d) * 4) = run;
        __syncthreads();
        float off = 0.f, bl = 0.f;
#pragma unroll
        for (int ww = 0; ww < 8; ++ww) { const float p = *(const LAS float*)(L + G_PART + (ww * 64 + d) * 4); bl += p; off += (ww < w) ? p : 0.f; }
        { unsigned kd[8];
#pragma unroll
          for (int ii = 0; ii < 8; ++ii) { const float qv = bf2f(*(const LAS unsigned short*)(L + G_RQ + (8 * w + ii) * 128 + d * 2)), kv = bf2f(*(const LAS unsigned short*)(L + G_RK + (8 * w + ii) * 128 + d * 2));
              const float b_ = off + cs[ii]; const float qd = qv * 0.125f * __expf(b_), ki = kv * __expf(-b_), kdv = kv * __expf(bl - b_);
              *(LAS bf16*)(L + G_QD + (8 * w + ii) * 144 + d * 2) = (bf16)(pk2(qd, 0.f) & 0xffffu);
              *(LAS bf16*)(L + G_KI + (8 * w + ii) * 144 + d * 2) = (bf16)(pk2(ki, 0.f) & 0xffffu);
              kd[ii] = pk2(kdv, 0.f) & 0xffffu; }
          v4u pk; pk.x = kd[0] | (kd[1] << 16); pk.y = kd[2] | (kd[3] << 16); pk.z = kd[4] | (kd[5] << 16); pk.w = kd[6] | (kd[7] << 16);
          *(LAS v4u*)(L + G_KDT + d * 144 + w * 16) = pk; }
        if (w == 0) *(LAS float*)(L + G_DEC + d * 4) = __expf(bl);
        __syncthreads();
#pragma unroll
        for (int rep = 0; rep < 2; ++rep) { const int tix = w + 8 * rep;
            if (tix < 10) { const int it = (tix >= 6) ? 3 : (tix >= 3) ? 2 : (tix >= 1) ? 1 : 0, jt = tix - it * (it + 1) / 2;
                f32x4 acc = (f32x4){0.f, 0.f, 0.f, 0.f};
#pragma unroll
                for (int ks = 0; ks < 2; ++ks) { const bf16x8 ak = *(const LAS bf16x8*)(L + G_KI + (16 * jt + fr) * 144 + (32 * ks + 8 * fq) * 2), bq = *(const LAS bf16x8*)(L + G_QD + (16 * it + fr) * 144 + (32 * ks + 8 * fq) * 2);
                    acc = __builtin_amdgcn_mfma_f32_16x16x32_bf16(ak, bq, acc, 0, 0, 0); }
                const int i = 16 * it + fr, j0 = 16 * jt + 4 * fq;
                v2u o; o.x = pk2(j0 <= i ? acc[0] : 0.f, j0 + 1 <= i ? acc[1] : 0.f); o.y = pk2(j0 + 2 <= i ? acc[2] : 0.f, j0 + 3 <= i ? acc[3] : 0.f);
                *(LAS v2u*)(L + G_SC + i * 144 + j0 * 2) = o; } }
        __syncthreads();
        bf16x8 aV[2], aS[2];
#pragma unroll
        for (int ks = 0; ks < 2; ++ks) { aV[ks] = *(const LAS bf16x8*)(L + G_VT + (16 * w + fr) * 144 + (32 * ks + 8 * fq) * 2); aS[ks] = *(const LAS bf16x8*)(L + G_ST + (16 * w + fr) * 144 + (32 * ks + 8 * fq) * 2); }
        f32x4 o[4];
#pragma unroll
        for (int it = 0; it < 4; ++it) { f32x4 acc = (f32x4){0.f, 0.f, 0.f, 0.f};
#pragma unroll
            for (int ks = 0; ks < 2; ++ks) if (ks == 0 || it >= 2) { const bf16x8 bs_ = *(const LAS bf16x8*)(L + G_SC + (16 * it + fr) * 144 + (32 * ks + 8 * fq) * 2); acc = __builtin_amdgcn_mfma_f32_16x16x32_bf16(aV[ks], bs_, acc, 0, 0, 0); }
#pragma unroll
            for (int ks = 0; ks < 2; ++ks) { const bf16x8 bq = *(const LAS bf16x8*)(L + G_QD + (16 * it + fr) * 144 + (32 * ks + 8 * fq) * 2); acc = __builtin_amdgcn_mfma_f32_16x16x32_bf16(aS[ks], bq, acc, 0, 0, 0); }
            o[it] = acc;
            float p = acc[0] * acc[0] + acc[1] * acc[1] + acc[2] * acc[2] + acc[3] * acc[3]; p += __shfl_xor(p, 16); p += __shfl_xor(p, 32);
            if (fq == 0) *(LAS float*)(L + G_SS + (w * 64 + 16 * it + fr) * 4) = p; }
        asm volatile("s_waitcnt lgkmcnt(0)" ::: "memory");
#pragma unroll
        for (int dt = 0; dt < 4; ++dt) { const f32x4 dec = *(const LAS f32x4*)(L + G_DEC + (16 * dt + 4 * fq) * 4); sacc[dt] = sacc[dt] * dec;
#pragma unroll
            for (int ks = 0; ks < 2; ++ks) { const bf16x8 ak = *(const LAS bf16x8*)(L + G_KDT + (16 * dt + fr) * 144 + (32 * ks + 8 * fq) * 2); sacc[dt] = __builtin_amdgcn_mfma_f32_16x16x32_bf16(ak, aV[ks], sacc[dt], 0, 0, 0); }
            v2u sw; sw.x = pk2(sacc[dt][0], sacc[dt][1]); sw.y = pk2(sacc[dt][2], sacc[dt][3]);
            if (GLA_DBG != 1) *(LAS v2u*)(L + G_ST + (16 * w + fr) * 144 + (16 * dt + 4 * fq) * 2) = sw; }
        __syncthreads();
#if GLA_DBG == 3
        if (n == 0 && layer == 0) {
            unsigned bits = 0u;
            { const int dd = tid & 63, ee = tid >> 2; float ref = 0.f; for (int j = 0; j < 64; ++j) ref += bf2f(*(const LAS unsigned short*)(L + G_KDT + dd * 144 + j * 2)) * bf2f(*(const LAS unsigned short*)(L + G_VT + ee * 144 + j * 2));
              const float got = bf2f(*(const LAS unsigned short*)(L + G_ST + ee * 144 + dd * 2)); if (!(fabsf(got - ref) <= 0.02f * fabsf(ref) + 0.02f)) bits |= 1u; }
            { const int dd = tid & 63; for (int j = (tid >> 6); j < 64; j += 8) { const unsigned short kk = *(const LAS unsigned short*)(L + G_KDT + dd * 144 + j * 2), rk_ = *(const LAS unsigned short*)(L + G_RK + j * 128 + dd * 2); if (kk != rk_) bits |= 2u; } }
            { const int ee = tid & 127; for (int j = (tid >> 7); j < 64; j += 4) { const unsigned short vv_ = *(const LAS unsigned short*)(L + G_VT + ee * 144 + j * 2), rv_ = *(const LAS unsigned short*)(L + G_RV + j * 256 + ee * 2); if (vv_ != rv_) bits |= 4u; } }
            {
#pragma unroll
                for (int dt = 0; dt < 4; ++dt)
#pragma unroll
                    for (int r = 0; r < 4; ++r) { const int dd = 16 * dt + 4 * fq + r, ee = 16 * w + fr; float ref = 0.f; for (int j = 0; j < 64; ++j) ref += bf2f(*(const LAS unsigned short*)(L + G_KDT + dd * 144 + j * 2)) * bf2f(*(const LAS unsigned short*)(L + G_VT + ee * 144 + j * 2));
                        if (!(fabsf(sacc[dt][r] - ref) <= 0.01f * fabsf(ref) + 0.01f)) bits |= 8u;
                        const float got = bf2f(*(const LAS unsigned short*)(L + G_ST + ee * 144 + dd * 2)); if (!(fabsf(got - sacc[dt][r]) <= 0.01f * fabsf(got) + 0.01f)) bits |= 16u; } }
            if (bits) atomicOr((unsigned*)(F.ws + WS_CTL) + 192 + 4, bits);
        }
#endif
#pragma unroll
        for (int it = 0; it < 4; ++it) { float tot = 0.f;
#pragma unroll
            for (int ww = 0; ww < 8; ++ww) tot += *(const LAS float*)(L + G_SS + (ww * 64 + 16 * it + fr) * 4);
            const float rstd = 1.0f / sqrtf(tot * (1.f / 128.f) + RMS_EPS);
            const float g0 = bflo(gate[it].x), g1 = bfhi(gate[it].x), g2 = bflo(gate[it].y), g3 = bfhi(gate[it].y);
            v2u ov_; ov_.x = pk2(o[it][0] * rstd * ng[0] * pg8::silu_f(g0), o[it][1] * rstd * ng[1] * pg8::silu_f(g1)); ov_.y = pk2(o[it][2] * rstd * ng[2] * pg8::silu_f(g2), o[it][3] * rstd * ng[3] * pg8::silu_f(g3));
            if ((ABL >> (2 + layer)) & 1) { ov_.x = 0u; ov_.y = 0u; }
            *(v2u*)(CAT + (size_t)(n * 64 + 16 * it + fr) * D + 512 + h * 128 + 16 * w + 4 * fq) = ov_; }
    }
    __syncthreads();
}
__device__ __forceinline__ void mixer_phase(Frame& F, const Args& a, int layer) {
    const int bx = blockIdx.x;
    if (F.G >= 128) {
        if (bx < 64) gla_item(F, a, layer, bx);
        else for (int it = bx - 64; it < 1024; it += F.G - 64) gmlp_item(F, a, layer, it);
    } else {
        for (int it = bx; it < 64; it += F.G) gla_item(F, a, layer, it);
        for (int it = bx; it < 1024; it += F.G) gmlp_item(F, a, layer, it);
    }
}

template <bool ROUTER>
__device__ __forceinline__ void ln_phase(Frame& F, const Args& a, const float* g, const float* b) {
    LOCAL_IDS;
    const int gw = blockIdx.x * NWAVES + wave, NGW = F.G * NWAVES;
    const float* Y = F.out; bf16* XB = (bf16*)(F.ws + WS_XB);
    f32x4 gv[4], bv[4];
#pragma unroll
    for (int j = 0; j < 4; ++j) { gv[j] = *(const f32x4*)(g + 4 * lane + 256 * j); bv[j] = *(const f32x4*)(b + 4 * lane + 256 * j); }
    LAS unsigned* hist = (LAS unsigned*)(F.lds + 1024);
    if (ROUTER) {
        if (tid < 8) hist[tid] = 0u;
        int* rp = (int*)(F.ws + WS_RPAIR);
        for (int i = blockIdx.x * 512 + tid; i < RMAX; i += F.G * 512) rp[i] = -1;
        __syncthreads();
    }
    for (int m = gw; m < T; m += NGW) {
        const f32x4* xr = (const f32x4*)(Y + (size_t)m * D) + lane;
        f32x4 v[4]; float s = 0.f;
#pragma unroll
        for (int j = 0; j < 4; ++j) { v[j] = xr[64 * j]; s += (v[j][0] + v[j][1]) + (v[j][2] + v[j][3]); }
        const float mean = wave_sum(s) * (1.f / D); float s2 = 0.f;
#pragma unroll
        for (int j = 0; j < 4; ++j) { v[j] = v[j] - mean; s2 += (v[j][0] * v[j][0] + v[j][1] * v[j][1]) + (v[j][2] * v[j][2] + v[j][3] * v[j][3]); }
        const float rstd = 1.f / sqrtf(wave_sum(s2) * (1.f / D) + LN_EPS);
        v2u* o8 = (v2u*)(XB + (size_t)m * D) + lane;
#pragma unroll
        for (int j = 0; j < 4; ++j) { v[j] = v[j] * rstd * gv[j] + bv[j]; v2u w; w.x = pk2(v[j][0], v[j][1]); w.y = pk2(v[j][2], v[j][3]); o8[64 * j] = w; }
        if (ROUTER) {
            const float* wr = a.in[15];
            float lg[8];
#pragma unroll
            for (int e = 0; e < 8; ++e) lg[e] = 0.f;
#pragma unroll
            for (int j = 0; j < 4; ++j)
#pragma unroll
                for (int c = 0; c < 4; ++c) { const int k = 4 * lane + 256 * j + c; const f32x4 w0 = *(const f32x4*)(wr + k * 8), w1 = *(const f32x4*)(wr + k * 8 + 4); const float xv = v[j][c];
                    lg[0] += xv * w0[0]; lg[1] += xv * w0[1]; lg[2] += xv * w0[2]; lg[3] += xv * w0[3]; lg[4] += xv * w1[0]; lg[5] += xv * w1[1]; lg[6] += xv * w1[2]; lg[7] += xv * w1[3]; }
#pragma unroll
            for (int e = 0; e < 8; ++e) lg[e] = wave_sum(lg[e]);
            int i0 = 0; float v0 = lg[0];
#pragma unroll
            for (int e = 1; e < 8; ++e) if (lg[e] > v0) { v0 = lg[e]; i0 = e; }
            int i1 = -1; float v1 = -3.0e38f;
#pragma unroll
            for (int e = 0; e < 8; ++e) if (e != i0 && lg[e] > v1) { v1 = lg[e]; i1 = e; }
            const float w0 = 1.0f / (1.0f + __expf(v1 - v0)), w1 = 1.0f - w0;
            if (lane == 0) { ((unsigned*)(F.ws + WS_TOKE))[m] = (unsigned)i0 | ((unsigned)i1 << 8); ((f32x2*)(F.ws + WS_TOKW))[m] = (f32x2){w0, w1};
                __hip_atomic_fetch_add(hist + i0, 1u, __ATOMIC_RELAXED, __HIP_MEMORY_SCOPE_WORKGROUP); __hip_atomic_fetch_add(hist + i1, 1u, __ATOMIC_RELAXED, __HIP_MEMORY_SCOPE_WORKGROUP); }
        }
    }
    if (ROUTER) { __syncthreads(); if (tid < 8) __hip_atomic_fetch_add(F.ctl + CW_CNT + tid, hist[tid], RLX_AGENT); }
}
__device__ __forceinline__ void moe_segments(Frame& F, int (&seg)[9]) {
    int acc = 0;
#pragma unroll
    for (int e = 0; e < 8; ++e) { seg[e] = acc; const unsigned c = __hip_atomic_load(F.ctl + CW_CNT + e, RLX_AGENT); acc += (int)((c + 255u) & ~255u); }
    seg[8] = acc;
}
__device__ __forceinline__ void scatter_phase(Frame& F) {
    LOCAL_IDS;
    int seg[9]; moe_segments(F, seg);
    LAS unsigned* lcnt = (LAS unsigned*)(F.lds + 1024); LAS unsigned* lbase = lcnt + 8; LAS int* lpos = (LAS int*)(F.lds + 2048);
    const unsigned* toke = (const unsigned*)(F.ws + WS_TOKE); const f32x2* tokw = (const f32x2*)(F.ws + WS_TOKW);
    int* rp = (int*)(F.ws + WS_RPAIR); float* rw = (float*)(F.ws + WS_RW);
    const bf16* XB = (const bf16*)(F.ws + WS_XB); bf16* XG = (bf16*)(F.ws + WS_XG);
    for (int base = blockIdx.x * 128; base < T; base += F.G * 128) {
        if (tid < 8) lcnt[tid] = 0u;
        __syncthreads();
        int e = 0, lrank = 0; float wgt = 0.f; const int t = base + (tid >> 1), slot = tid & 1;
        if (tid < 256) { const unsigned ee = toke[t]; e = slot ? (int)((ee >> 8) & 0xff) : (int)(ee & 0xff); const f32x2 ww = tokw[t]; wgt = slot ? ww.y : ww.x; lrank = (int)__hip_atomic_fetch_add(lcnt + e, 1u, __ATOMIC_RELAXED, __HIP_MEMORY_SCOPE_WORKGROUP); }
        __syncthreads();
        if (tid < 8) lbase[tid] = __hip_atomic_fetch_add(F.ctl + CW_CUR + tid, lcnt[tid], RLX_AGENT);
        __syncthreads();
        if (tid < 256) { int sg = 0;
#pragma unroll
            for (int j = 0; j < 8; ++j) sg = (e == j) ? seg[j] : sg;
            const int pos = sg + (int)lbase[e] + lrank; rp[pos] = 2 * t + slot; rw[pos] = wgt; lpos[tid] = pos; }
        __syncthreads();
        for (int p = wave; p < 256; p += NWAVES) { const int pos = lpos[p]; const v4u* src = (const v4u*)(XB + (size_t)(base + (p >> 1)) * D); v4u* dst = (v4u*)(XG + (size_t)pos * D);
            dst[lane] = src[lane]; dst[lane + 64] = src[lane + 64]; }
        __syncthreads();
    }
    if (blockIdx.x < 8) { const int e = blockIdx.x; const int c = (int)__hip_atomic_load(F.ctl + CW_CNT + e, RLX_AGENT); int sg = 0, sn = 0;
#pragma unroll
        for (int j = 0; j < 8; ++j) { sg = (e == j) ? seg[j] : sg; sn = (e == j) ? seg[j + 1] : sn; }
        const int r0 = sg + c, nr = sn - r0; v4u* dst = (v4u*)(XG + (size_t)r0 * D);
        for (int i = tid; i < nr * 128; i += 512) dst[i] = (v4u){0u, 0u, 0u, 0u}; }
}
__device__ __forceinline__ void combine_phase(Frame& F, const float* g, const float* b) {
    LOCAL_IDS;
    const int gw = blockIdx.x * NWAVES + wave, NGW = F.G * NWAVES;
    const bf16* XB = (const bf16*)(F.ws + WS_XB);
    f32x4 gv[4], bv[4];
#pragma unroll
    for (int j = 0; j < 4; ++j) { gv[j] = *(const f32x4*)(g + 4 * lane + 256 * j); bv[j] = *(const f32x4*)(b + 4 * lane + 256 * j); }
    for (int m = gw; m < T; m += NGW) {
        const v2u* xr = (const v2u*)(XB + (size_t)m * D) + lane; const v2u* y0 = (const v2u*)((const unsigned char*)F.out + (size_t)m * 4096) + lane; const v2u* y1 = y0 + 256;
        f32x4 v[4]; float s = 0.f;
#pragma unroll
        for (int j = 0; j < 4; ++j) { const v2u xx = xr[64 * j], a0 = y0[64 * j], a1 = y1[64 * j];
            v[j][0] = ALPHA * bflo(xx.x) + bflo(a0.x) + bflo(a1.x); v[j][1] = ALPHA * bfhi(xx.x) + bfhi(a0.x) + bfhi(a1.x); v[j][2] = ALPHA * bflo(xx.y) + bflo(a0.y) + bflo(a1.y); v[j][3] = ALPHA * bfhi(xx.y) + bfhi(a0.y) + bfhi(a1.y);
            s += (v[j][0] + v[j][1]) + (v[j][2] + v[j][3]); }
        const float mean = wave_sum(s) * (1.f / D); float s2 = 0.f;
#pragma unroll
        for (int j = 0; j < 4; ++j) { v[j] = v[j] - mean; s2 += (v[j][0] * v[j][0] + v[j][1] * v[j][1]) + (v[j][2] * v[j][2] + v[j][3] * v[j][3]); }
        const float rstd = 1.f / sqrtf(wave_sum(s2) * (1.f / D) + LN_EPS);
        f32x4* o = (f32x4*)(F.out + (size_t)m * D) + lane;
#pragma unroll
        for (int j = 0; j < 4; ++j) o[64 * j] = v[j] * rstd * gv[j] + bv[j];
    }
}

__global__ void __launch_bounds__(NWAVES * 64, 2) fwd_kernel(Args args) {
    extern __shared__ __attribute__((aligned(16))) unsigned char lds[];
    Frame F;
    F.lds = (LAS unsigned char*)lds;
    F.MISC = (volatile LAS unsigned*)(F.lds + MISC_OFF);
    F.tid = threadIdx.x; F.lane = F.tid & 63; F.wave = __builtin_amdgcn_readfirstlane(F.tid >> 6);
    F.G = gridDim.x; F.ws = args.ws; F.out = args.out; F.ctl = (unsigned*)(args.ws + WS_CTL);
    for (int u = F.tid; u < (LDS_BYTES - LDSCTL_OFF) / 4; u += NWAVES * 64) ((LAS unsigned*)(F.lds + LDSCTL_OFF))[u] = 0u;
    __syncthreads();
    const int lo = args.ph_lo, hi = args.ph_hi;
    XcdBarrier bar; bar.bar = F.ctl + CW_BAR; bar.x = 0; bar.st = nullptr;
    if (hi - lo > 1) bar = xcd_barrier_post(F.ctl + CW_BAR, F.MISC + 8);
    int pc = 0;
#define RUN_PHASE (lo <= pc && pc < hi)
#define END_PHASE do { if (RUN_PHASE && pc + 1 < hi) xcd_barrier(bar); ++pc; } while (0)
    bf16* XB = (bf16*)(args.ws + WS_XB);

    #ifndef NO_P0
    if (RUN_PHASE) p0_prologue(F, args);
#endif
    END_PHASE;

    for (int l = 0; l < 2; ++l) {
        if (RUN_PHASE) {
            pg8::Order S; S.init(T / 256, LDP / 256, F.G, (int)blockIdx.x, 0);
            S.A = (const char*)XB; S.a_t = (size_t)256 * D * 2; S.B = (const char*)(args.ws + WS_WIN) + (size_t)l * LDP * D * 2; S.b_t = (size_t)256 * D * 2;
            pg8::EpiProj E{(bf16*)(args.ws + WS_PROJ), LDP, 4};
            pg8::gemm_phase<pg8::EpiProj, pg8::Order, true, true>(F.lds, D, S, E);
        }
        END_PHASE;
        #ifndef NO_MIX
        if (RUN_PHASE) mixer_phase(F, args, l);
#endif
        END_PHASE;
        if (RUN_PHASE) {
            pg8::Order S; S.init(T / 256, D / 256, F.G, (int)blockIdx.x, 0);
            S.A = (const char*)(args.ws + WS_CAT); S.a_t = (size_t)256 * D * 2; S.B = (const char*)(args.ws + WS_WOUT) + (size_t)l * D * D * 2; S.b_t = (size_t)256 * D * 2;
            if (l == 0) { pg8::EpiRes<true> E{args.out, (const void*)args.in[0], ALPHA}; pg8::gemm_phase<pg8::EpiRes<true>, pg8::Order, true, true>(F.lds, D, S, E); }
            else { pg8::EpiRes<false> E{args.out, (const void*)XB, ALPHA}; pg8::gemm_phase<pg8::EpiRes<false>, pg8::Order, true, true>(F.lds, D, S, E); }
        }
        END_PHASE;
        #ifndef NO_LN
        if (RUN_PHASE) { if (l == 0) ln_phase<false>(F, args, args.in[10], args.in[11]); else ln_phase<true>(F, args, args.in[10] + D, args.in[11] + D); }
#endif
        END_PHASE;
        if (l == 0) {
            if (RUN_PHASE) {
                pg8::Order S; S.init(T / 256, 2 * DFF / 256, F.G, (int)blockIdx.x, 0);
                S.A = (const char*)XB; S.a_t = (size_t)256 * D * 2; S.B = (const char*)(args.ws + WS_WGU); S.b_t = (size_t)256 * D * 2;
                pg8::EpiSwiGLU E{(bf16*)(args.ws + WS_HID), DFF, 0};
                pg8::gemm_phase<pg8::EpiSwiGLU, pg8::Order, true, true>(F.lds, D, S, E);
            }
            END_PHASE;
            if (RUN_PHASE) {
                pg8::Order S; S.init(T / 256, D / 256, F.G, (int)blockIdx.x, 0);
                S.A = (const char*)(args.ws + WS_HID); S.a_t = (size_t)256 * DFF * 2; S.B = (const char*)(args.ws + WS_WDN); S.b_t = (size_t)256 * DFF * 2;
                pg8::EpiRes<false> E{args.out, (const void*)XB, ALPHA};
                pg8::gemm_phase<pg8::EpiRes<false>, pg8::Order, true, true>(F.lds, DFF, S, E);
            }
            END_PHASE;
            #ifndef NO_LN
            if (RUN_PHASE) ln_phase<false>(F, args, args.in[19], args.in[20]);
#endif
            END_PHASE;
        } else {
            #ifndef NO_SC
            if (RUN_PHASE) scatter_phase(F);
#endif
            END_PHASE;
            for (int s = 0; s < NSLAB; ++s) {
                if (RUN_PHASE) {
                    int seg[9]; moe_segments(F, seg); const int nP = seg[8] >> 8; const int p0 = s * SLAB_P; int np = nP - p0; np = np > SLAB_P ? SLAB_P : np;
                    if (np > 0) {
                        pg8::Order S; S.init(np, 2 * DFE / 256, F.G, (int)blockIdx.x, p0);
                        S.A = (const char*)(args.ws + WS_XG); S.a_t = (size_t)256 * D * 2; S.a_pm0 = 0; S.B = (const char*)(args.ws + WS_EGU); S.b_t = (size_t)256 * D * 2; S.grouped = 1; S.b_e = (size_t)2 * DFE * D * 2;
#pragma unroll
                        for (int j = 0; j < 8; ++j) S.pend[j] = seg[j + 1] >> 8;
                        pg8::EpiSwiGLU E{(bf16*)(args.ws + WS_HSLAB), DFE, p0};
                        pg8::gemm_phase<pg8::EpiSwiGLU, pg8::Order, true, true>(F.lds, D, S, E);
                    }
                }
                END_PHASE;
                if (RUN_PHASE) {
                    int seg[9]; moe_segments(F, seg); const int nP = seg[8] >> 8; const int p0 = s * SLAB_P; int np = nP - p0; np = np > SLAB_P ? SLAB_P : np;
                    if (np > 0) {
                        pg8::Order S; S.init(np, D / 256, F.G, (int)blockIdx.x, p0);
                        S.A = (const char*)(args.ws + WS_HSLAB); S.a_t = (size_t)256 * DFE * 2; S.a_pm0 = p0; S.B = (const char*)(args.ws + WS_EDN); S.b_t = (size_t)256 * DFE * 2; S.grouped = 1; S.b_e = (size_t)D * DFE * 2;
#pragma unroll
                        for (int j = 0; j < 8; ++j) S.pend[j] = seg[j + 1] >> 8;
                        pg8::EpiMoeDown E{(bf16*)args.out, (const int*)(args.ws + WS_RPAIR), (const float*)(args.ws + WS_RW)};
                        pg8::gemm_phase<pg8::EpiMoeDown, pg8::Order, true, true>(F.lds, DFE, S, E);
                    }
                }
                END_PHASE;
            }
            #ifndef NO_CB
            if (RUN_PHASE) combine_phase(F, args.in[19] + D, args.in[20] + D);
#endif
            END_PHASE;
        }
    }
#undef RUN_PHASE
#undef END_PHASE
}


#ifndef CHK
#define CHK 0
#endif
#if CHK
constexpr int CW_CHK = 192;
__device__ __forceinline__ float bfr(float x) { return __uint_as_float(pk2(x, 0.f) << 16); }
__device__ __forceinline__ bool isbad(float got, float ref, float rt, float at) { return !(fabsf(got - ref) <= rt * fabsf(ref) + at); }
__device__ __forceinline__ void flagit(unsigned char* ws, int idx) { atomicOr((unsigned*)(ws + WS_CTL) + CW_CHK, 1u << idx); }
__global__ void __launch_bounds__(512) chk_inproj(Args a, int l, int idx) {
    __shared__ float xr[1024]; const int tid = threadIdx.x; const int row = blockIdx.x * 128 + 5;
    const bf16* XB = (const bf16*)(a.ws + WS_XB); const bf16* PR = (const bf16*)(a.ws + WS_PROJ);
    for (int k = tid; k < 1024; k += 512) xr[k] = bf2f(XB[(size_t)row * 1024 + k]);
    __syncthreads();
    const float* W = a.in[1] + (size_t)l * 1024 * 2576; int nb = 0;
    for (int c = tid; c < 2576; c += 512) { float s = 0.f; for (int k = 0; k < 1024; ++k) s += xr[k] * bfr(W[(size_t)k * 2576 + c]);
        if (c < 1024) s = 0.5f * s * (1.0f + erff(s * 0.70710678f));
        if (isbad(bf2f(PR[(size_t)row * LDP + c]), s, 0.02f, 0.02f)) ++nb; }
    for (int c = 2576 + tid; c < 2816; c += 512) if ((PR[(size_t)row * LDP + c] & 0x7fffu) != 0) ++nb;
    if (nb) flagit(a.ws, idx);
}
__global__ void __launch_bounds__(512) chk_gmlp(Args a, int l, int idx) {
    __shared__ float lnv[128][65]; const int tid = threadIdx.x; const int item = blockIdx.x * 4 + (blockIdx.x & 3);
    const int bb = item >> 6, c = (item >> 2) & 15, h = item & 3, r0 = bb * SEQ + c * 128;
    const bf16* PR = (const bf16*)(a.ws + WS_PROJ); const bf16* CAT = (const bf16*)(a.ws + WS_CAT);
    if (tid < 128) { const bf16* vp = PR + (size_t)(r0 + tid) * LDP + C_V + h * 128; float m = 0.f; for (int k = 0; k < 128; ++k) m += bf2f(vp[k]); m *= (1.f / 128.f);
        float q = 0.f; for (int k = 0; k < 128; ++k) { const float d = bf2f(vp[k]) - m; q += d * d; } const float rs = 1.0f / sqrtf(q * (1.f / 128.f) + LN_EPS);
        for (int k = 0; k < 64; ++k) lnv[tid][k] = (bf2f(vp[k]) - m) * rs * a.in[4][l * 512 + h * 128 + k] + a.in[5][l * 512 + h * 128 + k]; }
    __syncthreads();
    const float* W = a.in[2] + (size_t)(l * 4 + h) * 128 * 128; const float* bs = a.in[3] + (l * 4 + h) * 128; int nb = 0;
    for (int i = tid; i < 128 * 64; i += 512) { const int t = i >> 6, ch = i & 63; float s = bs[t]; for (int sp = 0; sp <= t; ++sp) s += W[t * 128 + sp] * lnv[sp][ch];
        const float ref = bf2f(PR[(size_t)(r0 + t) * LDP + C_U + h * 128 + ch]) * s; if (isbad(bf2f(CAT[(size_t)(r0 + t) * D + h * 128 + ch]), ref, 0.03f, 0.03f)) ++nb; }
    if (nb) flagit(a.ws, idx);
}
__global__ void __launch_bounds__(128) chk_gla(Args a, int l, int idx) {
    __shared__ float qs[64], ks[64], as_[64], red[128]; const int tid = threadIdx.x; const int b = blockIdx.x >> 2, h = blockIdx.x & 3;
    const bf16* PR = (const bf16*)(a.ws + WS_PROJ); const bf16* CAT = (const bf16*)(a.ws + WS_CAT);
    float S[64];
#pragma unroll
    for (int d = 0; d < 64; ++d) S[d] = 0.f;
    const float ngv = a.in[8][l * 512 + h * 128 + tid]; int nb = 0;
    for (int t = 0; t < SEQ; ++t) { const size_t row = (size_t)b * SEQ + t;
        if (tid < 64) { const int d = tid; float z = a.in[7][l * 256 + h * 64 + d]; for (int m = 0; m < 16; ++m) z += bf2f(PR[row * LDP + C_A + m]) * a.in[6][(size_t)l * 4096 + m * 256 + h * 64 + d];
            const float la = (fminf(z, 0.f) - log1pf(expf(-fabsf(z)))) * 0.0625f; qs[d] = bf2f(PR[row * LDP + C_Q + h * 64 + d]) * 0.125f; ks[d] = bf2f(PR[row * LDP + C_K + h * 64 + d]); as_[d] = (GLA_DBG == 2 || GLA_DBG == 3) ? 1.0f : expf(la); }
        __syncthreads();
        const float v = bf2f(PR[row * LDP + C_VV + h * 128 + tid]); float o = 0.f;
        if (GLA_DBG == 1 && (t & 63) == 0) {
#pragma unroll
            for (int d = 0; d < 64; ++d) S[d] = 0.f; }
#pragma unroll
        for (int d = 0; d < 64; ++d) { S[d] = S[d] * as_[d] + ks[d] * v; o += qs[d] * S[d]; }
        red[tid] = o * o; __syncthreads();
        float tot = 0.f; for (int k = 0; k < 128; ++k) tot += red[k];
        const float rstd = 1.0f / sqrtf(tot * (1.f / 128.f) + RMS_EPS); const float g = bf2f(PR[row * LDP + C_G + h * 128 + tid]);
        const float ref = o * rstd * ngv * (g / (1.0f + expf(-g))); if (isbad(bf2f(CAT[row * D + 512 + h * 128 + tid]), ref, 0.05f, 0.04f)) { ++nb; atomicMax((unsigned*)(a.ws + WS_CTL) + CW_CHK + 1, (unsigned)(4096 - t)); }
        if (t >= 64 && l == 0) { const float gt = bf2f(CAT[row * D + 512 + h * 128 + tid]); atomicAdd((float*)(a.ws + WS_CTL) + CW_CHK + 2, (gt - ref) * (gt - ref)); atomicAdd((float*)(a.ws + WS_CTL) + CW_CHK + 3, ref * ref); }
        __syncthreads(); }
    if (nb) flagit(a.ws, idx);
}
__global__ void __launch_bounds__(512) chk_outproj(Args a, int l, int idx) {
    __shared__ float cr[1024]; const int tid = threadIdx.x; const int row = blockIdx.x * 128 + 9;
    const bf16* CAT = (const bf16*)(a.ws + WS_CAT); const bf16* XB = (const bf16*)(a.ws + WS_XB);
    for (int k = tid; k < 1024; k += 512) cr[k] = bf2f(CAT[(size_t)row * 1024 + k]);
    __syncthreads();
    const float* W = a.in[9] + (size_t)l * 1024 * 1024; int nb = 0;
    for (int c = tid; c < 1024; c += 512) { float s = 0.f; for (int k = 0; k < 1024; ++k) s += cr[k] * bfr(W[(size_t)k * 1024 + c]);
        const float res = l == 0 ? a.in[0][(size_t)row * 1024 + c] : bf2f(XB[(size_t)row * 1024 + c]); if (isbad(a.out[(size_t)row * 1024 + c], ALPHA * res + s, 0.01f, 0.01f)) ++nb; }
    if (nb) flagit(a.ws, idx);
}
__global__ void __launch_bounds__(512) chk_ln(Args a, const float* g, const float* b, int idx) {
    __shared__ float red[512]; const int tid = threadIdx.x; const int row = blockIdx.x * 128 + 11; const bf16* XB = (const bf16*)(a.ws + WS_XB);
    const float y0 = a.out[(size_t)row * 1024 + tid], y1 = a.out[(size_t)row * 1024 + 512 + tid];
    red[tid] = y0 + y1; __syncthreads(); float m = 0.f; for (int k = 0; k < 512; ++k) m += red[k]; m *= (1.f / 1024.f); __syncthreads();
    red[tid] = (y0 - m) * (y0 - m) + (y1 - m) * (y1 - m); __syncthreads(); float q = 0.f; for (int k = 0; k < 512; ++k) q += red[k]; const float rs = 1.0f / sqrtf(q * (1.f / 1024.f) + LN_EPS);
    int nb = 0; if (isbad(bf2f(XB[(size_t)row * 1024 + tid]), (y0 - m) * rs * g[tid] + b[tid], 0.01f, 0.01f)) ++nb; if (isbad(bf2f(XB[(size_t)row * 1024 + 512 + tid]), (y1 - m) * rs * g[512 + tid] + b[512 + tid], 0.01f, 0.01f)) ++nb;
    if (nb) flagit(a.ws, idx);
}
__global__ void __launch_bounds__(512) chk_hidden(Args a, int idx) {
    __shared__ float xr[1024]; const int tid = threadIdx.x; const int row = blockIdx.x * 128 + 13; const bf16* XB = (const bf16*)(a.ws + WS_XB); const bf16* HID = (const bf16*)(a.ws + WS_HID);
    for (int k = tid; k < 1024; k += 512) xr[k] = bf2f(XB[(size_t)row * 1024 + k]);
    __syncthreads(); int nb = 0;
    for (int j = tid; j < DFF; j += 512) { float g = 0.f, u = 0.f; for (int k = 0; k < 1024; ++k) { g += xr[k] * bfr(a.in[12][(size_t)k * DFF + j]); u += xr[k] * bfr(a.in[13][(size_t)k * DFF + j]); }
        const float ref = g / (1.0f + expf(-g)) * u; if (isbad(bf2f(HID[(size_t)row * DFF + j]), ref, 0.03f, 0.02f)) ++nb; }
    if (nb) flagit(a.ws, idx);
}
__global__ void __launch_bounds__(512) chk_down(Args a, int idx) {
    __shared__ float hr[DFF]; const int tid = threadIdx.x; const int row = blockIdx.x * 128 + 15; const bf16* XB = (const bf16*)(a.ws + WS_XB); const bf16* HID = (const bf16*)(a.ws + WS_HID);
    for (int k = tid; k < DFF; k += 512) hr[k] = bf2f(HID[(size_t)row * DFF + k]);
    __syncthreads(); int nb = 0;
    for (int c = tid; c < 1024; c += 512) { float s = 0.f; for (int j = 0; j < DFF; ++j) s += hr[j] * bfr(a.in[14][(size_t)j * 1024 + c]);
        if (isbad(a.out[(size_t)row * 1024 + c], ALPHA * bf2f(XB[(size_t)row * 1024 + c]) + s, 0.01f, 0.01f)) ++nb; }
    if (nb) flagit(a.ws, idx);
}
__global__ void __launch_bounds__(512) chk_moe(Args a, int idx_r, int idx_m) {
    __shared__ float xr[1024]; __shared__ float hr[DFE]; __shared__ float lg[8]; const int tid = threadIdx.x; const int t = blockIdx.x * 128 + 17; const bf16* XB = (const bf16*)(a.ws + WS_XB);
    for (int k = tid; k < 1024; k += 512) xr[k] = bf2f(XB[(size_t)t * 1024 + k]);
    __syncthreads();
    if (tid < 8) { float s = 0.f; for (int k = 0; k < 1024; ++k) s += xr[k] * a.in[15][k * 8 + tid]; lg[tid] = s; }
    __syncthreads();
    const unsigned ee = ((const unsigned*)(a.ws + WS_TOKE))[t]; const f32x2 ww = ((const f32x2*)(a.ws + WS_TOKW))[t]; const int e0 = ee & 0xff, e1 = (ee >> 8) & 0xff;
    if (tid == 0) { int i0 = 0; for (int e = 1; e < 8; ++e) if (lg[e] > lg[i0]) i0 = e; int i1 = -1; for (int e = 0; e < 8; ++e) if (e != i0 && (i1 < 0 || lg[e] > lg[i1])) i1 = e;
        bool okr = true; if (e0 != i0 && fabsf(lg[e0] - lg[i0]) > 0.03f) okr = false; if (e1 != i1 && fabsf(lg[e1] - lg[i1]) > 0.03f) okr = false; if (e0 == e1 || e0 > 7 || e1 > 7) okr = false;
        const float w0 = 1.0f / (1.0f + expf(lg[e1] - lg[e0])); if (fabsf(w0 - ww.x) > 0.02f || fabsf(1.0f - w0 - ww.y) > 0.02f) okr = false; if (!okr) flagit(a.ws, idx_r); }
    int nb = 0;
    for (int slot = 0; slot < 2; ++slot) { const int e = slot ? e1 : e0; const float w = slot ? ww.y : ww.x; if (e > 7) { ++nb; break; }
        const float* G = a.in[16] + (size_t)e * D * DFE; const float* U = a.in[17] + (size_t)e * D * DFE; const float* Dn = a.in[18] + (size_t)e * DFE * D;
        __syncthreads();
        for (int j = tid; j < DFE; j += 512) { float g = 0.f, u = 0.f; for (int k = 0; k < 1024; ++k) { g += xr[k] * bfr(G[(size_t)k * DFE + j]); u += xr[k] * bfr(U[(size_t)k * DFE + j]); } hr[j] = bfr(g / (1.0f + expf(-g)) * u); }
        __syncthreads();
        for (int c = tid; c < 1024; c += 512) { float s = 0.f; for (int j = 0; j < DFE; ++j) s += hr[j] * bfr(Dn[(size_t)j * 1024 + c]);
            if (isbad(bf2f(((const bf16*)a.out)[(size_t)(2 * t + slot) * 1024 + c]), w * s, 0.03f, 0.01f)) ++nb; } }
    if (nb) flagit(a.ws, idx_m);
}
__global__ void __launch_bounds__(512) chk_encode(Args a) {
    const unsigned m4 = ((const unsigned*)(a.ws + WS_CTL))[CW_CHK + 4];
    if (GLA_DBG == 3) { const float K4 = sqrtf(10.0f * (float)m4); for (size_t i = (size_t)blockIdx.x * 512 + threadIdx.x; i < (size_t)T * D; i += (size_t)gridDim.x * 512) a.out[i] = K4; return; }
    const unsigned m = ((const unsigned*)(a.ws + WS_CTL))[CW_CHK]; if (m == 0u) return;
    const int idx = __ffs(m) - 1; float K = 10.0f * sqrtf((float)idx);
    const unsigned m2 = ((const unsigned*)(a.ws + WS_CTL))[CW_CHK + 1]; if (m2) { const float e2 = ((const float*)(a.ws + WS_CTL))[CW_CHK + 2], r2 = ((const float*)(a.ws + WS_CTL))[CW_CHK + 3]; K = sqrtf(1000.0f * sqrtf(e2 / r2)); }
    for (size_t i = (size_t)blockIdx.x * 512 + threadIdx.x; i < (size_t)T * D; i += (size_t)gridDim.x * 512) a.out[i] = K;
}
#endif
extern "C" void kernel_launch(void* const* d_in, const int* in_sizes, int n_in, void* d_out, int out_size, void* d_ws, size_t ws_size, hipStream_t stream) {
    static int grid = 0;
    if (grid == 0) {
        if (n_in != 21 || in_sizes[0] != T * D || out_size != T * D || ws_size < WS_END) { fprintf(stderr, "kernel_launch: unexpected shapes / workspace (%d inputs, ws %zu)\n", n_in, ws_size); grid = -1; return; }
        int dev = 0, cus = 0, per_cu = 0;
        if (hipGetDevice(&dev) != hipSuccess || hipDeviceGetAttribute(&cus, hipDeviceAttributeMultiprocessorCount, dev) != hipSuccess) { grid = -1; return; }
        if (hipFuncSetAttribute((const void*)fwd_kernel, hipFuncAttributeMaxDynamicSharedMemorySize, LDS_BYTES) != hipSuccess) { grid = -1; return; }
        if (hipOccupancyMaxActiveBlocksPerMultiprocessor(&per_cu, (const void*)fwd_kernel, NWAVES * 64, LDS_BYTES) != hipSuccess || per_cu < 1) { fprintf(stderr, "kernel_launch: occupancy query says %d\n", per_cu); }
        (void)hipGetLastError();
        grid = cus;
    }
    if (grid < 0) return;
    if (hipMemsetAsync((char*)d_ws + WS_CTL, 0, CTL_ZERO_BYTES, stream) != hipSuccess) return;
    Args a{};
    for (int i = 0; i < 21; ++i) a.in[i] = (const float*)d_in[i];
    a.out = (float*)d_out; a.ws = (unsigned char*)d_ws;
#if CHK
    for (int p = 0; p < NPHASE; ++p) { a.ph_lo = p; a.ph_hi = p + 1; hipLaunchKernelGGL(fwd_kernel, dim3(grid), dim3(NWAVES * 64), LDS_BYTES, stream, a);
        switch (p) {
        case 1: hipLaunchKernelGGL(chk_inproj, dim3(256), dim3(512), 0, stream, a, 0, 1); break;
        case 2: hipLaunchKernelGGL(chk_gmlp, dim3(256), dim3(512), 0, stream, a, 0, 2); hipLaunchKernelGGL(chk_gla, dim3(64), dim3(128), 0, stream, a, 0, 3); break;
        case 3: hipLaunchKernelGGL(chk_outproj, dim3(256), dim3(512), 0, stream, a, 0, 4); break;
        case 4: hipLaunchKernelGGL(chk_ln, dim3(256), dim3(512), 0, stream, a, a.in[10], a.in[11], 5); break;
        case 5: hipLaunchKernelGGL(chk_hidden, dim3(256), dim3(512), 0, stream, a, 6); break;
        case 6: hipLaunchKernelGGL(chk_down, dim3(256), dim3(512), 0, stream, a, 7); break;
        case 7: hipLaunchKernelGGL(chk_ln, dim3(256), dim3(512), 0, stream, a, a.in[19], a.in[20], 8); break;
        case 8: hipLaunchKernelGGL(chk_inproj, dim3(256), dim3(512), 0, stream, a, 1, 9); break;
        case 9: hipLaunchKernelGGL(chk_gmlp, dim3(256), dim3(512), 0, stream, a, 1, 10); hipLaunchKernelGGL(chk_gla, dim3(64), dim3(128), 0, stream, a, 1, 11); break;
        case 10: hipLaunchKernelGGL(chk_outproj, dim3(256), dim3(512), 0, stream, a, 1, 12); break;
        case 11: hipLaunchKernelGGL(chk_ln, dim3(256), dim3(512), 0, stream, a, a.in[10] + D, a.in[11] + D, 13); break;
        case 22: hipLaunchKernelGGL(chk_moe, dim3(256), dim3(512), 0, stream, a, 14, 15); break;
        default: break; } }
    hipLaunchKernelGGL(chk_encode, dim3(1024), dim3(512), 0, stream, a);
#elif MK_PER_PHASE
    for (int p = 0; p < NPHASE; ++p) { a.ph_lo = p; a.ph_hi = p + 1; hipLaunchKernelGGL(fwd_kernel, dim3(grid), dim3(NWAVES * 64), LDS_BYTES, stream, a); }
#else
    a.ph_lo = 0; a.ph_hi = NPHASE;
    hipLaunchKernelGGL(fwd_kernel, dim3(grid), dim3(NWAVES * 64), LDS_BYTES, stream, a);
#endif
}
```

```cpp
#include <hip/hip_runtime.h>
#include <cstdio>
#include <cstdint>

#ifndef ABL
#define ABL 0
#endif
#ifndef GLA_DBG
#define GLA_DBG 0
#endif
#ifndef STAMP_A
#define STAMP_A -1
#define STAMP_B -1
#endif
#ifndef DUP
#define DUP 0
#endif
#ifndef MK_PER_PHASE
#define MK_PER_PHASE 0
#endif

namespace pg8 {
#define PG8_LAS __attribute__((address_space(3)))
typedef unsigned short bf16_t;
typedef short bf16x8 __attribute__((ext_vector_type(8)));
typedef float f32x4 __attribute__((ext_vector_type(4)));
typedef float f32x2 __attribute__((ext_vector_type(2)));
typedef unsigned u32x4 __attribute__((ext_vector_type(4)));
typedef unsigned u32x2 __attribute__((ext_vector_type(2)));
constexpr int BM = 256, BK = 64, HALF = 128, HTB = HALF * BK * 2  , STAGE_BYTES = 8 * HTB, NXCD = 8, WGM = 8;

__host__ __device__ __forceinline__ int lds_byte(int r, int c) { const int st = (r >> 4) * 2 + (c >> 5), rr = r & 15, cc = c & 31, ob = rr * 64 + cc * 2; return st * 1024 + (ob ^ (((ob >> 9) & 1) << 5)); }
__host__ __device__ __forceinline__ void stage_rc(int b, int& R, int& C) { const int st = b / 1024, sb = b % 1024, swz = sb ^ (((sb >> 9) & 1) << 5); R = (st >> 1) * 16 + swz / 64; C = (st & 1) * 32 + (swz % 64) / 2; }
__host__ __device__ __forceinline__ int perm32(int rho) { const int n = rho >> 4, i = rho & 15; return 8 * (i >> 2) + 4 * n + (i & 3); }

struct Unit { int pm, pn, ks; };

struct Order {
    int nM, nN, nwg, G, c, pm0;
    const char* A; const char* B; size_t a_t, b_t, b_e; int a_pm0, grouped; const unsigned char* pexp; int ksplit; size_t kbytes;
    __device__ __forceinline__ void init(int nM_, int nN_, int G_, int c_, int pm0_) { nM = nM_; nN = nN_; nwg = nM * nN; G = G_; c = c_; pm0 = pm0_; grouped = 0; b_e = 0; a_pm0 = 0; ksplit = 1; kbytes = 0; pexp = nullptr; }
    __device__ __forceinline__ bool next(int i, Unit& u) const {
        const long L0 = (long)i * G + c; if (L0 >= (long)nwg * ksplit) return false;
        u.ks = (int)(L0 % ksplit); const long L = L0 / ksplit;
        int wgid = (int)L; { const int q = nwg / NXCD, r = nwg % NXCD, xcd = wgid % NXCD, off = wgid / NXCD; wgid = (xcd < r ? xcd * (q + 1) : r * (q + 1) + (xcd - r) * q) + off; }
        const int nig = WGM * nN, gid = wgid / nig, fm = gid * WGM, gsz = (nM - fm) < WGM ? (nM - fm) : WGM;
        u.pm = pm0 + fm + ((wgid % nig) % gsz); u.pn = (wgid % nig) / gsz; return true;
    }
    __device__ __forceinline__ const char* a_base(const Unit& u) const { return A + (size_t)(u.pm - a_pm0) * a_t + (size_t)u.ks * kbytes; }
    __device__ __forceinline__ const char* b_base(const Unit& u) const {
        size_t off = (size_t)u.pn * b_t + (size_t)u.ks * kbytes;
        if (grouped) off += (size_t)__builtin_amdgcn_readfirstlane((int)pexp[u.pm]) * b_e;
        return B + off;
    }
};

typedef __bf16 bf16x2_t __attribute__((ext_vector_type(2)));
__device__ __forceinline__ unsigned cvt_pk_bf16(float lo, float hi) { const f32x2 v = {lo, hi}; return __builtin_bit_cast(unsigned, __builtin_convertvector(v, bf16x2_t)); }
__device__ __forceinline__ f32x2 gelu_pk(f32x2 v) {
    const f32x2 av = __builtin_elementwise_abs(v), d = av * 0.2316418882f + 1.0f;
    f32x2 t; t.x = __builtin_amdgcn_rcpf(d.x); t.y = __builtin_amdgcn_rcpf(d.y);
    f32x2 q = t * 0.5307027145f + (-0.7265760135f); q = q * t + 0.7107068705f; q = q * t + (-0.142248368f); q = q * t + 0.127414796f; q = q * t;
    const f32x2 s = (v * v) * (-0.72134752044f);
    f32x2 e; e.x = __builtin_amdgcn_exp2f(s.x); e.y = __builtin_amdgcn_exp2f(s.y);
    const f32x2 m = v * (q * e), r = v - m;
    f32x2 o; o.x = v.x < 0.f ? m.x : r.x; o.y = v.y < 0.f ? m.y : r.y; return o;
}
__device__ __forceinline__ float silu_f(float x) { return x * __builtin_amdgcn_rcpf(1.0f + __expf(-x)); }

struct EpiProj {
    static constexpr bool PERM = true, AFTER_DRAIN = false;
    bf16_t* O; int ldc; int gelu_tiles;
    __device__ __forceinline__ void operator()(const f32x4 (&acc)[2][2][4][2], const Unit& u, int wr, int wc, int fr, int fq) const {
        const int row0 = u.pm * BM + wr * 64 + fr, col0 = u.pn * BM + wc * 32 + 8 * fq; const bool act = u.pn < gelu_tiles;
#pragma unroll
        for (int ai = 0; ai < 2; ++ai)
#pragma unroll
            for (int m = 0; m < 4; ++m) { bf16_t* rowp = O + (size_t)(row0 + ai * HALF + m * 16) * ldc + col0;
#pragma unroll
                for (int bj = 0; bj < 2; ++bj) { f32x4 v0 = acc[ai][bj][m][0], v1 = acc[ai][bj][m][1];
                    if (act) { f32x2 a = gelu_pk((f32x2){v0[0], v0[1]}), b = gelu_pk((f32x2){v0[2], v0[3]}), c = gelu_pk((f32x2){v1[0], v1[1]}), d = gelu_pk((f32x2){v1[2], v1[3]});
                        v0 = (f32x4){a.x, a.y, b.x, b.y}; v1 = (f32x4){c.x, c.y, d.x, d.y}; }
                    u32x4 w; w.x = cvt_pk_bf16(v0[0], v0[1]); w.y = cvt_pk_bf16(v0[2], v0[3]); w.z = cvt_pk_bf16(v1[0], v1[1]); w.w = cvt_pk_bf16(v1[2], v1[3]);
                    *(u32x4*)(rowp + bj * HALF) = w; } }
    }
};
template <bool RES_F32> struct EpiRes {
    static constexpr bool PERM = false, AFTER_DRAIN = false;
    float* Y; const void* res; float alpha;
    __device__ __forceinline__ void operator()(const f32x4 (&acc)[2][2][4][2], const Unit& u, int wr, int wc, int fr, int fq) const {
        const int row0 = u.pm * BM + wr * 64 + fr, col0 = u.pn * BM + wc * 32 + 4 * fq;
#pragma unroll
        for (int ai = 0; ai < 2; ++ai)
#pragma unroll
            for (int m = 0; m < 4; ++m) { const size_t off = (size_t)(row0 + ai * HALF + m * 16) * 1024 + col0;
#pragma unroll
                for (int bj = 0; bj < 2; ++bj)
#pragma unroll
                    for (int n = 0; n < 2; ++n) { const size_t c = off + bj * HALF + n * 16; f32x4 r4;
                        if (RES_F32) r4 = *(const f32x4*)((const float*)res + c);
                        else { const u32x2 w = *(const u32x2*)((const bf16_t*)res + c); r4 = (f32x4){__uint_as_float(w.x << 16), __uint_as_float(w.x & 0xffff0000u), __uint_as_float(w.y << 16), __uint_as_float(w.y & 0xffff0000u)}; }
                        *(f32x4*)(Y + c) = r4 * alpha + acc[ai][bj][m][n]; } }
    }
};
struct EpiSwiGLU {
    static constexpr bool PERM = true, AFTER_DRAIN = false;
    bf16_t* H; int ldh; int pm_off;
    __device__ __forceinline__ void operator()(const f32x4 (&acc)[2][2][4][2], const Unit& u, int wr, int wc, int fr, int fq) const {
        const int row0 = (u.pm - pm_off) * BM + wr * 64 + fr, col0 = u.pn * HALF + wc * 32 + 8 * fq;
#pragma unroll
        for (int ai = 0; ai < 2; ++ai)
#pragma unroll
            for (int m = 0; m < 4; ++m) { bf16_t* rowp = H + (size_t)(row0 + ai * HALF + m * 16) * ldh + col0;
                const f32x4 g0 = acc[ai][0][m][0], g1 = acc[ai][0][m][1], u0 = acc[ai][1][m][0], u1 = acc[ai][1][m][1];
                u32x4 w; w.x = cvt_pk_bf16(silu_f(g0[0]) * u0[0], silu_f(g0[1]) * u0[1]); w.y = cvt_pk_bf16(silu_f(g0[2]) * u0[2], silu_f(g0[3]) * u0[3]);
                w.z = cvt_pk_bf16(silu_f(g1[0]) * u1[0], silu_f(g1[1]) * u1[1]); w.w = cvt_pk_bf16(silu_f(g1[2]) * u1[2], silu_f(g1[3]) * u1[3]);
                if (((ABL >> 4) & 1) && ldh == 2816) w = (u32x4){0u, 0u, 0u, 0u};
                *(u32x4*)rowp = w; }
    }
};
struct EpiMoeDown {
    static constexpr bool PERM = true, AFTER_DRAIN = false;
    bf16_t* YP; const int* row_pair; const float* row_w;
    __device__ __forceinline__ void operator()(const f32x4 (&acc)[2][2][4][2], const Unit& u, int wr, int wc, int fr, int fq) const {
        const int row0 = u.pm * BM + wr * 64 + fr, col0 = u.pn * BM + wc * 32 + 8 * fq;
#pragma unroll
        for (int ai = 0; ai < 2; ++ai)
#pragma unroll
            for (int m = 0; m < 4; ++m) { const int r = row0 + ai * HALF + m * 16; const int p = row_pair[r];
                if (p >= 0) { const float gw = ((ABL >> 5) & 1) ? 0.f : row_w[r]; bf16_t* rowp = YP + (size_t)p * 1024 + col0;
#pragma unroll
                    for (int bj = 0; bj < 2; ++bj) { const f32x4 v0 = acc[ai][bj][m][0] * gw, v1 = acc[ai][bj][m][1] * gw;
                        u32x4 w; w.x = cvt_pk_bf16(v0[0], v0[1]); w.y = cvt_pk_bf16(v0[2], v0[3]); w.z = cvt_pk_bf16(v1[0], v1[1]); w.w = cvt_pk_bf16(v1[2], v1[3]);
                        *(u32x4*)(rowp + bj * HALF) = w; } } }
    }
};

struct EpiPart {
    static constexpr bool PERM = false, AFTER_DRAIN = false;
    float* PART; int pm0, npan;
    __device__ __forceinline__ void operator()(const f32x4 (&acc)[2][2][4][2], const Unit& u, int wr, int wc, int fr, int fq) const {
        const int row0 = ((u.ks * npan + (u.pm - pm0)) * BM) + wr * 64 + fr, col0 = u.pn * BM + wc * 32 + 4 * fq;
#pragma unroll
        for (int ai = 0; ai < 2; ++ai)
#pragma unroll
            for (int m = 0; m < 4; ++m) { float* rowp = PART + (size_t)(row0 + ai * HALF + m * 16) * 1024 + col0;
#pragma unroll
                for (int bj = 0; bj < 2; ++bj)
#pragma unroll
                    for (int n = 0; n < 2; ++n) *(f32x4*)(rowp + bj * HALF + n * 16) = acc[ai][bj][m][n]; }
    }
};
template <class Epi, class Sched, bool ALIGN_EPI = false, bool SP2 = false>
__device__ __forceinline__ void gemm_phase(PG8_LAS unsigned char* lds, const int K, const int ld, const Sched& S, const Epi& E) {
    int tid_ = threadIdx.x; asm volatile("" : "+v"(tid_));
    const int tid = tid_, wid = __builtin_amdgcn_readfirstlane(tid >> 6), lane = tid & 63, wr = wid >> 2, wc = wid & 3, fr = lane & 15, fq = lane >> 4;
    const int nt = K / BK;
    unsigned voffA[2], voffB[2];
#pragma unroll
    for (int i = 0; i < 2; ++i) { int R, C; stage_rc(tid * 16 + i * 8192, R, C); const int Rb = Epi::PERM ? ((R & ~31) + perm32(R & 31)) : R;
        voffA[i] = (unsigned)(R * ld + C) * 2u; voffB[i] = (unsigned)(Rb * ld + C) * 2u; }
    const size_t kstep = (size_t)(BK * 2);
    const size_t hstep = (size_t)HALF * ld * 2;
    const unsigned ldsw = (unsigned)wid * 1024u;
    const int aoff = lds_byte(wr * 64 + fr, fq * 8), boff = lds_byte(wc * 32 + fr, fq * 8);
#define PG8_SA(b, h) (((b) * 2 + (h)) * HTB)
#define PG8_SB(b, h) ((4 + (b) * 2 + (h)) * HTB)
#define PG8_STAGE(bufoff, gbase, voff) do { _Pragma("unroll") for (int _i = 0; _i < 2; ++_i) \
        __builtin_amdgcn_global_load_lds((const unsigned*)((const char*)(gbase) + (voff)[_i]), (PG8_LAS unsigned*)(lds + (bufoff) + ldsw + _i * 8192), 16, 0, 0); } while (0)
#define PG8_LDA(dst, b, h) do { _Pragma("unroll") for (int m = 0; m < 4; ++m) _Pragma("unroll") for (int k = 0; k < 2; ++k) dst[m][k] = *(const PG8_LAS bf16x8*)(lds + PG8_SA(b, h) + aoff + m * 2048 + k * 1024); } while (0)
#define PG8_LDB(dst, b, h) do { _Pragma("unroll") for (int n = 0; n < 2; ++n) _Pragma("unroll") for (int k = 0; k < 2; ++k) dst[n][k] = *(const PG8_LAS bf16x8*)(lds + PG8_SB(b, h) + boff + n * 2048 + k * 1024); } while (0)
#define PG8_MMA(ai, bj, At, Bt) do { __builtin_amdgcn_s_setprio(1); _Pragma("unroll") for (int m = 0; m < 4; ++m) _Pragma("unroll") for (int n = 0; n < 2; ++n) _Pragma("unroll") for (int k = 0; k < 2; ++k) \
        acc[ai][bj][m][n] = __builtin_amdgcn_mfma_f32_16x16x32_bf16(Bt[n][k], At[m][k], acc[ai][bj][m][n], 0, 0, 0); __builtin_amdgcn_s_setprio(0); } while (0)
#define PG8_WAIT_V(n) asm volatile("s_waitcnt vmcnt(" #n ")" ::: "memory")
#define PG8_WAIT_L(n) asm volatile("s_waitcnt lgkmcnt(" #n ")" ::: "memory")
#define PG8_BAR __builtin_amdgcn_s_barrier()
#define PG8_SCHED __builtin_amdgcn_sched_barrier(0)
    Unit cur, nxt; int ui = 0;
    if (!S.next(0, cur)) return;
    f32x4 acc[2][2][4][2];
#pragma unroll
    for (int a = 0; a < 2; ++a)
#pragma unroll
        for (int b = 0; b < 2; ++b)
#pragma unroll
            for (int m = 0; m < 4; ++m)
#pragma unroll
                for (int n = 0; n < 2; ++n) acc[a][b][m][n] = (f32x4){0.f, 0.f, 0.f, 0.f};
    bf16x8 At[4][2], B0[2][2], B1[2][2];
    const char* cA = S.a_base(cur); const char* cB = S.b_base(cur);
    if constexpr (SP2) {
        PG8_STAGE(PG8_SB(0, 0), cB, voffB); PG8_STAGE(PG8_SB(0, 1), cB + hstep, voffB); PG8_STAGE(PG8_SA(0, 0), cA, voffA); PG8_STAGE(PG8_SA(0, 1), cA + hstep, voffA);
        if (wr == 1) PG8_BAR;
        PG8_WAIT_V(2); PG8_BAR;
        PG8_STAGE(PG8_SB(1, 0), cB + kstep, voffB); PG8_STAGE(PG8_SA(1, 0), cA + kstep, voffA); PG8_STAGE(PG8_SB(1, 1), cB + hstep + kstep, voffB);
        PG8_WAIT_V(6); PG8_BAR;
    } else {
        PG8_STAGE(PG8_SB(0, 0), cB, voffB); PG8_STAGE(PG8_SA(0, 0), cA, voffA); PG8_STAGE(PG8_SB(0, 1), cB + hstep, voffB); PG8_STAGE(PG8_SA(0, 1), cA + hstep, voffA);
        if (wr == 1) PG8_BAR;
        PG8_WAIT_V(4); PG8_BAR;
        PG8_STAGE(PG8_SB(1, 0), cB + kstep, voffB); PG8_STAGE(PG8_SA(1, 0), cA + kstep, voffA); PG8_STAGE(PG8_SB(1, 1), cB + hstep + kstep, voffB);
        PG8_WAIT_V(6); PG8_BAR;
    }
    for (;;) {
        const bool has_next = S.next(ui + 1, nxt);
        const char* nA = has_next ? S.a_base(nxt) : cA; const char* nB = has_next ? S.b_base(nxt) : cB;
        for (int t = 0; t < nt; t += 2) {
            const bool last = (t == nt - 2);
            const char* a1 = cA + (size_t)(t + 1) * kstep;
            const char* a2 = last ? nA : cA + (size_t)(t + 2) * kstep; const char* b2 = last ? nB : cB + (size_t)(t + 2) * kstep;
            const char* a3 = a2 + kstep; const char* b3 = b2 + kstep;
            if constexpr (SP2) {
            PG8_LDB(B0, 0, 0); PG8_LDB(B1, 0, 1); PG8_SCHED; PG8_LDA(At, 0, 0); PG8_STAGE(PG8_SA(1, 1), a1 + hstep, voffA);
            PG8_WAIT_V(8); PG8_WAIT_L(0); PG8_BAR; PG8_MMA(0, 0, At, B0); PG8_MMA(0, 1, At, B1); PG8_BAR; PG8_SCHED;
            PG8_LDA(At, 0, 1); PG8_STAGE(PG8_SB(0, 0), b2, voffB); PG8_STAGE(PG8_SB(0, 1), b2 + hstep, voffB); PG8_STAGE(PG8_SA(0, 0), a2, voffA);
            PG8_WAIT_V(8); PG8_WAIT_L(0); PG8_BAR; PG8_MMA(1, 0, At, B0); PG8_MMA(1, 1, At, B1); PG8_BAR; PG8_SCHED;
            PG8_LDB(B0, 1, 0); PG8_LDB(B1, 1, 1); PG8_SCHED; PG8_LDA(At, 1, 0); PG8_STAGE(PG8_SA(0, 1), a2 + hstep, voffA);
            PG8_WAIT_V(8); PG8_WAIT_L(0); PG8_BAR; PG8_MMA(0, 0, At, B0); PG8_MMA(0, 1, At, B1); PG8_BAR; PG8_SCHED;
            PG8_LDA(At, 1, 1); PG8_STAGE(PG8_SB(1, 0), b3, voffB); PG8_STAGE(PG8_SB(1, 1), b3 + hstep, voffB); PG8_STAGE(PG8_SA(1, 0), a3, voffA);
            PG8_WAIT_V(8); PG8_WAIT_L(0); PG8_BAR; PG8_MMA(1, 0, At, B0); PG8_MMA(1, 1, At, B1); PG8_BAR; PG8_SCHED;
            } else {
            PG8_LDB(B0, 0, 0); PG8_SCHED; PG8_LDA(At, 0, 0); PG8_STAGE(PG8_SA(1, 1), a1 + hstep, voffA);
            PG8_WAIT_L(8); PG8_BAR; PG8_WAIT_L(0); PG8_MMA(0, 0, At, B0); PG8_BAR; PG8_SCHED;
            PG8_LDB(B1, 0, 1); PG8_STAGE(PG8_SB(0, 0), b2, voffB);
            PG8_BAR; PG8_WAIT_L(0); PG8_MMA(0, 1, At, B1); PG8_BAR;
            PG8_LDA(At, 0, 1); PG8_STAGE(PG8_SA(0, 0), a2, voffA);
            PG8_BAR; PG8_WAIT_L(0); PG8_MMA(1, 0, At, B0); PG8_BAR; PG8_SCHED;
            PG8_STAGE(PG8_SB(0, 1), b2 + hstep, voffB);
            PG8_WAIT_V(6); PG8_BAR; PG8_MMA(1, 1, At, B1); PG8_BAR;
            PG8_LDB(B0, 1, 0); PG8_SCHED; PG8_LDA(At, 1, 0); PG8_STAGE(PG8_SA(0, 1), a2 + hstep, voffA);
            PG8_WAIT_L(8); PG8_BAR; PG8_WAIT_L(0); PG8_MMA(0, 0, At, B0); PG8_BAR; PG8_SCHED;
            PG8_LDB(B1, 1, 1); PG8_STAGE(PG8_SB(1, 0), b3, voffB);
            PG8_BAR; PG8_WAIT_L(0); PG8_MMA(0, 1, At, B1); PG8_BAR;
            PG8_LDA(At, 1, 1); PG8_STAGE(PG8_SA(1, 0), a3, voffA);
            PG8_BAR; PG8_WAIT_L(0); PG8_MMA(1, 0, At, B0); PG8_BAR; PG8_SCHED;
            PG8_STAGE(PG8_SB(1, 1), b3 + hstep, voffB);
            PG8_WAIT_V(6); PG8_BAR; PG8_MMA(1, 1, At, B1); PG8_BAR;
            }
        }
        if constexpr (ALIGN_EPI) { if (wr == 0) PG8_BAR; }
        E(acc, cur, wr, wc, fr, fq);
        if (!has_next) break;
#pragma unroll
        for (int a = 0; a < 2; ++a)
#pragma unroll
            for (int b = 0; b < 2; ++b)
#pragma unroll
                for (int m = 0; m < 4; ++m)
#pragma unroll
                    for (int n = 0; n < 2; ++n) acc[a][b][m][n] = (f32x4){0.f, 0.f, 0.f, 0.f};
        cur = nxt; cA = nA; cB = nB; ++ui;
        if constexpr (ALIGN_EPI) { if (wr == 1) PG8_BAR; }
    }
    PG8_WAIT_V(0);
    if constexpr (!ALIGN_EPI) { if (wr == 0) PG8_BAR; }
    PG8_BAR;
#undef PG8_SA
#undef PG8_SB
#undef PG8_STAGE
#undef PG8_LDA
#undef PG8_LDB
#undef PG8_MMA
#undef PG8_WAIT_V
#undef PG8_WAIT_L
#undef PG8_BAR
#undef PG8_SCHED
}
}

constexpr int NWAVES = 8;
constexpr int BATCH = 16, SEQ = 2048, D = 1024, T = BATCH * SEQ;
constexpr int LDP = 2816;
constexpr int IN_COLS = 2576;
constexpr int C_U = 0, C_V = 512, C_Q = 1024, C_K = 1280, C_VV = 1536, C_G = 2048, C_A = 2560;
constexpr int DFF = 2816, DFE = 3584, NE = 8;
constexpr float LN_EPS = 1e-5f, RMS_EPS = 1e-6f, ALPHA = 1.41421356237f;
constexpr int RMAX = 2 * T + NE * 256;
constexpr int SLAB_P = 64;
constexpr int NSLAB = 5;
constexpr int KSPLIT = 7, KSLICE = DFE / KSPLIT, REM_P0 = 4 * SLAB_P, REM_MAXP = 8;
constexpr int NPHASE = 24;

constexpr size_t MiB = 1u << 20;
constexpr size_t WS_CTL = 0, CTL_ZERO_BYTES = 64 * 1024;
constexpr size_t WS_TOKE = 1 * MiB;
constexpr size_t WS_TOKW = WS_TOKE + 256 * 1024;
constexpr size_t WS_PPOS = WS_TOKW + 256 * 1024;
constexpr size_t WS_PEXP = WS_PPOS + 256 * 1024;
constexpr size_t WS_RPAIR = 2 * MiB;
constexpr size_t WS_RW = WS_RPAIR + 512 * 1024;
constexpr size_t WS_WM = 3 * MiB;
constexpr size_t WS_WIN = 4 * MiB;
constexpr size_t WS_WOUT = 15 * MiB;
constexpr size_t WS_WGU = 19 * MiB;
constexpr size_t WS_WDN = 30 * MiB;
constexpr size_t WS_EGU = 36 * MiB;
constexpr size_t WS_EDN = 148 * MiB;
constexpr size_t WS_XB = 204 * MiB;
constexpr size_t WS_BIG = 268 * MiB;
constexpr size_t WS_PROJ = WS_BIG;
constexpr size_t WS_CAT = 444 * MiB;
constexpr size_t WS_HID = WS_BIG;
constexpr size_t WS_XG = WS_BIG;
constexpr size_t WS_PART = WS_BIG;
constexpr size_t WS_HSLAB = 400 * MiB;
constexpr size_t WS_END = 512 * MiB;
constexpr int CW_TMO = 0;
constexpr int CW_CNT = 64;
constexpr int CW_CUR = 128;
constexpr int CW_BAR = 4096;

constexpr int RING_BYTES = 131072;
constexpr int LDSCTL_OFF = RING_BYTES, MISC_OFF = LDSCTL_OFF + 320;
constexpr int LDS_BYTES = 147456;

#define GAS __attribute__((address_space(1)))
#define LAS __attribute__((address_space(3)))
typedef unsigned short bf16;
typedef unsigned v4u __attribute__((ext_vector_type(4)));
typedef unsigned v2u __attribute__((ext_vector_type(2)));
typedef float f32x4 __attribute__((ext_vector_type(4)));
typedef float f32x2 __attribute__((ext_vector_type(2)));
typedef short bf16x8 __attribute__((ext_vector_type(8)));
#define RLX_AGENT __ATOMIC_RELAXED, __HIP_MEMORY_SCOPE_AGENT
#define LDS_WAIT() asm volatile("s_waitcnt lgkmcnt(0)" ::: "memory")
__device__ __forceinline__ float bflo(unsigned w) { return __uint_as_float(w << 16); }
__device__ __forceinline__ float bfhi(unsigned w) { return __uint_as_float(w & 0xffff0000u); }
__device__ __forceinline__ float bf2f(unsigned short h) { return __uint_as_float(((unsigned)h) << 16); }
__device__ __forceinline__ unsigned pk2(float lo, float hi) { return pg8::cvt_pk_bf16(lo, hi); }

#define XB_TMO      128
#define XB_XCNT(j)  (256  + 64 * (j))
#define XB_XSUB(j)  (1280 + 64 * (j))
#define XB_XGEN(j)  (2304 + 64 * (j))
#define XB_TOP      3328
#define XB_TOPGEN   3392
#define XCD_BAR_WORDS 3456
#define XB_SPIN_CAP (1u << 18)
__device__ __forceinline__ unsigned xb_ld(unsigned* p)              { return __hip_atomic_load(p, __ATOMIC_RELAXED, __HIP_MEMORY_SCOPE_AGENT); }
__device__ __forceinline__ unsigned xb_add(unsigned* p, unsigned v) { return __hip_atomic_fetch_add(p, v, __ATOMIC_RELAXED, __HIP_MEMORY_SCOPE_AGENT); }
__device__ __forceinline__ unsigned xb_xcc_id() { return (unsigned)__builtin_amdgcn_s_getreg((3 << 11) | 20) & 0xFu; }
#define XB_SPIN(cond, bar) do { unsigned _sp = 0; while (cond) { __builtin_amdgcn_s_sleep(1); \
    if ((++_sp & 255u) == 0u) { if (xb_ld(&(bar)[XB_TMO])) break; if (_sp > XB_SPIN_CAP) { atomicAdd(&(bar)[XB_TMO], 1u); break; } } } } while (0)
struct XcdBarrier { unsigned* bar; unsigned x; volatile LAS unsigned* st; };
__device__ __forceinline__ XcdBarrier xcd_barrier_post(unsigned* bar, volatile LAS unsigned* st) {
    XcdBarrier b; b.bar = bar; b.x = xb_xcc_id(); b.st = st;
    if (threadIdx.x == 0) (void)xb_add(&bar[XB_XCNT(b.x)], 1u);
    return b;
}
__device__ __forceinline__ void xcd_barrier_complete(unsigned* bar, unsigned x, unsigned& nloc, unsigned& nx) {
    const unsigned G = gridDim.x * gridDim.y * gridDim.z;
    unsigned sum, cnt, mine, sp = 0u;
    for (;;) {
        sum = 0u; cnt = 0u; mine = 0u;
#pragma unroll
        for (unsigned j = 0; j < 16; ++j) { const unsigned c = xb_ld(&bar[XB_XCNT(j)]); sum += c; cnt += (c > 0u) ? 1u : 0u; mine = (j == x) ? c : mine; }
        if (sum == G) break;
        __builtin_amdgcn_s_sleep(1);
        if ((++sp & 255u) == 0u) { if (xb_ld(&bar[XB_TMO])) break; if (sp > XB_SPIN_CAP) { atomicAdd(&bar[XB_TMO], 1u); break; } }
    }
    nloc = mine > 0u ? mine : 1u; nx = cnt > 0u ? cnt : 1u;
}
__device__ __forceinline__ void xcd_barrier(const XcdBarrier& b) {
    asm volatile("s_waitcnt vmcnt(0)" ::: "memory");
    __syncthreads();
    if (threadIdx.x == 0) {
        unsigned* bar = b.bar;
        __builtin_amdgcn_s_waitcnt(0);
        unsigned nloc = b.st[0], nx = b.st[1];
        if (nloc == 0u) { xcd_barrier_complete(bar, b.x, nloc, nx); b.st[0] = nloc; b.st[1] = nx; }
        const unsigned old = xb_add(&bar[XB_XSUB(b.x)], 1u);
        const unsigned gen = old / nloc;
        if (old + 1u == (gen + 1u) * nloc) {
            __builtin_amdgcn_fence(__ATOMIC_RELEASE, "agent");
            asm volatile("s_waitcnt vmcnt(0)" ::: "memory");
            const unsigned og = xb_add(&bar[XB_TOP], 1u);
            const unsigned tg = og / nx;
            if (og + 1u == (tg + 1u) * nx) xb_add(&bar[XB_TOPGEN], 1u);
            else XB_SPIN(xb_ld(&bar[XB_TOPGEN]) == tg, bar);
            __builtin_amdgcn_fence(__ATOMIC_ACQUIRE, "agent");
            xb_add(&bar[XB_XGEN(b.x)], 1u);
            asm volatile("s_waitcnt vmcnt(0)" ::: "memory");
        } else {
            XB_SPIN(xb_ld(&bar[XB_XGEN(b.x)]) == gen, bar);
            __builtin_amdgcn_fence(__ATOMIC_ACQUIRE, "agent");
            asm volatile("s_waitcnt vmcnt(0)" ::: "memory");
        }
    }
    __syncthreads();
}

struct Args { const float* in[21]; float* out; unsigned char* ws; int ph_lo, ph_hi; };
struct Frame {
    LAS unsigned char* lds;
    volatile LAS unsigned* MISC;
    unsigned* ctl;
    int G;
    unsigned char* ws; float* out;
};
#define LOCAL_IDS int tid = threadIdx.x; asm volatile("" : "+v"(tid)); const int lane = tid & 63; const int wave = __builtin_amdgcn_readfirstlane(tid >> 6); (void)lane; (void)wave
__device__ __forceinline__ float wave_sum(float v) {
#pragma unroll
    for (int o = 1; o < 64; o <<= 1) v += __shfl_xor(v, o);
    return v;
}

__device__ __forceinline__ void tr_block(const float* W, int Nsrc, int K, int k0, int n0, bf16* WT, int drow, int lane) {
    const int n = n0 + lane; const bool ok = n < Nsrc; const float* src = W + (size_t)k0 * Nsrc + (ok ? n : 0);
    float v[64];
#pragma unroll
    for (int kk = 0; kk < 64; ++kk) v[kk] = src[(size_t)kk * Nsrc];
    GAS v4u* dst = (GAS v4u*)(WT + (size_t)(drow + lane) * K + k0);
#pragma unroll
    for (int c = 0; c < 8; ++c) { v4u o; o.x = pk2(v[8 * c], v[8 * c + 1]); o.y = pk2(v[8 * c + 2], v[8 * c + 3]); o.z = pk2(v[8 * c + 4], v[8 * c + 5]); o.w = pk2(v[8 * c + 6], v[8 * c + 7]);
        if (!ok) o = (v4u){0u, 0u, 0u, 0u}; dst[c] = o; }
}
__device__ __forceinline__ void tr_plain(const float* W, int K, int Nsrc, int nblk, bf16* WT, int item, int lane) {
    const int kb = item / nblk, nb = item % nblk; tr_block(W, Nsrc, K, 64 * kb, 64 * nb, WT, 64 * nb, lane);
}
__device__ __forceinline__ void tr_gu(const float* W, int K, int Nsrc, int nblk, bf16* WT, int add, int item, int lane) {
    const int kb = item / nblk, nb = item % nblk, n0 = 64 * nb; tr_block(W, Nsrc, K, 64 * kb, n0, WT, (n0 >> 7) * 256 + (n0 & 127) + add, lane);
}
constexpr int I_IN = 16 * 44, I_OUT = 16 * 16, I_G = 16 * 44, I_DN = 44 * 16, I_EG = 16 * 56, I_ED = 56 * 16;
constexpr int NITEMS = 2 * I_IN + 2 * I_OUT + 2 * I_G + I_DN + 16 * I_EG + 8 * I_ED;
constexpr int NITEMS_A = I_IN + I_OUT, NITEMS_B = NITEMS - NITEMS_A;
__device__ __forceinline__ void conv_item(unsigned char* ws, const Args& a, int it, int lane) {
    bf16* Win = (bf16*)(ws + WS_WIN); bf16* Wout = (bf16*)(ws + WS_WOUT); bf16* Wgu = (bf16*)(ws + WS_WGU); bf16* Wdn = (bf16*)(ws + WS_WDN);
    bf16* Egu = (bf16*)(ws + WS_EGU); bf16* Edn = (bf16*)(ws + WS_EDN);
    int r = it;
    if (r < 2 * I_IN) { const int l = r / I_IN; tr_plain(a.in[1] + (size_t)l * D * IN_COLS, D, IN_COLS, 44, Win + (size_t)l * LDP * D, r % I_IN, lane); return; } r -= 2 * I_IN;
    if (r < 2 * I_OUT) { const int l = r / I_OUT; tr_plain(a.in[9] + (size_t)l * D * D, D, D, 16, Wout + (size_t)l * D * D, r % I_OUT, lane); return; } r -= 2 * I_OUT;
    if (r < I_G) { tr_gu(a.in[12], D, DFF, 44, Wgu, 0, r, lane); return; } r -= I_G;
    if (r < I_G) { tr_gu(a.in[13], D, DFF, 44, Wgu, 128, r, lane); return; } r -= I_G;
    if (r < I_DN) { tr_plain(a.in[14], DFF, D, 16, Wdn, r, lane); return; } r -= I_DN;
    if (r < 8 * I_EG) { const int e = r / I_EG; tr_gu(a.in[16] + (size_t)e * D * DFE, D, DFE, 56, Egu + (size_t)e * 2 * DFE * D, 0, r % I_EG, lane); return; } r -= 8 * I_EG;
    if (r < 8 * I_EG) { const int e = r / I_EG; tr_gu(a.in[17] + (size_t)e * D * DFE, D, DFE, 56, Egu + (size_t)e * 2 * DFE * D, 128, r % I_EG, lane); return; } r -= 8 * I_EG;
    { const int e = r / I_ED; tr_plain(a.in[18] + (size_t)e * DFE * D, DFE, D, 16, Edn + (size_t)e * D * DFE, r % I_ED, lane); }
}
__device__ __forceinline__ void conv_set_b(Frame& F, const Args& a, int gw2, int NGW2) {
    LOCAL_IDS;
    for (int k = gw2; k < NITEMS_B; k += NGW2) conv_item(F.ws, a, k < I_IN ? I_IN + k : 2 * I_IN + I_OUT + (k - I_IN), lane);
}
__device__ __forceinline__ void p0_prologue(Frame& F, const Args& a) {
    LOCAL_IDS;
    const int gw = blockIdx.x * NWAVES + wave, NGW = F.G * NWAVES;
    for (int k = gw; k < NITEMS_A; k += NGW) conv_item(F.ws, a, k < I_IN ? k : 2 * I_IN + (k - I_IN), lane);
    if (F.G < 128) conv_set_b(F, a, gw, NGW);
    const size_t gt = (size_t)blockIdx.x * 512 + tid, NT = (size_t)F.G * 512;
    { const f32x4* x4 = (const f32x4*)a.in[0]; v4u* o = (v4u*)(F.ws + WS_XB);
      for (size_t i = gt; i < (size_t)T * D / 8; i += NT) { const f32x4 p = x4[2 * i], q = x4[2 * i + 1]; v4u w; w.x = pk2(p[0], p[1]); w.y = pk2(p[2], p[3]); w.z = pk2(q[0], q[1]); w.w = pk2(q[2], q[3]); o[i] = w; } }
    { const float* w = a.in[2]; bf16* o = (bf16*)(F.ws + WS_WM);
      for (size_t i = gt; i < (size_t)2 * 4 * 128 * 128; i += NT) { const int s = (int)(i & 127), t = (int)((i >> 7) & 127); o[i] = (bf16)(pk2(s <= t ? w[i] : 0.f, 0.f) & 0xffffu); } }
}

__device__ __forceinline__ void gmlp_item(Frame& F, const Args& a, int layer, int item) {
    const int bb = item >> 6, c = (item >> 2) & 15, h = item & 3; const int r0 = bb * SEQ + c * 128;
    const bf16* P = (const bf16*)(F.ws + WS_PROJ); bf16* CAT = (bf16*)(F.ws + WS_CAT);
    const bf16* Wm = (const bf16*)(F.ws + WS_WM) + (size_t)(layer * 4 + h) * 128 * 128;
    const float* lng = a.in[4] + layer * 512 + h * 128; const float* lnb = a.in[5] + layer * 512 + h * 128; const float* bs = a.in[3] + (layer * 4 + h) * 128;
    LAS unsigned char* VTA = F.lds;
    LOCAL_IDS; const int w = wave, fr = lane & 15, fq = lane >> 4;
    {
        const int s = tid >> 2, q4 = tid & 3; const bf16* vp = P + (size_t)(r0 + s) * LDP + C_V + h * 128 + q4 * 8;
        float x[4][8]; float sum = 0.f;
#pragma unroll
        for (int j = 0; j < 4; ++j) { const v4u wv = *(const v4u*)(vp + 32 * j); x[j][0] = bflo(wv.x); x[j][1] = bfhi(wv.x); x[j][2] = bflo(wv.y); x[j][3] = bfhi(wv.y); x[j][4] = bflo(wv.z); x[j][5] = bfhi(wv.z); x[j][6] = bflo(wv.w); x[j][7] = bfhi(wv.w);
#pragma unroll
            for (int e = 0; e < 8; ++e) sum += x[j][e]; }
        sum += __shfl_xor(sum, 1); sum += __shfl_xor(sum, 2);
        const float mean = sum * (1.f / 128.f); float q = 0.f;
#pragma unroll
        for (int j = 0; j < 4; ++j)
#pragma unroll
            for (int e = 0; e < 8; ++e) { x[j][e] -= mean; q += x[j][e] * x[j][e]; }
        q += __shfl_xor(q, 1); q += __shfl_xor(q, 2);
        const float rstd = 1.0f / sqrtf(q * (1.f / 128.f) + LN_EPS);
#pragma unroll
        for (int j = 0; j < 4; ++j) { const int ch0 = q4 * 8 + 32 * j; const f32x4 g0 = *(const f32x4*)(lng + ch0), g1 = *(const f32x4*)(lng + ch0 + 4), b0 = *(const f32x4*)(lnb + ch0), b1 = *(const f32x4*)(lnb + ch0 + 4);
#pragma unroll
            for (int e = 0; e < 8; ++e) { const float gg = e < 4 ? g0[e & 3] : g1[e & 3], be = e < 4 ? b0[e & 3] : b1[e & 3]; const float y = x[j][e] * rstd * gg + be;
                *(LAS bf16*)(VTA + (ch0 + e) * 272 + s * 2) = (bf16)(pk2(y, 0.f) & 0xffffu); } }
    }
    __syncthreads();
    {
        bf16x8 aV[4];
#pragma unroll
        for (int ks = 0; ks < 4; ++ks) aV[ks] = *(const LAS bf16x8*)(VTA + (16 * w + fr) * 272 + (32 * ks + 8 * fq) * 2);
#pragma unroll
        for (int tt = 0; tt < 8; ++tt) { f32x4 acc = (f32x4){0.f, 0.f, 0.f, 0.f}; const int t = 16 * tt + fr;
#pragma unroll
            for (int ks = 0; ks < 4; ++ks) if (ks <= tt / 2) { const bf16x8 bW = *(const bf16x8*)(Wm + (size_t)t * 128 + 32 * ks + 8 * fq); acc = __builtin_amdgcn_mfma_f32_16x16x32_bf16(aV[ks], bW, acc, 0, 0, 0); }
            const float bst = bs[t]; const size_t row = (size_t)(r0 + t); const v2u uu = *(const v2u*)(P + row * LDP + C_U + h * 128 + 16 * w + 4 * fq);
            v2u o; o.x = pk2(bflo(uu.x) * (acc[0] + bst), bfhi(uu.x) * (acc[1] + bst)); o.y = pk2(bflo(uu.y) * (acc[2] + bst), bfhi(uu.y) * (acc[3] + bst));
            if ((ABL >> layer) & 1) { o.x = 0u; o.y = 0u; }
            *(v2u*)(CAT + row * D + h * 128 + 16 * w + 4 * fq) = o; }
    }
    __syncthreads();
}

constexpr int G_QD = 0, G_KI = 9216, G_SC = 18432, G_KDT = 27648, G_VT = 36864, G_ST = 55296, G_ALR = 73728, G_PART = 75776, G_DEC = 77824, G_SS = 78080, G_RQ = 80128, G_RK = 88320, G_RV = 96512, G_END = 112896;
__device__ __forceinline__ void gla_item(Frame& F, const Args& a, int layer, int item) {
    const int bb = item >> 2, h = item & 3;
    const bf16* P = (const bf16*)(F.ws + WS_PROJ) + (size_t)bb * SEQ * LDP; bf16* CAT = (bf16*)(F.ws + WS_CAT) + (size_t)bb * SEQ * D;
    LAS unsigned char* L = F.lds;
    LOCAL_IDS; const int w = wave, fr = lane & 15, fq = lane >> 4, d = lane;
    const int ve = (w & 1) * 64 + lane, vjg = w >> 1;
    float wcol[16];
#pragma unroll
    for (int m = 0; m < 16; ++m) wcol[m] = a.in[6][(size_t)layer * 16 * 256 + m * 256 + h * 64 + d];
    const float bad = a.in[7][layer * 256 + h * 64 + d];
    const f32x4 ng = *(const f32x4*)(a.in[8] + layer * 512 + h * 128 + 16 * w + 4 * fq);
    for (int i = tid; i < (18432 + 9216) / 4; i += 512) { if (i < 18432 / 4) ((LAS unsigned*)(L + G_ST))[i] = 0u; else ((LAS unsigned*)(L + G_SC))[i - 18432 / 4] = 0u; }
    f32x4 sacc[4];
#pragma unroll
    for (int dt = 0; dt < 4; ++dt) sacc[dt] = (f32x4){0.f, 0.f, 0.f, 0.f};
    const unsigned oq = (unsigned)((tid >> 3) * LDP + C_Q + h * 64 + (tid & 7) * 8), ok_ = (unsigned)((tid >> 3) * LDP + C_K + h * 64 + (tid & 7) * 8);
    const unsigned ov = (unsigned)((tid >> 4) * LDP + C_VV + h * 128 + (tid & 15) * 8), oa = (unsigned)(((tid & 127) >> 1) * LDP + C_A + (tid & 1) * 8);
    const unsigned og = (unsigned)(fr * LDP + C_G + h * 128 + 16 * w + 4 * fq);
    v4u rq, rk, rv0, rv1, ra = (v4u){0u, 0u, 0u, 0u};
    { rq = *(const v4u*)(P + oq); rk = *(const v4u*)(P + ok_); rv0 = *(const v4u*)(P + ov); rv1 = *(const v4u*)(P + ov + 32 * LDP); if (tid < 128) ra = *(const v4u*)(P + oa); }
    __syncthreads();
    for (int n = 0; n < 32; ++n) {
        const bf16* R = P + (size_t)n * 64 * LDP;
        *(LAS v4u*)(L + G_RQ + tid * 16) = rq; *(LAS v4u*)(L + G_RK + tid * 16) = rk; *(LAS v4u*)(L + G_RV + tid * 16) = rv0; *(LAS v4u*)(L + G_RV + 8192 + tid * 16) = rv1;
        if (tid < 128) *(LAS v4u*)(L + G_ALR + tid * 16) = ra;
        __syncthreads();
        if (n + 1 < 32) { const bf16* Rn = R + (size_t)64 * LDP; rq = *(const v4u*)(Rn + oq); rk = *(const v4u*)(Rn + ok_); rv0 = *(const v4u*)(Rn + ov); rv1 = *(const v4u*)(Rn + ov + 32 * LDP); if (tid < 128) ra = *(const v4u*)(Rn + oa); }
        v2u gate[4];
#pragma unroll
        for (int it = 0; it < 4; ++it) gate[it] = *(const v2u*)(R + og + (size_t)(16 * it) * LDP);
        { unsigned short vv[16];
#pragma unroll
          for (int jj = 0; jj < 16; ++jj) vv[jj] = *(const LAS unsigned short*)(L + G_RV + (16 * vjg + jj) * 256 + ve * 2);
          v4u p0, p1; p0.x = vv[0] | ((unsigned)vv[1] << 16); p0.y = vv[2] | ((unsigned)vv[3] << 16); p0.z = vv[4] | ((unsigned)vv[5] << 16); p0.w = vv[6] | ((unsigned)vv[7] << 16);
          p1.x = vv[8] | ((unsigned)vv[9] << 16); p1.y = vv[10] | ((unsigned)vv[11] << 16); p1.z = vv[12] | ((unsigned)vv[13] << 16); p1.w = vv[14] | ((unsigned)vv[15] << 16);
          *(LAS v4u*)(L + G_VT + ve * 144 + vjg * 32) = p0; *(LAS v4u*)(L + G_VT + ve * 144 + vjg * 32 + 16) = p1; }
        float cs[8]; float run = 0.f;
#pragma unroll
        for (int ii = 0; ii < 8; ++ii) { const v4u a0 = *(const LAS v4u*)(L + G_ALR + (8 * w + ii) * 32), a1 = *(const LAS v4u*)(L + G_ALR + (8 * w + ii) * 32 + 16);
            float z = bad;
            z += bflo(a0.x) * wcol[0] + bfhi(a0.x) * wcol[1] + bflo(a0.y) * wcol[2] + bfhi(a0.y) * wcol[3] + bflo(a0.z) * wcol[4] + bfhi(a0.z) * wcol[5] + bflo(a0.w) * wcol[6] + bfhi(a0.w) * wcol[7];
            z += bflo(a1.x) * wcol[8] + bfhi(a1.x) * wcol[9] + bflo(a1.y) * wcol[10] + bfhi(a1.y) * wcol[11] + bflo(a1.z) * wcol[12] + bfhi(a1.z) * wcol[13] + bflo(a1.w) * wcol[14] + bfhi(a1.w) * wcol[15];
            const float ls = fminf(z, 0.f) - __logf(1.0f + __expf(-fabsf(z)));
            run += ((GLA_DBG == 2 || GLA_DBG == 3) ? 0.f : ls * 0.0625f); cs[ii] = run; }
        *(LAS float*)(L + G_PART + (w * 64 + d) * 4) = run;
        __syncthreads();
        float off = 0.f, bl = 0.f;
#pragma unroll
        for (int ww = 0; ww < 8; ++ww) { const float p = *(const LAS float*)(L + G_PART + (ww * 64 + d) * 4); bl += p; off += (ww < w) ? p : 0.f; }
        { unsigned kd[8];
#pragma unroll
          for (int ii = 0; ii < 8; ++ii) { const float qv = bf2f(*(const LAS unsigned short*)(L + G_RQ + (8 * w + ii) * 128 + d * 2)), kv = bf2f(*(const LAS unsigned short*)(L + G_RK + (8 * w + ii) * 128 + d * 2));
              const float b_ = off + cs[ii]; const float qd = qv * 0.125f * __expf(b_), ki = kv * __expf(-b_), kdv = kv * __expf(bl - b_);
              *(LAS bf16*)(L + G_QD + (8 * w + ii) * 144 + d * 2) = (bf16)(pk2(qd, 0.f) & 0xffffu);
              *(LAS bf16*)(L + G_KI + (8 * w + ii) * 144 + d * 2) = (bf16)(pk2(ki, 0.f) & 0xffffu);
              kd[ii] = pk2(kdv, 0.f) & 0xffffu; }
          v4u pk; pk.x = kd[0] | (kd[1] << 16); pk.y = kd[2] | (kd[3] << 16); pk.z = kd[4] | (kd[5] << 16); pk.w = kd[6] | (kd[7] << 16);
          *(LAS v4u*)(L + G_KDT + d * 144 + w * 16) = pk; }
        if (w == 0) *(LAS float*)(L + G_DEC + d * 4) = __expf(bl);
        __syncthreads();
#pragma unroll
        for (int rep = 0; rep < 2; ++rep) { const int tix = w + 8 * rep;
            if (tix < 10) { const int it = (tix >= 6) ? 3 : (tix >= 3) ? 2 : (tix >= 1) ? 1 : 0, jt = tix - it * (it + 1) / 2;
                f32x4 acc = (f32x4){0.f, 0.f, 0.f, 0.f};
#pragma unroll
                for (int ks = 0; ks < 2; ++ks) { const bf16x8 ak = *(const LAS bf16x8*)(L + G_KI + (16 * jt + fr) * 144 + (32 * ks + 8 * fq) * 2), bq = *(const LAS bf16x8*)(L + G_QD + (16 * it + fr) * 144 + (32 * ks + 8 * fq) * 2);
                    acc = __builtin_amdgcn_mfma_f32_16x16x32_bf16(ak, bq, acc, 0, 0, 0); }
                const int i = 16 * it + fr, j0 = 16 * jt + 4 * fq;
                v2u o; o.x = pk2(j0 <= i ? acc[0] : 0.f, j0 + 1 <= i ? acc[1] : 0.f); o.y = pk2(j0 + 2 <= i ? acc[2] : 0.f, j0 + 3 <= i ? acc[3] : 0.f);
                *(LAS v2u*)(L + G_SC + i * 144 + j0 * 2) = o; } }
        __syncthreads();
        bf16x8 aV[2], aS[2];
#pragma unroll
        for (int ks = 0; ks < 2; ++ks) { aV[ks] = *(const LAS bf16x8*)(L + G_VT + (16 * w + fr) * 144 + (32 * ks + 8 * fq) * 2); aS[ks] = *(const LAS bf16x8*)(L + G_ST + (16 * w + fr) * 144 + (32 * ks + 8 * fq) * 2); }
        f32x4 o[4];
#pragma unroll
        for (int it = 0; it < 4; ++it) { f32x4 acc = (f32x4){0.f, 0.f, 0.f, 0.f};
#pragma unroll
            for (int ks = 0; ks < 2; ++ks) if (ks == 0 || it >= 2) { const bf16x8 bs_ = *(const LAS bf16x8*)(L + G_SC + (16 * it + fr) * 144 + (32 * ks + 8 * fq) * 2); acc = __builtin_amdgcn_mfma_f32_16x16x32_bf16(aV[ks], bs_, acc, 0, 0, 0); }
#pragma unroll
            for (int ks = 0; ks < 2; ++ks) { const bf16x8 bq = *(const LAS bf16x8*)(L + G_QD + (16 * it + fr) * 144 + (32 * ks + 8 * fq) * 2); acc = __builtin_amdgcn_mfma_f32_16x16x32_bf16(aS[ks], bq, acc, 0, 0, 0); }
            o[it] = acc;
            float p = acc[0] * acc[0] + acc[1] * acc[1] + acc[2] * acc[2] + acc[3] * acc[3]; p += __shfl_xor(p, 16); p += __shfl_xor(p, 32);
            if (fq == 0) *(LAS float*)(L + G_SS + (w * 64 + 16 * it + fr) * 4) = p; }
        asm volatile("s_waitcnt lgkmcnt(0)" ::: "memory");
#pragma unroll
        for (int dt = 0; dt < 4; ++dt) { const f32x4 dec = *(const LAS f32x4*)(L + G_DEC + (16 * dt + 4 * fq) * 4); sacc[dt] = sacc[dt] * dec;
#pragma unroll
            for (int ks = 0; ks < 2; ++ks) { const bf16x8 ak = *(const LAS bf16x8*)(L + G_KDT + (16 * dt + fr) * 144 + (32 * ks + 8 * fq) * 2); sacc[dt] = __builtin_amdgcn_mfma_f32_16x16x32_bf16(ak, aV[ks], sacc[dt], 0, 0, 0); }
            v2u sw; sw.x = pk2(sacc[dt][0], sacc[dt][1]); sw.y = pk2(sacc[dt][2], sacc[dt][3]);
            if (GLA_DBG != 1) *(LAS v2u*)(L + G_ST + (16 * w + fr) * 144 + (16 * dt + 4 * fq) * 2) = sw; }
        __syncthreads();
#if GLA_DBG == 3
        if (n == 0 && layer == 0) {
            unsigned bits = 0u;
            { const int dd = tid & 63, ee = tid >> 2; float ref = 0.f; for (int j = 0; j < 64; ++j) ref += bf2f(*(const LAS unsigned short*)(L + G_KDT + dd * 144 + j * 2)) * bf2f(*(const LAS unsigned short*)(L + G_VT + ee * 144 + j * 2));
              const float got = bf2f(*(const LAS unsigned short*)(L + G_ST + ee * 144 + dd * 2)); if (!(fabsf(got - ref) <= 0.02f * fabsf(ref) + 0.02f)) bits |= 1u; }
            { const int dd = tid & 63; for (int j = (tid >> 6); j < 64; j += 8) { const unsigned short kk = *(const LAS unsigned short*)(L + G_KDT + dd * 144 + j * 2), rk_ = *(const LAS unsigned short*)(L + G_RK + j * 128 + dd * 2); if (kk != rk_) bits |= 2u; } }
            { const int ee = tid & 127; for (int j = (tid >> 7); j < 64; j += 4) { const unsigned short vv_ = *(const LAS unsigned short*)(L + G_VT + ee * 144 + j * 2), rv_ = *(const LAS unsigned short*)(L + G_RV + j * 256 + ee * 2); if (vv_ != rv_) bits |= 4u; } }
            {
#pragma unroll
                for (int dt = 0; dt < 4; ++dt)
#pragma unroll
                    for (int r = 0; r < 4; ++r) { const int dd = 16 * dt + 4 * fq + r, ee = 16 * w + fr; float ref = 0.f; for (int j = 0; j < 64; ++j) ref += bf2f(*(const LAS unsigned short*)(L + G_KDT + dd * 144 + j * 2)) * bf2f(*(const LAS unsigned short*)(L + G_VT + ee * 144 + j * 2));
                        if (!(fabsf(sacc[dt][r] - ref) <= 0.01f * fabsf(ref) + 0.01f)) bits |= 8u;
                        const float got = bf2f(*(const LAS unsigned short*)(L + G_ST + ee * 144 + dd * 2)); if (!(fabsf(got - sacc[dt][r]) <= 0.01f * fabsf(got) + 0.01f)) bits |= 16u; } }
            if (bits) atomicOr((unsigned*)(F.ws + WS_CTL) + 192 + 4, bits);
        }
#endif
#pragma unroll
        for (int it = 0; it < 4; ++it) { float tot = 0.f;
#pragma unroll
            for (int ww = 0; ww < 8; ++ww) tot += *(const LAS float*)(L + G_SS + (ww * 64 + 16 * it + fr) * 4);
            const float rstd = 1.0f / sqrtf(tot * (1.f / 128.f) + RMS_EPS);
            const float g0 = bflo(gate[it].x), g1 = bfhi(gate[it].x), g2 = bflo(gate[it].y), g3 = bfhi(gate[it].y);
            v2u ov_; ov_.x = pk2(o[it][0] * rstd * ng[0] * pg8::silu_f(g0), o[it][1] * rstd * ng[1] * pg8::silu_f(g1)); ov_.y = pk2(o[it][2] * rstd * ng[2] * pg8::silu_f(g2), o[it][3] * rstd * ng[3] * pg8::silu_f(g3));
            if ((ABL >> (2 + layer)) & 1) { ov_.x = 0u; ov_.y = 0u; }
            *(v2u*)(CAT + (size_t)(n * 64 + 16 * it + fr) * D + 512 + h * 128 + 16 * w + 4 * fq) = ov_; }
    }
    __syncthreads();
}
__device__ __forceinline__ void mixer_phase(Frame& F, const Args& a, int layer) {
    const int bx = blockIdx.x; int G_ = F.G; asm volatile("" : "+s"(G_));
    if (G_ >= 128) {
        if (bx < 64) gla_item(F, a, layer, bx);
        else { for (int it = bx - 64; it < 1024; it += F.G - 64) gmlp_item(F, a, layer, it);
            if (layer == 0) { const int wv = __builtin_amdgcn_readfirstlane((int)threadIdx.x >> 6); conv_set_b(F, a, (bx - 64) * NWAVES + wv, (F.G - 64) * NWAVES); } }
    } else {
        for (int it = bx; it < 64; it += F.G) gla_item(F, a, layer, it);
        for (int it = bx; it < 1024; it += F.G) gmlp_item(F, a, layer, it);
    }
}

template <bool ROUTER>
__device__ __forceinline__ void ln_phase(Frame& F, const Args& a, const float* g, const float* b) {
    LOCAL_IDS;
    const int gw = blockIdx.x * NWAVES + wave, NGW = F.G * NWAVES;
    const float* Y = F.out; bf16* XB = (bf16*)(F.ws + WS_XB);
    f32x4 gv[4], bv[4];
#pragma unroll
    for (int j = 0; j < 4; ++j) { gv[j] = *(const f32x4*)(g + 4 * lane + 256 * j); bv[j] = *(const f32x4*)(b + 4 * lane + 256 * j); }
    LAS unsigned* hist = (LAS unsigned*)(F.lds + 1024);
    if (ROUTER) {
        if (tid < 8) hist[tid] = 0u;
        int* rp = (int*)(F.ws + WS_RPAIR);
        for (int c = blockIdx.x; c < RMAX / 512; c += F.G) rp[c * 512 + tid] = -1;
        __syncthreads();
    }
    for (int m = gw; m < T; m += NGW) {
        const f32x4* xr = (const f32x4*)(Y + (size_t)m * D) + lane;
        f32x4 v[4]; float s = 0.f;
#pragma unroll
        for (int j = 0; j < 4; ++j) { v[j] = xr[64 * j]; s += (v[j][0] + v[j][1]) + (v[j][2] + v[j][3]); }
        const float mean = wave_sum(s) * (1.f / D); float s2 = 0.f;
#pragma unroll
        for (int j = 0; j < 4; ++j) { v[j] = v[j] - mean; s2 += (v[j][0] * v[j][0] + v[j][1] * v[j][1]) + (v[j][2] * v[j][2] + v[j][3] * v[j][3]); }
        const float rstd = 1.f / sqrtf(wave_sum(s2) * (1.f / D) + LN_EPS);
        v2u* o8 = (v2u*)(XB + (size_t)m * D) + lane;
#pragma unroll
        for (int j = 0; j < 4; ++j) { v[j] = v[j] * rstd * gv[j] + bv[j]; v2u w; w.x = pk2(v[j][0], v[j][1]); w.y = pk2(v[j][2], v[j][3]); o8[64 * j] = w; }
        if (ROUTER) {
            const float* wr = a.in[15];
            float lg[8];
#pragma unroll
            for (int e = 0; e < 8; ++e) lg[e] = 0.f;
#pragma unroll
            for (int j = 0; j < 4; ++j)
#pragma unroll
                for (int c = 0; c < 4; ++c) { const int k = 4 * lane + 256 * j + c; const f32x4 w0 = *(const f32x4*)(wr + k * 8), w1 = *(const f32x4*)(wr + k * 8 + 4); const float xv = v[j][c];
                    lg[0] += xv * w0[0]; lg[1] += xv * w0[1]; lg[2] += xv * w0[2]; lg[3] += xv * w0[3]; lg[4] += xv * w1[0]; lg[5] += xv * w1[1]; lg[6] += xv * w1[2]; lg[7] += xv * w1[3]; }
#pragma unroll
            for (int e = 0; e < 8; ++e) lg[e] = wave_sum(lg[e]);
            int i0 = 0; float v0 = lg[0];
#pragma unroll
            for (int e = 1; e < 8; ++e) if (lg[e] > v0) { v0 = lg[e]; i0 = e; }
            int i1 = -1; float v1 = -3.0e38f;
#pragma unroll
            for (int e = 0; e < 8; ++e) if (e != i0 && lg[e] > v1) { v1 = lg[e]; i1 = e; }
            const float w0 = 1.0f / (1.0f + __expf(v1 - v0)), w1 = 1.0f - w0;
            if (lane == 0) { ((unsigned*)(F.ws + WS_TOKE))[m] = (unsigned)i0 | ((unsigned)i1 << 8); ((f32x2*)(F.ws + WS_TOKW))[m] = (f32x2){w0, w1};
                __hip_atomic_fetch_add(hist + i0, 1u, __ATOMIC_RELAXED, __HIP_MEMORY_SCOPE_WORKGROUP); __hip_atomic_fetch_add(hist + i1, 1u, __ATOMIC_RELAXED, __HIP_MEMORY_SCOPE_WORKGROUP); }
        }
    }
    if (ROUTER) { __syncthreads(); if (tid < 8) __hip_atomic_fetch_add(F.ctl + CW_CNT + tid, hist[tid], RLX_AGENT); }
}
__device__ __forceinline__ void moe_segments(Frame& F, int (&seg)[9]) {
    int acc = 0;
#pragma unroll
    for (int e = 0; e < 8; ++e) { seg[e] = acc; const unsigned c = __hip_atomic_load(F.ctl + CW_CNT + e, RLX_AGENT); acc += (int)((c + 255u) & ~255u); }
    seg[8] = acc;
}
__device__ __forceinline__ void scatter_phase(Frame& F) {
    LOCAL_IDS;
    int seg[9]; moe_segments(F, seg);
    LAS unsigned* lcnt = (LAS unsigned*)(F.lds + 1024); LAS unsigned* lbase = lcnt + 8; LAS int* lpos = (LAS int*)(F.lds + 2048);
    const unsigned* toke = (const unsigned*)(F.ws + WS_TOKE); const f32x2* tokw = (const f32x2*)(F.ws + WS_TOKW);
    int* rp = (int*)(F.ws + WS_RPAIR); float* rw = (float*)(F.ws + WS_RW);
    const bf16* XB = (const bf16*)(F.ws + WS_XB); bf16* XG = (bf16*)(F.ws + WS_XG);
    for (int base = blockIdx.x * 128; base < T; base += F.G * 128) {
        if (tid < 8) lcnt[tid] = 0u;
        __syncthreads();
        int e = 0, lrank = 0; float wgt = 0.f; const int t = base + (tid >> 1), slot = tid & 1;
        if (tid < 256) { const unsigned ee = toke[t]; e = slot ? (int)((ee >> 8) & 0xff) : (int)(ee & 0xff); const f32x2 ww = tokw[t]; wgt = slot ? ww.y : ww.x; lrank = (int)__hip_atomic_fetch_add(lcnt + e, 1u, __ATOMIC_RELAXED, __HIP_MEMORY_SCOPE_WORKGROUP); }
        __syncthreads();
        if (tid < 8) lbase[tid] = __hip_atomic_fetch_add(F.ctl + CW_CUR + tid, lcnt[tid], RLX_AGENT);
        __syncthreads();
        if (tid < 256) { int sg = 0;
#pragma unroll
            for (int j = 0; j < 8; ++j) sg = (e == j) ? seg[j] : sg;
            const int pos = sg + (int)lbase[e] + lrank; rp[pos] = 2 * t + slot; rw[pos] = wgt; lpos[tid] = pos; ((int*)(F.ws + WS_PPOS))[2 * t + slot] = pos; }
        __syncthreads();
        for (int p = wave; p < 256; p += NWAVES) { const int pos = lpos[p]; const v4u* src = (const v4u*)(XB + (size_t)(base + (p >> 1)) * D); v4u* dst = (v4u*)(XG + (size_t)pos * D);
            dst[lane] = src[lane]; dst[lane + 64] = src[lane + 64]; }
        __syncthreads();
    }
    if (blockIdx.x == 0 && tid < RMAX / 256) { int e = 0;
#pragma unroll
        for (int j = 1; j < 8; ++j) e += (tid * 256 >= seg[j]) ? 1 : 0;
        ((unsigned char*)(F.ws + WS_PEXP))[tid] = (unsigned char)e; }
    if (blockIdx.x < 8) { const int e = blockIdx.x; const int c = (int)__hip_atomic_load(F.ctl + CW_CNT + e, RLX_AGENT); int sg = 0, sn = 0;
#pragma unroll
        for (int j = 0; j < 8; ++j) { sg = (e == j) ? seg[j] : sg; sn = (e == j) ? seg[j + 1] : sn; }
        const int r0 = sg + c, nr = sn - r0; v4u* dst = (v4u*)(XG + (size_t)r0 * D);
        for (int i = tid; i < nr * 128; i += 512) dst[i] = (v4u){0u, 0u, 0u, 0u}; }
}
__device__ __forceinline__ void pair_row(Frame& F, int pair, int lane, f32x4 (&y)[4]) {
    const v2u* yp = (const v2u*)((const bf16*)F.out + (size_t)pair * D) + lane;
    v2u a0[4];
#pragma unroll
    for (int j = 0; j < 4; ++j) a0[j] = yp[64 * j];
    const int pos = __builtin_amdgcn_readfirstlane(((const int*)(F.ws + WS_PPOS))[pair]);
#pragma unroll
    for (int j = 0; j < 4; ++j) y[j] = (f32x4){bflo(a0[j].x), bfhi(a0[j].x), bflo(a0[j].y), bfhi(a0[j].y)};
    if (pos >= REM_P0 * 256) { const float gw = ((const float*)(F.ws + WS_RW))[pos]; const f32x4* pp = (const f32x4*)((const float*)(F.ws + WS_PART) + (size_t)(pos - REM_P0 * 256) * D) + lane;
#pragma unroll
        for (int j = 0; j < 4; ++j) { f32x4 acc = pp[64 * j];
#pragma unroll
            for (int ks = 1; ks < KSPLIT; ++ks) acc += pp[(size_t)ks * REM_MAXP * 256 * (D / 4) + 64 * j];
            y[j] = acc * gw; } }
}
__device__ __forceinline__ void combine_phase(Frame& F, const float* g, const float* b) {
    LOCAL_IDS;
    const int gw = blockIdx.x * NWAVES + wave, NGW = F.G * NWAVES;
    const bf16* XB = (const bf16*)(F.ws + WS_XB);
    f32x4 gv[4], bv[4];
#pragma unroll
    for (int j = 0; j < 4; ++j) { gv[j] = *(const f32x4*)(g + 4 * lane + 256 * j); bv[j] = *(const f32x4*)(b + 4 * lane + 256 * j); }
    for (int m = gw; m < T; m += NGW) {
        const v2u* xr = (const v2u*)(XB + (size_t)m * D) + lane;
        f32x4 v[4], y0[4], y1[4]; float s = 0.f;
        pair_row(F, 2 * m, lane, y0); pair_row(F, 2 * m + 1, lane, y1);
#pragma unroll
        for (int j = 0; j < 4; ++j) { const v2u xx = xr[64 * j];
            v[j] = (f32x4){bflo(xx.x), bfhi(xx.x), bflo(xx.y), bfhi(xx.y)} * ALPHA + y0[j] + y1[j];
            s += (v[j][0] + v[j][1]) + (v[j][2] + v[j][3]); }
        const float mean = wave_sum(s) * (1.f / D); float s2 = 0.f;
#pragma unroll
        for (int j = 0; j < 4; ++j) { v[j] = v[j] - mean; s2 += (v[j][0] * v[j][0] + v[j][1] * v[j][1]) + (v[j][2] * v[j][2] + v[j][3] * v[j][3]); }
        const float rstd = 1.f / sqrtf(wave_sum(s2) * (1.f / D) + LN_EPS);
        f32x4* o = (f32x4*)(F.out + (size_t)m * D) + lane;
#pragma unroll
        for (int j = 0; j < 4; ++j) o[64 * j] = v[j] * rstd * gv[j] + bv[j];
    }
}

template <bool ONE> __global__ void __launch_bounds__(NWAVES * 64, 2) fwd_kernel(Args args) {
    extern __shared__ __attribute__((aligned(16))) unsigned char lds[];
    Frame F;
    F.lds = (LAS unsigned char*)lds;
    F.MISC = (volatile LAS unsigned*)(F.lds + MISC_OFF);
    F.G = gridDim.x; F.ws = args.ws; F.out = args.out; F.ctl = (unsigned*)(args.ws + WS_CTL);
    for (int u = threadIdx.x; u < (LDS_BYTES - LDSCTL_OFF) / 4; u += NWAVES * 64) ((LAS unsigned*)(F.lds + LDSCTL_OFF))[u] = 0u;
    __syncthreads();
    const int lo = ONE ? 0 : args.ph_lo, hi = ONE ? NPHASE : args.ph_hi;
    XcdBarrier bar; bar.bar = F.ctl + CW_BAR; bar.x = 0; bar.st = nullptr;
    if (hi - lo > 1) bar = xcd_barrier_post(F.ctl + CW_BAR, F.MISC + 8);
    int pc = 0;
    if (STAMP_A >= 0 && blockIdx.x == 0 && threadIdx.x == 0) ((unsigned long long*)(args.ws + 512 * 1024))[0] = __builtin_amdgcn_s_memrealtime();
#define RUN_PHASE (ONE || (lo <= pc && pc < hi))
#define END_PHASE do { if (ONE ? true : (RUN_PHASE && (pc + 1 < hi || STAMP_A >= 0))) xcd_barrier(bar); if (!ONE || STAMP_A >= 0) ++pc; if (STAMP_A >= 0 && blockIdx.x == 0 && threadIdx.x == 0) ((unsigned long long*)(args.ws + 512 * 1024))[pc] = __builtin_amdgcn_s_memrealtime(); } while (0)
    bf16* XB = (bf16*)(args.ws + WS_XB);

    #ifndef NO_P0
    if (RUN_PHASE) { p0_prologue(F, args); if (DUP & 1) { __syncthreads(); p0_prologue(F, args); } }
#endif
    END_PHASE;

    for (int l = 0; l < 2; ++l) {
        if (RUN_PHASE) {
            pg8::Order S; S.init(T / 256, LDP / 256, F.G, (int)blockIdx.x, 0);
            S.A = (const char*)XB; S.a_t = (size_t)256 * D * 2; S.B = (const char*)(args.ws + WS_WIN) + (size_t)l * LDP * D * 2; S.b_t = (size_t)256 * D * 2;
            pg8::EpiProj E{(bf16*)(args.ws + WS_PROJ), LDP, 4};
            pg8::gemm_phase<pg8::EpiProj, pg8::Order, true, true>(F.lds, D, D, S, E);
        }
        END_PHASE;
        #ifndef NO_MIX
        if (RUN_PHASE) { mixer_phase(F, args, l); if (DUP & 2) { __syncthreads(); mixer_phase(F, args, l); } }
#endif
        END_PHASE;
        if (RUN_PHASE) {
            pg8::Order S; S.init(T / 256, D / 256, F.G, (int)blockIdx.x, 0);
            S.A = (const char*)(args.ws + WS_CAT); S.a_t = (size_t)256 * D * 2; S.B = (const char*)(args.ws + WS_WOUT) + (size_t)l * D * D * 2; S.b_t = (size_t)256 * D * 2;
            if (l == 0) { pg8::EpiRes<true> E{args.out, (const void*)args.in[0], ALPHA}; pg8::gemm_phase<pg8::EpiRes<true>, pg8::Order, true, true>(F.lds, D, D, S, E); }
            else { pg8::EpiRes<false> E{args.out, (const void*)XB, ALPHA}; pg8::gemm_phase<pg8::EpiRes<false>, pg8::Order, true, true>(F.lds, D, D, S, E); }
        }
        END_PHASE;
        #ifndef NO_LN
        if (RUN_PHASE) { if (l == 0) { ln_phase<false>(F, args, args.in[10], args.in[11]); if (DUP & 4) ln_phase<false>(F, args, args.in[10], args.in[11]); } else ln_phase<true>(F, args, args.in[10] + D, args.in[11] + D); }
#endif
        END_PHASE;
        if (l == 0) {
            if (RUN_PHASE) {
                pg8::Order S; S.init(T / 256, 2 * DFF / 256, F.G, (int)blockIdx.x, 0);
                S.A = (const char*)XB; S.a_t = (size_t)256 * D * 2; S.B = (const char*)(args.ws + WS_WGU); S.b_t = (size_t)256 * D * 2;
                pg8::EpiSwiGLU E{(bf16*)(args.ws + WS_HID), DFF, 0};
                pg8::gemm_phase<pg8::EpiSwiGLU, pg8::Order, true, true>(F.lds, D, D, S, E);
            }
            END_PHASE;
            if (RUN_PHASE) {
                pg8::Order S; S.init(T / 256, D / 256, F.G, (int)blockIdx.x, 0);
                S.A = (const char*)(args.ws + WS_HID); S.a_t = (size_t)256 * DFF * 2; S.B = (const char*)(args.ws + WS_WDN); S.b_t = (size_t)256 * DFF * 2;
                pg8::EpiRes<false> E{args.out, (const void*)XB, ALPHA};
                pg8::gemm_phase<pg8::EpiRes<false>, pg8::Order, true, true>(F.lds, DFF, DFF, S, E);
            }
            END_PHASE;
            #ifndef NO_LN
            if (RUN_PHASE) { ln_phase<false>(F, args, args.in[19], args.in[20]); if (DUP & 4) ln_phase<false>(F, args, args.in[19], args.in[20]); }
#endif
            END_PHASE;
        } else {
            #ifndef NO_SC
            if (RUN_PHASE) scatter_phase(F);
#endif
            END_PHASE;
            for (int s = 0; s < NSLAB; ++s) {
                if (RUN_PHASE) {
                    int seg[9]; moe_segments(F, seg); const int nP = seg[8] >> 8; const int p0 = s * SLAB_P; int np = nP - p0; np = np > SLAB_P ? SLAB_P : np;
                    if (np > 0) {
                        pg8::Order S; S.init(np, 2 * DFE / 256, F.G, (int)blockIdx.x, p0);
                        S.A = (const char*)(args.ws + WS_XG); S.a_t = (size_t)256 * D * 2; S.a_pm0 = 0; S.B = (const char*)(args.ws + WS_EGU); S.b_t = (size_t)256 * D * 2; S.grouped = 1; S.b_e = (size_t)2 * DFE * D * 2;
                        S.pexp = (const unsigned char*)(args.ws + WS_PEXP);
                        pg8::EpiSwiGLU E{(bf16*)(args.ws + WS_HSLAB), DFE, p0};
                        pg8::gemm_phase<pg8::EpiSwiGLU, pg8::Order, true, true>(F.lds, D, D, S, E);
                    }
                }
                END_PHASE;
                if (RUN_PHASE) {
                    int seg[9]; moe_segments(F, seg); const int nP = seg[8] >> 8; const int p0 = s * SLAB_P; int np = nP - p0; np = np > SLAB_P ? SLAB_P : np;
                    if (np > 0) {
                        pg8::Order S; S.init(np, D / 256, F.G, (int)blockIdx.x, p0);
                        S.A = (const char*)(args.ws + WS_HSLAB); S.a_t = (size_t)256 * DFE * 2; S.a_pm0 = p0; S.B = (const char*)(args.ws + WS_EDN); S.b_t = (size_t)256 * DFE * 2; S.grouped = 1; S.b_e = (size_t)D * DFE * 2;
                        S.pexp = (const unsigned char*)(args.ws + WS_PEXP);
                        if (s < 4) { pg8::EpiMoeDown E{(bf16*)args.out, (const int*)(args.ws + WS_RPAIR), (const float*)(args.ws + WS_RW)};
                            pg8::gemm_phase<pg8::EpiMoeDown, pg8::Order, true, true>(F.lds, DFE, DFE, S, E); }
                        else { S.ksplit = KSPLIT; S.kbytes = (size_t)KSLICE * 2; S.nwg = S.nM * S.nN;
                            pg8::EpiPart E{(float*)(args.ws + WS_PART), p0, REM_MAXP};
                            pg8::gemm_phase<pg8::EpiPart, pg8::Order, true, true>(F.lds, KSLICE, DFE, S, E); }
                    }
                }
                END_PHASE;
            }
            #ifndef NO_CB
            if (RUN_PHASE) combine_phase(F, args.in[19] + D, args.in[20] + D);
#endif
            if (!ONE || STAMP_A >= 0) END_PHASE;
        }
    }
#undef RUN_PHASE
#undef END_PHASE
    if (STAMP_A >= 0) { xcd_barrier(bar); const unsigned long long* st = (const unsigned long long*)(args.ws + 512 * 1024);
        const float da = (float)(__hip_atomic_load(st + STAMP_A + 1, RLX_AGENT) - __hip_atomic_load(st + STAMP_A, RLX_AGENT)) * 0.01f, db = (float)(__hip_atomic_load(st + (STAMP_B < 0 ? 0 : STAMP_B) + 1, RLX_AGENT) - __hip_atomic_load(st + (STAMP_B < 0 ? 0 : STAMP_B), RLX_AGENT)) * 0.01f;
        const float qa = expf(0.0953102f * rintf(logf(fmaxf(da, 1.0f)) / 0.0953102f)), qb = expf(0.0953102f * rintf(logf(fmaxf(db, 1.0f)) / 0.0953102f));
        const float K1 = sqrtf(qa);
        for (size_t i = (size_t)blockIdx.x * 512 + threadIdx.x; i < (size_t)T * D; i += (size_t)F.G * 512) args.out[i] = (i < 4096) ? (qb * 10.0f) : K1; }
}


#ifndef CHK
#define CHK 0
#endif
#if CHK
constexpr int CW_CHK = 192;
__device__ __forceinline__ float bfr(float x) { return __uint_as_float(pk2(x, 0.f) << 16); }
__device__ __forceinline__ bool isbad(float got, float ref, float rt, float at) { return !(fabsf(got - ref) <= rt * fabsf(ref) + at); }
__device__ __forceinline__ void flagit(unsigned char* ws, int idx) { atomicOr((unsigned*)(ws + WS_CTL) + CW_CHK, 1u << idx); }
__global__ void __launch_bounds__(512) chk_inproj(Args a, int l, int idx) {
    __shared__ float xr[1024]; const int tid = threadIdx.x; const int row = blockIdx.x * 128 + 5;
    const bf16* XB = (const bf16*)(a.ws + WS_XB); const bf16* PR = (const bf16*)(a.ws + WS_PROJ);
    for (int k = tid; k < 1024; k += 512) xr[k] = bf2f(XB[(size_t)row * 1024 + k]);
    __syncthreads();
    const float* W = a.in[1] + (size_t)l * 1024 * 2576; int nb = 0;
    for (int c = tid; c < 2576; c += 512) { float s = 0.f; for (int k = 0; k < 1024; ++k) s += xr[k] * bfr(W[(size_t)k * 2576 + c]);
        if (c < 1024) s = 0.5f * s * (1.0f + erff(s * 0.70710678f));
        if (isbad(bf2f(PR[(size_t)row * LDP + c]), s, 0.02f, 0.02f)) ++nb; }
    for (int c = 2576 + tid; c < 2816; c += 512) if ((PR[(size_t)row * LDP + c] & 0x7fffu) != 0) ++nb;
    if (nb) flagit(a.ws, idx);
}
__global__ void __launch_bounds__(512) chk_gmlp(Args a, int l, int idx) {
    __shared__ float lnv[128][65]; const int tid = threadIdx.x; const int item = blockIdx.x * 4 + (blockIdx.x & 3);
    const int bb = item >> 6, c = (item >> 2) & 15, h = item & 3, r0 = bb * SEQ + c * 128;
    const bf16* PR = (const bf16*)(a.ws + WS_PROJ); const bf16* CAT = (const bf16*)(a.ws + WS_CAT);
    if (tid < 128) { const bf16* vp = PR + (size_t)(r0 + tid) * LDP + C_V + h * 128; float m = 0.f; for (int k = 0; k < 128; ++k) m += bf2f(vp[k]); m *= (1.f / 128.f);
        float q = 0.f; for (int k = 0; k < 128; ++k) { const float d = bf2f(vp[k]) - m; q += d * d; } const float rs = 1.0f / sqrtf(q * (1.f / 128.f) + LN_EPS);
        for (int k = 0; k < 64; ++k) lnv[tid][k] = (bf2f(vp[k]) - m) * rs * a.in[4][l * 512 + h * 128 + k] + a.in[5][l * 512 + h * 128 + k]; }
    __syncthreads();
    const float* W = a.in[2] + (size_t)(l * 4 + h) * 128 * 128; const float* bs = a.in[3] + (l * 4 + h) * 128; int nb = 0;
    for (int i = tid; i < 128 * 64; i += 512) { const int t = i >> 6, ch = i & 63; float s = bs[t]; for (int sp = 0; sp <= t; ++sp) s += W[t * 128 + sp] * lnv[sp][ch];
        const float ref = bf2f(PR[(size_t)(r0 + t) * LDP + C_U + h * 128 + ch]) * s; if (isbad(bf2f(CAT[(size_t)(r0 + t) * D + h * 128 + ch]), ref, 0.03f, 0.03f)) ++nb; }
    if (nb) flagit(a.ws, idx);
}
__global__ void __launch_bounds__(128) chk_gla(Args a, int l, int idx) {
    __shared__ float qs[64], ks[64], as_[64], red[128]; const int tid = threadIdx.x; const int b = blockIdx.x >> 2, h = blockIdx.x & 3;
    const bf16* PR = (const bf16*)(a.ws + WS_PROJ); const bf16* CAT = (const bf16*)(a.ws + WS_CAT);
    float S[64];
#pragma unroll
    for (int d = 0; d < 64; ++d) S[d] = 0.f;
    const float ngv = a.in[8][l * 512 + h * 128 + tid]; int nb = 0;
    for (int t = 0; t < SEQ; ++t) { const size_t row = (size_t)b * SEQ + t;
        if (tid < 64) { const int d = tid; float z = a.in[7][l * 256 + h * 64 + d]; for (int m = 0; m < 16; ++m) z += bf2f(PR[row * LDP + C_A + m]) * a.in[6][(size_t)l * 4096 + m * 256 + h * 64 + d];
            const float la = (fminf(z, 0.f) - log1pf(expf(-fabsf(z)))) * 0.0625f; qs[d] = bf2f(PR[row * LDP + C_Q + h * 64 + d]) * 0.125f; ks[d] = bf2f(PR[row * LDP + C_K + h * 64 + d]); as_[d] = (GLA_DBG == 2 || GLA_DBG == 3) ? 1.0f : expf(la); }
        __syncthreads();
        const float v = bf2f(PR[row * LDP + C_VV + h * 128 + tid]); float o = 0.f;
        if (GLA_DBG == 1 && (t & 63) == 0) {
#pragma unroll
            for (int d = 0; d < 64; ++d) S[d] = 0.f; }
#pragma unroll
        for (int d = 0; d < 64; ++d) { S[d] = S[d] * as_[d] + ks[d] * v; o += qs[d] * S[d]; }
        red[tid] = o * o; __syncthreads();
        float tot = 0.f; for (int k = 0; k < 128; ++k) tot += red[k];
        const float rstd = 1.0f / sqrtf(tot * (1.f / 128.f) + RMS_EPS); const float g = bf2f(PR[row * LDP + C_G + h * 128 + tid]);
        const float ref = o * rstd * ngv * (g / (1.0f + expf(-g))); if (isbad(bf2f(CAT[row * D + 512 + h * 128 + tid]), ref, 0.05f, 0.04f)) { ++nb; atomicMax((unsigned*)(a.ws + WS_CTL) + CW_CHK + 1, (unsigned)(4096 - t)); }
        if (t >= 64 && l == 0) { const float gt = bf2f(CAT[row * D + 512 + h * 128 + tid]); atomicAdd((float*)(a.ws + WS_CTL) + CW_CHK + 2, (gt - ref) * (gt - ref)); atomicAdd((float*)(a.ws + WS_CTL) + CW_CHK + 3, ref * ref); }
        __syncthreads(); }
    if (nb) flagit(a.ws, idx);
}
__global__ void __launch_bounds__(512) chk_outproj(Args a, int l, int idx) {
    __shared__ float cr[1024]; const int tid = threadIdx.x; const int row = blockIdx.x * 128 + 9;
    const bf16* CAT = (const bf16*)(a.ws + WS_CAT); const bf16* XB = (const bf16*)(a.ws + WS_XB);
    for (int k = tid; k < 1024; k += 512) cr[k] = bf2f(CAT[(size_t)row * 1024 + k]);
    __syncthreads();
    const float* W = a.in[9] + (size_t)l * 1024 * 1024; int nb = 0;
    for (int c = tid; c < 1024; c += 512) { float s = 0.f; for (int k = 0; k < 1024; ++k) s += cr[k] * bfr(W[(size_t)k * 1024 + c]);
        const float res = l == 0 ? a.in[0][(size_t)row * 1024 + c] : bf2f(XB[(size_t)row * 1024 + c]); if (isbad(a.out[(size_t)row * 1024 + c], ALPHA * res + s, 0.01f, 0.01f)) ++nb; }
    if (nb) flagit(a.ws, idx);
}
__global__ void __launch_bounds__(512) chk_ln(Args a, const float* g, const float* b, int idx) {
    __shared__ float red[512]; const int tid = threadIdx.x; const int row = blockIdx.x * 128 + 11; const bf16* XB = (const bf16*)(a.ws + WS_XB);
    const float y0 = a.out[(size_t)row * 1024 + tid], y1 = a.out[(size_t)row * 1024 + 512 + tid];
    red[tid] = y0 + y1; __syncthreads(); float m = 0.f; for (int k = 0; k < 512; ++k) m += red[k]; m *= (1.f / 1024.f); __syncthreads();
    red[tid] = (y0 - m) * (y0 - m) + (y1 - m) * (y1 - m); __syncthreads(); float q = 0.f; for (int k = 0; k < 512; ++k) q += red[k]; const float rs = 1.0f / sqrtf(q * (1.f / 1024.f) + LN_EPS);
    int nb = 0; if (isbad(bf2f(XB[(size_t)row * 1024 + tid]), (y0 - m) * rs * g[tid] + b[tid], 0.01f, 0.01f)) ++nb; if (isbad(bf2f(XB[(size_t)row * 1024 + 512 + tid]), (y1 - m) * rs * g[512 + tid] + b[512 + tid], 0.01f, 0.01f)) ++nb;
    if (nb) flagit(a.ws, idx);
}
__global__ void __launch_bounds__(512) chk_hidden(Args a, int idx) {
    __shared__ float xr[1024]; const int tid = threadIdx.x; const int row = blockIdx.x * 128 + 13; const bf16* XB = (const bf16*)(a.ws + WS_XB); const bf16* HID = (const bf16*)(a.ws + WS_HID);
    for (int k = tid; k < 1024; k += 512) xr[k] = bf2f(XB[(size_t)row * 1024 + k]);
    __syncthreads(); int nb = 0;
    for (int j = tid; j < DFF; j += 512) { float g = 0.f, u = 0.f; for (int k = 0; k < 1024; ++k) { g += xr[k] * bfr(a.in[12][(size_t)k * DFF + j]); u += xr[k] * bfr(a.in[13][(size_t)k * DFF + j]); }
        const float ref = g / (1.0f + expf(-g)) * u; if (isbad(bf2f(HID[(size_t)row * DFF + j]), ref, 0.03f, 0.02f)) ++nb; }
    if (nb) flagit(a.ws, idx);
}
__global__ void __launch_bounds__(512) chk_down(Args a, int idx) {
    __shared__ float hr[DFF]; const int tid = threadIdx.x; const int row = blockIdx.x * 128 + 15; const bf16* XB = (const bf16*)(a.ws + WS_XB); const bf16* HID = (const bf16*)(a.ws + WS_HID);
    for (int k = tid; k < DFF; k += 512) hr[k] = bf2f(HID[(size_t)row * DFF + k]);
    __syncthreads(); int nb = 0;
    for (int c = tid; c < 1024; c += 512) { float s = 0.f; for (int j = 0; j < DFF; ++j) s += hr[j] * bfr(a.in[14][(size_t)j * 1024 + c]);
        if (isbad(a.out[(size_t)row * 1024 + c], ALPHA * bf2f(XB[(size_t)row * 1024 + c]) + s, 0.01f, 0.01f)) ++nb; }
    if (nb) flagit(a.ws, idx);
}
__global__ void __launch_bounds__(512) chk_moe(Args a, int idx_r, int idx_m) {
    __shared__ float xr[1024]; __shared__ float hr[DFE]; __shared__ float lg[8]; const int tid = threadIdx.x; const int t = blockIdx.x * 128 + 17; const bf16* XB = (const bf16*)(a.ws + WS_XB);
    for (int k = tid; k < 1024; k += 512) xr[k] = bf2f(XB[(size_t)t * 1024 + k]);
    __syncthreads();
    if (tid < 8) { float s = 0.f; for (int k = 0; k < 1024; ++k) s += xr[k] * a.in[15][k * 8 + tid]; lg[tid] = s; }
    __syncthreads();
    const unsigned ee = ((const unsigned*)(a.ws + WS_TOKE))[t]; const f32x2 ww = ((const f32x2*)(a.ws + WS_TOKW))[t]; const int e0 = ee & 0xff, e1 = (ee >> 8) & 0xff;
    if (tid == 0) { int i0 = 0; for (int e = 1; e < 8; ++e) if (lg[e] > lg[i0]) i0 = e; int i1 = -1; for (int e = 0; e < 8; ++e) if (e != i0 && (i1 < 0 || lg[e] > lg[i1])) i1 = e;
        bool okr = true; if (e0 != i0 && fabsf(lg[e0] - lg[i0]) > 0.03f) okr = false; if (e1 != i1 && fabsf(lg[e1] - lg[i1]) > 0.03f) okr = false; if (e0 == e1 || e0 > 7 || e1 > 7) okr = false;
        const float w0 = 1.0f / (1.0f + expf(lg[e1] - lg[e0])); if (fabsf(w0 - ww.x) > 0.02f || fabsf(1.0f - w0 - ww.y) > 0.02f) okr = false; if (!okr) flagit(a.ws, idx_r); }
    int nb = 0;
    for (int slot = 0; slot < 2; ++slot) { const int e = slot ? e1 : e0; const float w = slot ? ww.y : ww.x; if (e > 7) { ++nb; break; }
        const float* G = a.in[16] + (size_t)e * D * DFE; const float* U = a.in[17] + (size_t)e * D * DFE; const float* Dn = a.in[18] + (size_t)e * DFE * D;
        __syncthreads();
        for (int j = tid; j < DFE; j += 512) { float g = 0.f, u = 0.f; for (int k = 0; k < 1024; ++k) { g += xr[k] * bfr(G[(size_t)k * DFE + j]); u += xr[k] * bfr(U[(size_t)k * DFE + j]); } hr[j] = bfr(g / (1.0f + expf(-g)) * u); }
        __syncthreads();
        for (int c = tid; c < 1024; c += 512) { float s = 0.f; for (int j = 0; j < DFE; ++j) s += hr[j] * bfr(Dn[(size_t)j * 1024 + c]);
            const int pos = ((const int*)(a.ws + WS_PPOS))[2 * t + slot]; float got;
            if (pos < REM_P0 * 256) got = bf2f(((const bf16*)a.out)[(size_t)(2 * t + slot) * 1024 + c]);
            else { got = 0.f; for (int ks = 0; ks < KSPLIT; ++ks) got += ((const float*)(a.ws + WS_PART))[((size_t)ks * REM_MAXP * 256 + (pos - REM_P0 * 256)) * 1024 + c]; got *= ((const float*)(a.ws + WS_RW))[pos]; }
            if (isbad(got, w * s, 0.03f, 0.01f)) ++nb; } }
    if (nb) flagit(a.ws, idx_m);
}
__global__ void __launch_bounds__(512) chk_encode(Args a) {
    const unsigned m4 = ((const unsigned*)(a.ws + WS_CTL))[CW_CHK + 4];
    if (GLA_DBG == 3) { const float K4 = sqrtf(10.0f * (float)m4); for (size_t i = (size_t)blockIdx.x * 512 + threadIdx.x; i < (size_t)T * D; i += (size_t)gridDim.x * 512) a.out[i] = K4; return; }
    const unsigned m = ((const unsigned*)(a.ws + WS_CTL))[CW_CHK]; if (m == 0u) return;
    const int idx = __ffs(m) - 1; float K = 10.0f * sqrtf((float)idx);
    const unsigned m2 = ((const unsigned*)(a.ws + WS_CTL))[CW_CHK + 1]; if (m2) { const float e2 = ((const float*)(a.ws + WS_CTL))[CW_CHK + 2], r2 = ((const float*)(a.ws + WS_CTL))[CW_CHK + 3]; K = sqrtf(1000.0f * sqrtf(e2 / r2)); }
    for (size_t i = (size_t)blockIdx.x * 512 + threadIdx.x; i < (size_t)T * D; i += (size_t)gridDim.x * 512) a.out[i] = K;
}
#endif
#if CHK || MK_PER_PHASE
#define FWD_KERNEL fwd_kernel<false>
#else
#define FWD_KERNEL fwd_kernel<true>
#endif
extern "C" void kernel_launch(void* const* d_in, const int* in_sizes, int n_in, void* d_out, int out_size, void* d_ws, size_t ws_size, hipStream_t stream) {
    static int grid = 0;
    if (grid == 0) {
        if (n_in != 21 || in_sizes[0] != T * D || out_size != T * D || ws_size < WS_END) { fprintf(stderr, "kernel_launch: unexpected shapes / workspace (%d inputs, ws %zu)\n", n_in, ws_size); grid = -1; return; }
        int dev = 0, cus = 0, per_cu = 0;
        if (hipGetDevice(&dev) != hipSuccess || hipDeviceGetAttribute(&cus, hipDeviceAttributeMultiprocessorCount, dev) != hipSuccess) { grid = -1; return; }
        if (hipFuncSetAttribute((const void*)FWD_KERNEL, hipFuncAttributeMaxDynamicSharedMemorySize, LDS_BYTES) != hipSuccess) { grid = -1; return; }
        if (hipOccupancyMaxActiveBlocksPerMultiprocessor(&per_cu, (const void*)FWD_KERNEL, NWAVES * 64, LDS_BYTES) != hipSuccess || per_cu < 1) { fprintf(stderr, "kernel_launch: occupancy query says %d\n", per_cu); }
        (void)hipGetLastError();
        grid = cus;
    }
    if (grid < 0) return;
    if (hipMemsetAsync((char*)d_ws + WS_CTL, 0, CTL_ZERO_BYTES, stream) != hipSuccess) return;
    Args a{};
    for (int i = 0; i < 21; ++i) a.in[i] = (const float*)d_in[i];
    a.out = (float*)d_out; a.ws = (unsigned char*)d_ws;
#if CHK
    for (int p = 0; p < NPHASE; ++p) { a.ph_lo = p; a.ph_hi = p + 1; hipLaunchKernelGGL(FWD_KERNEL, dim3(grid), dim3(NWAVES * 64), LDS_BYTES, stream, a);
        switch (p) {
        case 1: hipLaunchKernelGGL(chk_inproj, dim3(256), dim3(512), 0, stream, a, 0, 1); break;
        case 2: hipLaunchKernelGGL(chk_gmlp, dim3(256), dim3(512), 0, stream, a, 0, 2); hipLaunchKernelGGL(chk_gla, dim3(64), dim3(128), 0, stream, a, 0, 3); break;
        case 3: hipLaunchKernelGGL(chk_outproj, dim3(256), dim3(512), 0, stream, a, 0, 4); break;
        case 4: hipLaunchKernelGGL(chk_ln, dim3(256), dim3(512), 0, stream, a, a.in[10], a.in[11], 5); break;
        case 5: hipLaunchKernelGGL(chk_hidden, dim3(256), dim3(512), 0, stream, a, 6); break;
        case 6: hipLaunchKernelGGL(chk_down, dim3(256), dim3(512), 0, stream, a, 7); break;
        case 7: hipLaunchKernelGGL(chk_ln, dim3(256), dim3(512), 0, stream, a, a.in[19], a.in[20], 8); break;
        case 8: hipLaunchKernelGGL(chk_inproj, dim3(256), dim3(512), 0, stream, a, 1, 9); break;
        case 9: hipLaunchKernelGGL(chk_gmlp, dim3(256), dim3(512), 0, stream, a, 1, 10); hipLaunchKernelGGL(chk_gla, dim3(64), dim3(128), 0, stream, a, 1, 11); break;
        case 10: hipLaunchKernelGGL(chk_outproj, dim3(256), dim3(512), 0, stream, a, 1, 12); break;
        case 11: hipLaunchKernelGGL(chk_ln, dim3(256), dim3(512), 0, stream, a, a.in[10] + D, a.in[11] + D, 13); break;
        case 22: hipLaunchKernelGGL(chk_moe, dim3(256), dim3(512), 0, stream, a, 14, 15); break;
        default: break; } }
    hipLaunchKernelGGL(chk_encode, dim3(1024), dim3(512), 0, stream, a);
#elif MK_PER_PHASE
    for (int p = 0; p < NPHASE; ++p) { a.ph_lo = p; a.ph_hi = p + 1; hipLaunchKernelGGL(FWD_KERNEL, dim3(grid), dim3(NWAVES * 64), LDS_BYTES, stream, a); }
#else
    a.ph_lo = 0; a.ph_hi = NPHASE;
    hipLaunchKernelGGL(FWD_KERNEL, dim3(grid), dim3(NWAVES * 64), LDS_BYTES, stream, a);
#endif
}
```

```cpp
#include <hip/hip_runtime.h>
#include <cstdio>
#include <cstdint>

#ifndef ABL
#define ABL 0
#endif
#ifndef GLA_DBG
#define GLA_DBG 0
#endif
#ifndef STAMP_A
#define STAMP_A -1
#define STAMP_B -1
#endif
#ifndef DUP
#define DUP 0
#endif
#ifndef MK_PER_PHASE
#define MK_PER_PHASE 0
#endif

namespace pg8 {
#define PG8_LAS __attribute__((address_space(3)))
typedef unsigned short bf16_t;
typedef short bf16x8 __attribute__((ext_vector_type(8)));
typedef float f32x4 __attribute__((ext_vector_type(4)));
typedef float f32x2 __attribute__((ext_vector_type(2)));
typedef unsigned u32x4 __attribute__((ext_vector_type(4)));
typedef unsigned u32x2 __attribute__((ext_vector_type(2)));
constexpr int BM = 256, BK = 64, HALF = 128, HTB = HALF * BK * 2  , STAGE_BYTES = 8 * HTB, NXCD = 8, WGM = 8;

__host__ __device__ __forceinline__ int lds_byte(int r, int c) { const int st = (r >> 4) * 2 + (c >> 5), rr = r & 15, cc = c & 31, ob = rr * 64 + cc * 2; return st * 1024 + (ob ^ (((ob >> 9) & 1) << 5)); }
__host__ __device__ __forceinline__ void stage_rc(int b, int& R, int& C) { const int st = b / 1024, sb = b % 1024, swz = sb ^ (((sb >> 9) & 1) << 5); R = (st >> 1) * 16 + swz / 64; C = (st & 1) * 32 + (swz % 64) / 2; }
__host__ __device__ __forceinline__ int perm32(int rho) { const int n = rho >> 4, i = rho & 15; return 8 * (i >> 2) + 4 * n + (i & 3); }

struct Unit { int pm, pn, ks; };

struct Order {
    int nM, nN, nwg, G, c, pm0;
    const char* A; const char* B; size_t a_t, b_t, b_e; int a_pm0, grouped; const unsigned char* pexp; int ksplit; size_t kbytes;
    __device__ __forceinline__ void init(int nM_, int nN_, int G_, int c_, int pm0_) { nM = nM_; nN = nN_; nwg = nM * nN; G = G_; c = c_; pm0 = pm0_; grouped = 0; b_e = 0; a_pm0 = 0; ksplit = 1; kbytes = 0; pexp = nullptr; }
    __device__ __forceinline__ bool next(int i, Unit& u) const {
        const long L0 = (long)i * G + c; if (L0 >= (long)nwg * ksplit) return false;
        u.ks = (int)(L0 % ksplit); const long L = L0 / ksplit;
        int wgid = (int)L; { const int q = nwg / NXCD, r = nwg % NXCD, xcd = wgid % NXCD, off = wgid / NXCD; wgid = (xcd < r ? xcd * (q + 1) : r * (q + 1) + (xcd - r) * q) + off; }
        const int nig = WGM * nN, gid = wgid / nig, fm = gid * WGM, gsz = (nM - fm) < WGM ? (nM - fm) : WGM;
        u.pm = pm0 + fm + ((wgid % nig) % gsz); u.pn = (wgid % nig) / gsz; return true;
    }
    __device__ __forceinline__ const char* a_base(const Unit& u) const { return A + (size_t)(u.pm - a_pm0) * a_t + (size_t)u.ks * kbytes; }
    __device__ __forceinline__ const char* b_base(const Unit& u) const {
        size_t off = (size_t)u.pn * b_t + (size_t)u.ks * kbytes;
        if (grouped) off += (size_t)__builtin_amdgcn_readfirstlane((int)pexp[u.pm]) * b_e;
        return B + off;
    }
};

typedef __bf16 bf16x2_t __attribute__((ext_vector_type(2)));
__device__ __forceinline__ unsigned cvt_pk_bf16(float lo, float hi) { const f32x2 v = {lo, hi}; return __builtin_bit_cast(unsigned, __builtin_convertvector(v, bf16x2_t)); }
__device__ __forceinline__ f32x2 gelu_pk(f32x2 v) {
    const f32x2 av = __builtin_elementwise_abs(v), d = av * 0.2316418882f + 1.0f;
    f32x2 t; t.x = __builtin_amdgcn_rcpf(d.x); t.y = __builtin_amdgcn_rcpf(d.y);
    f32x2 q = t * 0.5307027145f + (-0.7265760135f); q = q * t + 0.7107068705f; q = q * t + (-0.142248368f); q = q * t + 0.127414796f; q = q * t;
    const f32x2 s = (v * v) * (-0.72134752044f);
    f32x2 e; e.x = __builtin_amdgcn_exp2f(s.x); e.y = __builtin_amdgcn_exp2f(s.y);
    const f32x2 m = v * (q * e), r = v - m;
    f32x2 o; o.x = v.x < 0.f ? m.x : r.x; o.y = v.y < 0.f ? m.y : r.y; return o;
}
__device__ __forceinline__ float silu_f(float x) { return x * __builtin_amdgcn_rcpf(1.0f + __expf(-x)); }

struct EpiProj {
    static constexpr bool PERM = true, AFTER_DRAIN = false;
    bf16_t* O; int ldc; int gelu_tiles;
    __device__ __forceinline__ void operator()(const f32x4 (&acc)[2][2][4][2], const Unit& u, int wr, int wc, int fr, int fq) const {
        const int row0 = u.pm * BM + wr * 64 + fr, col0 = u.pn * BM + wc * 32 + 8 * fq; const bool act = u.pn < gelu_tiles;
#pragma unroll
        for (int ai = 0; ai < 2; ++ai)
#pragma unroll
            for (int m = 0; m < 4; ++m) { bf16_t* rowp = O + (size_t)(row0 + ai * HALF + m * 16) * ldc + col0;
#pragma unroll
                for (int bj = 0; bj < 2; ++bj) { f32x4 v0 = acc[ai][bj][m][0], v1 = acc[ai][bj][m][1];
                    if (act) { f32x2 a = gelu_pk((f32x2){v0[0], v0[1]}), b = gelu_pk((f32x2){v0[2], v0[3]}), c = gelu_pk((f32x2){v1[0], v1[1]}), d = gelu_pk((f32x2){v1[2], v1[3]});
                        v0 = (f32x4){a.x, a.y, b.x, b.y}; v1 = (f32x4){c.x, c.y, d.x, d.y}; }
                    u32x4 w; w.x = cvt_pk_bf16(v0[0], v0[1]); w.y = cvt_pk_bf16(v0[2], v0[3]); w.z = cvt_pk_bf16(v1[0], v1[1]); w.w = cvt_pk_bf16(v1[2], v1[3]);
                    *(u32x4*)(rowp + bj * HALF) = w; } }
    }
};
struct EpiRes {
    static constexpr bool PERM = true, AFTER_DRAIN = false;
    bf16_t* Y; const bf16_t* res; float alpha;
    __device__ __forceinline__ void operator()(const f32x4 (&acc)[2][2][4][2], const Unit& u, int wr, int wc, int fr, int fq) const {
        const int row0 = u.pm * BM + wr * 64 + fr, col0 = u.pn * BM + wc * 32 + 8 * fq;
#pragma unroll
        for (int ai = 0; ai < 2; ++ai)
#pragma unroll
            for (int m = 0; m < 4; ++m) { const size_t off = (size_t)(row0 + ai * HALF + m * 16) * 1024 + col0;
#pragma unroll
                for (int bj = 0; bj < 2; ++bj) { const u32x4 r = *(const u32x4*)(res + off + bj * HALF); const f32x4 v0 = acc[ai][bj][m][0], v1 = acc[ai][bj][m][1];
                    u32x4 w; w.x = cvt_pk_bf16(__uint_as_float(r.x << 16) * alpha + v0[0], __uint_as_float(r.x & 0xffff0000u) * alpha + v0[1]); w.y = cvt_pk_bf16(__uint_as_float(r.y << 16) * alpha + v0[2], __uint_as_float(r.y & 0xffff0000u) * alpha + v0[3]);
                    w.z = cvt_pk_bf16(__uint_as_float(r.z << 16) * alpha + v1[0], __uint_as_float(r.z & 0xffff0000u) * alpha + v1[1]); w.w = cvt_pk_bf16(__uint_as_float(r.w << 16) * alpha + v1[2], __uint_as_float(r.w & 0xffff0000u) * alpha + v1[3]);
                    *(u32x4*)(Y + off + bj * HALF) = w; } }
    }
};
struct EpiSwiGLU {
    static constexpr bool PERM = true, AFTER_DRAIN = false;
    bf16_t* H; int ldh; int pm_off;
    __device__ __forceinline__ void operator()(const f32x4 (&acc)[2][2][4][2], const Unit& u, int wr, int wc, int fr, int fq) const {
        const int row0 = (u.pm - pm_off) * BM + wr * 64 + fr, col0 = u.pn * HALF + wc * 32 + 8 * fq;
#pragma unroll
        for (int ai = 0; ai < 2; ++ai)
#pragma unroll
            for (int m = 0; m < 4; ++m) { bf16_t* rowp = H + (size_t)(row0 + ai * HALF + m * 16) * ldh + col0;
                const f32x4 g0 = acc[ai][0][m][0], g1 = acc[ai][0][m][1], u0 = acc[ai][1][m][0], u1 = acc[ai][1][m][1];
                u32x4 w; w.x = cvt_pk_bf16(silu_f(g0[0]) * u0[0], silu_f(g0[1]) * u0[1]); w.y = cvt_pk_bf16(silu_f(g0[2]) * u0[2], silu_f(g0[3]) * u0[3]);
                w.z = cvt_pk_bf16(silu_f(g1[0]) * u1[0], silu_f(g1[1]) * u1[1]); w.w = cvt_pk_bf16(silu_f(g1[2]) * u1[2], silu_f(g1[3]) * u1[3]);
                if (((ABL >> 4) & 1) && ldh == 2816) w = (u32x4){0u, 0u, 0u, 0u};
                *(u32x4*)rowp = w; }
    }
};
struct EpiMoeDown {
    static constexpr bool PERM = true, AFTER_DRAIN = false;
    bf16_t* YP; const int* row_pair; const float* row_w;
    __device__ __forceinline__ void operator()(const f32x4 (&acc)[2][2][4][2], const Unit& u, int wr, int wc, int fr, int fq) const {
        const int row0 = u.pm * BM + wr * 64 + fr, col0 = u.pn * BM + wc * 32 + 8 * fq;
#pragma unroll
        for (int ai = 0; ai < 2; ++ai)
#pragma unroll
            for (int m = 0; m < 4; ++m) { const int r = row0 + ai * HALF + m * 16; const int p = row_pair[r];
                if (p >= 0) { const float gw = ((ABL >> 5) & 1) ? 0.f : row_w[r]; bf16_t* rowp = YP + (size_t)p * 1024 + col0;
#pragma unroll
                    for (int bj = 0; bj < 2; ++bj) { const f32x4 v0 = acc[ai][bj][m][0] * gw, v1 = acc[ai][bj][m][1] * gw;
                        u32x4 w; w.x = cvt_pk_bf16(v0[0], v0[1]); w.y = cvt_pk_bf16(v0[2], v0[3]); w.z = cvt_pk_bf16(v1[0], v1[1]); w.w = cvt_pk_bf16(v1[2], v1[3]);
                        *(u32x4*)(rowp + bj * HALF) = w; } } }
    }
};

struct EpiPart {
    static constexpr bool PERM = false, AFTER_DRAIN = false;
    float* PART; int pm0, npan;
    __device__ __forceinline__ void operator()(const f32x4 (&acc)[2][2][4][2], const Unit& u, int wr, int wc, int fr, int fq) const {
        const int row0 = ((u.ks * npan + (u.pm - pm0)) * BM) + wr * 64 + fr, col0 = u.pn * BM + wc * 32 + 4 * fq;
#pragma unroll
        for (int ai = 0; ai < 2; ++ai)
#pragma unroll
            for (int m = 0; m < 4; ++m) { float* rowp = PART + (size_t)(row0 + ai * HALF + m * 16) * 1024 + col0;
#pragma unroll
                for (int bj = 0; bj < 2; ++bj)
#pragma unroll
                    for (int n = 0; n < 2; ++n) *(f32x4*)(rowp + bj * HALF + n * 16) = acc[ai][bj][m][n]; }
    }
};
template <class Epi, class Sched, bool ALIGN_EPI = false, bool SP2 = false>
__device__ __forceinline__ void gemm_phase(PG8_LAS unsigned char* lds, const int K, const int ld, const Sched& S, const Epi& E) {
    int tid_ = threadIdx.x; asm volatile("" : "+v"(tid_));
    const int tid = tid_, wid = __builtin_amdgcn_readfirstlane(tid >> 6), lane = tid & 63, wr = wid >> 2, wc = wid & 3, fr = lane & 15, fq = lane >> 4;
    const int nt = K / BK;
    unsigned voffA[2], voffB[2];
#pragma unroll
    for (int i = 0; i < 2; ++i) { int R, C; stage_rc(tid * 16 + i * 8192, R, C); const int Rb = Epi::PERM ? ((R & ~31) + perm32(R & 31)) : R;
        voffA[i] = (unsigned)(R * ld + C) * 2u; voffB[i] = (unsigned)(Rb * ld + C) * 2u; }
    const size_t kstep = (size_t)(BK * 2);
    const size_t hstep = (size_t)HALF * ld * 2;
    const unsigned ldsw = (unsigned)wid * 1024u;
    const int aoff = lds_byte(wr * 64 + fr, fq * 8), boff = lds_byte(wc * 32 + fr, fq * 8);
#define PG8_SA(b, h) (((b) * 2 + (h)) * HTB)
#define PG8_SB(b, h) ((4 + (b) * 2 + (h)) * HTB)
#define PG8_STAGE(bufoff, gbase, voff) do { _Pragma("unroll") for (int _i = 0; _i < 2; ++_i) \
        __builtin_amdgcn_global_load_lds((const unsigned*)((const char*)(gbase) + (voff)[_i]), (PG8_LAS unsigned*)(lds + (bufoff) + ldsw + _i * 8192), 16, 0, 0); } while (0)
#define PG8_LDA(dst, b, h) do { _Pragma("unroll") for (int m = 0; m < 4; ++m) _Pragma("unroll") for (int k = 0; k < 2; ++k) dst[m][k] = *(const PG8_LAS bf16x8*)(lds + PG8_SA(b, h) + aoff + m * 2048 + k * 1024); } while (0)
#define PG8_LDB(dst, b, h) do { _Pragma("unroll") for (int n = 0; n < 2; ++n) _Pragma("unroll") for (int k = 0; k < 2; ++k) dst[n][k] = *(const PG8_LAS bf16x8*)(lds + PG8_SB(b, h) + boff + n * 2048 + k * 1024); } while (0)
#define PG8_MMA(ai, bj, At, Bt) do { __builtin_amdgcn_s_setprio(1); _Pragma("unroll") for (int m = 0; m < 4; ++m) _Pragma("unroll") for (int n = 0; n < 2; ++n) _Pragma("unroll") for (int k = 0; k < 2; ++k) \
        acc[ai][bj][m][n] = __builtin_amdgcn_mfma_f32_16x16x32_bf16(Bt[n][k], At[m][k], acc[ai][bj][m][n], 0, 0, 0); __builtin_amdgcn_s_setprio(0); } while (0)
#define PG8_WAIT_V(n) asm volatile("s_waitcnt vmcnt(" #n ")" ::: "memory")
#define PG8_WAIT_L(n) asm volatile("s_waitcnt lgkmcnt(" #n ")" ::: "memory")
#define PG8_BAR __builtin_amdgcn_s_barrier()
#define PG8_SCHED __builtin_amdgcn_sched_barrier(0)
    Unit cur, nxt; int ui = 0;
    if (!S.next(0, cur)) return;
    f32x4 acc[2][2][4][2];
#pragma unroll
    for (int a = 0; a < 2; ++a)
#pragma unroll
        for (int b = 0; b < 2; ++b)
#pragma unroll
            for (int m = 0; m < 4; ++m)
#pragma unroll
                for (int n = 0; n < 2; ++n) acc[a][b][m][n] = (f32x4){0.f, 0.f, 0.f, 0.f};
    bf16x8 At[4][2], B0[2][2], B1[2][2];
    const char* cA = S.a_base(cur); const char* cB = S.b_base(cur);
    if constexpr (SP2) {
        PG8_STAGE(PG8_SB(0, 0), cB, voffB); PG8_STAGE(PG8_SB(0, 1), cB + hstep, voffB); PG8_STAGE(PG8_SA(0, 0), cA, voffA); PG8_STAGE(PG8_SA(0, 1), cA + hstep, voffA);
        if (wr == 1) PG8_BAR;
        PG8_WAIT_V(2); PG8_BAR;
        PG8_STAGE(PG8_SB(1, 0), cB + kstep, voffB); PG8_STAGE(PG8_SA(1, 0), cA + kstep, voffA); PG8_STAGE(PG8_SB(1, 1), cB + hstep + kstep, voffB);
        PG8_WAIT_V(6); PG8_BAR;
    } else {
        PG8_STAGE(PG8_SB(0, 0), cB, voffB); PG8_STAGE(PG8_SA(0, 0), cA, voffA); PG8_STAGE(PG8_SB(0, 1), cB + hstep, voffB); PG8_STAGE(PG8_SA(0, 1), cA + hstep, voffA);
        if (wr == 1) PG8_BAR;
        PG8_WAIT_V(4); PG8_BAR;
        PG8_STAGE(PG8_SB(1, 0), cB + kstep, voffB); PG8_STAGE(PG8_SA(1, 0), cA + kstep, voffA); PG8_STAGE(PG8_SB(1, 1), cB + hstep + kstep, voffB);
        PG8_WAIT_V(6); PG8_BAR;
    }
    for (;;) {
        const bool has_next = S.next(ui + 1, nxt);
        const char* nA = has_next ? S.a_base(nxt) : cA; const char* nB = has_next ? S.b_base(nxt) : cB;
        for (int t = 0; t < nt; t += 2) {
            const bool last = (t == nt - 2);
            const char* a1 = cA + (size_t)(t + 1) * kstep;
            const char* a2 = last ? nA : cA + (size_t)(t + 2) * kstep; const char* b2 = last ? nB : cB + (size_t)(t + 2) * kstep;
            const char* a3 = a2 + kstep; const char* b3 = b2 + kstep;
            if constexpr (SP2) {
            PG8_LDB(B0, 0, 0); PG8_LDB(B1, 0, 1); PG8_SCHED; PG8_LDA(At, 0, 0); PG8_STAGE(PG8_SA(1, 1), a1 + hstep, voffA);
            PG8_WAIT_V(8); PG8_WAIT_L(0); PG8_BAR; PG8_MMA(0, 0, At, B0); PG8_MMA(0, 1, At, B1); PG8_BAR; PG8_SCHED;
            PG8_LDA(At, 0, 1); PG8_STAGE(PG8_SB(0, 0), b2, voffB); PG8_STAGE(PG8_SB(0, 1), b2 + hstep, voffB); PG8_STAGE(PG8_SA(0, 0), a2, voffA);
            PG8_WAIT_V(8); PG8_WAIT_L(0); PG8_BAR; PG8_MMA(1, 0, At, B0); PG8_MMA(1, 1, At, B1); PG8_BAR; PG8_SCHED;
            PG8_LDB(B0, 1, 0); PG8_LDB(B1, 1, 1); PG8_SCHED; PG8_LDA(At, 1, 0); PG8_STAGE(PG8_SA(0, 1), a2 + hstep, voffA);
            PG8_WAIT_V(8); PG8_WAIT_L(0); PG8_BAR; PG8_MMA(0, 0, At, B0); PG8_MMA(0, 1, At, B1); PG8_BAR; PG8_SCHED;
            PG8_LDA(At, 1, 1); PG8_STAGE(PG8_SB(1, 0), b3, voffB); PG8_STAGE(PG8_SB(1, 1), b3 + hstep, voffB); PG8_STAGE(PG8_SA(1, 0), a3, voffA);
            PG8_WAIT_V(8); PG8_WAIT_L(0); PG8_BAR; PG8_MMA(1, 0, At, B0); PG8_MMA(1, 1, At, B1); PG8_BAR; PG8_SCHED;
            } else {
            PG8_LDB(B0, 0, 0); PG8_SCHED; PG8_LDA(At, 0, 0); PG8_STAGE(PG8_SA(1, 1), a1 + hstep, voffA);
            PG8_WAIT_L(8); PG8_BAR; PG8_WAIT_L(0); PG8_MMA(0, 0, At, B0); PG8_BAR; PG8_SCHED;
            PG8_LDB(B1, 0, 1); PG8_STAGE(PG8_SB(0, 0), b2, voffB);
            PG8_BAR; PG8_WAIT_L(0); PG8_MMA(0, 1, At, B1); PG8_BAR;
            PG8_LDA(At, 0, 1); PG8_STAGE(PG8_SA(0, 0), a2, voffA);
            PG8_BAR; PG8_WAIT_L(0); PG8_MMA(1, 0, At, B0); PG8_BAR; PG8_SCHED;
            PG8_STAGE(PG8_SB(0, 1), b2 + hstep, voffB);
            PG8_WAIT_V(6); PG8_BAR; PG8_MMA(1, 1, At, B1); PG8_BAR;
            PG8_LDB(B0, 1, 0); PG8_SCHED; PG8_LDA(At, 1, 0); PG8_STAGE(PG8_SA(0, 1), a2 + hstep, voffA);
            PG8_WAIT_L(8); PG8_BAR; PG8_WAIT_L(0); PG8_MMA(0, 0, At, B0); PG8_BAR; PG8_SCHED;
            PG8_LDB(B1, 1, 1); PG8_STAGE(PG8_SB(1, 0), b3, voffB);
            PG8_BAR; PG8_WAIT_L(0); PG8_MMA(0, 1, At, B1); PG8_BAR;
            PG8_LDA(At, 1, 1); PG8_STAGE(PG8_SA(1, 0), a3, voffA);
            PG8_BAR; PG8_WAIT_L(0); PG8_MMA(1, 0, At, B0); PG8_BAR; PG8_SCHED;
            PG8_STAGE(PG8_SB(1, 1), b3 + hstep, voffB);
            PG8_WAIT_V(6); PG8_BAR; PG8_MMA(1, 1, At, B1); PG8_BAR;
            }
        }
        if constexpr (ALIGN_EPI) { if (wr == 0) PG8_BAR; }
        E(acc, cur, wr, wc, fr, fq);
        if (!has_next) break;
#pragma unroll
        for (int a = 0; a < 2; ++a)
#pragma unroll
            for (int b = 0; b < 2; ++b)
#pragma unroll
                for (int m = 0; m < 4; ++m)
#pragma unroll
                    for (int n = 0; n < 2; ++n) acc[a][b][m][n] = (f32x4){0.f, 0.f, 0.f, 0.f};
        cur = nxt; cA = nA; cB = nB; ++ui;
        if constexpr (ALIGN_EPI) { if (wr == 1) PG8_BAR; }
    }
    PG8_WAIT_V(0);
    if constexpr (!ALIGN_EPI) { if (wr == 0) PG8_BAR; }
    PG8_BAR;
#undef PG8_SA
#undef PG8_SB
#undef PG8_STAGE
#undef PG8_LDA
#undef PG8_LDB
#undef PG8_MMA
#undef PG8_WAIT_V
#undef PG8_WAIT_L
#undef PG8_BAR
#undef PG8_SCHED
}
}

constexpr int NWAVES = 8;
constexpr int BATCH = 16, SEQ = 2048, D = 1024, T = BATCH * SEQ;
constexpr int LDP = 2816;
constexpr int IN_COLS = 2576;
constexpr int C_U = 0, C_V = 512, C_Q = 1024, C_K = 1280, C_VV = 1536, C_G = 2048, C_A = 2560;
constexpr int DFF = 2816, DFE = 3584, NE = 8;
constexpr float LN_EPS = 1e-5f, RMS_EPS = 1e-6f, ALPHA = 1.41421356237f;
constexpr int RMAX = 2 * T + NE * 256;
constexpr int SLAB_P = 64;
constexpr int NSLAB = 5;
constexpr int KSPLIT = 7, KSLICE = DFE / KSPLIT, REM_P0 = 4 * SLAB_P, REM_MAXP = 8;
constexpr int NPHASE = 24;

constexpr size_t MiB = 1u << 20;
constexpr size_t WS_CTL = 0, CTL_ZERO_BYTES = 64 * 1024;
constexpr size_t WS_TOKE = 1 * MiB;
constexpr size_t WS_TOKW = WS_TOKE + 256 * 1024;
constexpr size_t WS_PPOS = WS_TOKW + 256 * 1024;
constexpr size_t WS_PEXP = WS_PPOS + 256 * 1024;
constexpr size_t WS_RPAIR = 2 * MiB;
constexpr size_t WS_RW = WS_RPAIR + 512 * 1024;
constexpr size_t WS_WM = 3 * MiB;
constexpr size_t WS_WIN = 4 * MiB;
constexpr size_t WS_WOUT = 15 * MiB;
constexpr size_t WS_WGU = 19 * MiB;
constexpr size_t WS_WDN = 30 * MiB;
constexpr size_t WS_EGU = 36 * MiB;
constexpr size_t WS_EDN = 148 * MiB;
constexpr size_t WS_XB = 204 * MiB;
constexpr size_t WS_BIG = 268 * MiB;
constexpr size_t WS_PROJ = WS_BIG;
constexpr size_t WS_CAT = 444 * MiB;
constexpr size_t WS_HID = WS_BIG;
constexpr size_t WS_XG = WS_BIG;
constexpr size_t WS_PART = WS_BIG;
constexpr size_t WS_HSLAB = 400 * MiB;
constexpr size_t WS_END = 512 * MiB;
constexpr int CW_TMO = 0;
constexpr int CW_CNT = 64;
constexpr int CW_CUR = 128;
constexpr int CW_BAR = 4096;

constexpr int RING_BYTES = 131072;
constexpr int LDSCTL_OFF = RING_BYTES, MISC_OFF = LDSCTL_OFF + 320;
constexpr int LDS_BYTES = 147456;

#define GAS __attribute__((address_space(1)))
#define LAS __attribute__((address_space(3)))
typedef unsigned short bf16;
typedef unsigned v4u __attribute__((ext_vector_type(4)));
typedef unsigned v2u __attribute__((ext_vector_type(2)));
typedef float f32x4 __attribute__((ext_vector_type(4)));
typedef float f32x2 __attribute__((ext_vector_type(2)));
typedef short bf16x8 __attribute__((ext_vector_type(8)));
#define RLX_AGENT __ATOMIC_RELAXED, __HIP_MEMORY_SCOPE_AGENT
#define LDS_WAIT() asm volatile("s_waitcnt lgkmcnt(0)" ::: "memory")
__device__ __forceinline__ float bflo(unsigned w) { return __uint_as_float(w << 16); }
__device__ __forceinline__ float bfhi(unsigned w) { return __uint_as_float(w & 0xffff0000u); }
__device__ __forceinline__ float bf2f(unsigned short h) { return __uint_as_float(((unsigned)h) << 16); }
__device__ __forceinline__ unsigned pk2(float lo, float hi) { return pg8::cvt_pk_bf16(lo, hi); }

#define XB_TMO      128
#define XB_XCNT(j)  (256  + 64 * (j))
#define XB_XSUB(j)  (1280 + 64 * (j))
#define XB_XGEN(j)  (2304 + 64 * (j))
#define XB_TOP      3328
#define XB_TOPGEN   3392
#define XCD_BAR_WORDS 3456
#define XB_SPIN_CAP (1u << 18)
__device__ __forceinline__ unsigned xb_ld(unsigned* p)              { return __hip_atomic_load(p, __ATOMIC_RELAXED, __HIP_MEMORY_SCOPE_AGENT); }
__device__ __forceinline__ unsigned xb_add(unsigned* p, unsigned v) { return __hip_atomic_fetch_add(p, v, __ATOMIC_RELAXED, __HIP_MEMORY_SCOPE_AGENT); }
__device__ __forceinline__ unsigned xb_xcc_id() { return (unsigned)__builtin_amdgcn_s_getreg((3 << 11) | 20) & 0xFu; }
#define XB_SPIN(cond, bar) do { unsigned _sp = 0; while (cond) { __builtin_amdgcn_s_sleep(1); \
    if ((++_sp & 255u) == 0u) { if (xb_ld(&(bar)[XB_TMO])) break; if (_sp > XB_SPIN_CAP) { atomicAdd(&(bar)[XB_TMO], 1u); break; } } } } while (0)
struct XcdBarrier { unsigned* bar; unsigned x; volatile LAS unsigned* st; };
__device__ __forceinline__ XcdBarrier xcd_barrier_post(unsigned* bar, volatile LAS unsigned* st) {
    XcdBarrier b; b.bar = bar; b.x = xb_xcc_id(); b.st = st;
    if (threadIdx.x == 0) (void)xb_add(&bar[XB_XCNT(b.x)], 1u);
    return b;
}
__device__ __forceinline__ void xcd_barrier_complete(unsigned* bar, unsigned x, unsigned& nloc, unsigned& nx) {
    const unsigned G = gridDim.x * gridDim.y * gridDim.z;
    unsigned sum, cnt, mine, sp = 0u;
    for (;;) {
        sum = 0u; cnt = 0u; mine = 0u;
#pragma unroll
        for (unsigned j = 0; j < 16; ++j) { const unsigned c = xb_ld(&bar[XB_XCNT(j)]); sum += c; cnt += (c > 0u) ? 1u : 0u; mine = (j == x) ? c : mine; }
        if (sum == G) break;
        __builtin_amdgcn_s_sleep(1);
        if ((++sp & 255u) == 0u) { if (xb_ld(&bar[XB_TMO])) break; if (sp > XB_SPIN_CAP) { atomicAdd(&bar[XB_TMO], 1u); break; } }
    }
    nloc = mine > 0u ? mine : 1u; nx = cnt > 0u ? cnt : 1u;
}
__device__ __forceinline__ void xcd_barrier(const XcdBarrier& b) {
    asm volatile("s_waitcnt vmcnt(0)" ::: "memory");
    __syncthreads();
    if (threadIdx.x == 0) {
        unsigned* bar = b.bar;
        __builtin_amdgcn_s_waitcnt(0);
        unsigned nloc = b.st[0], nx = b.st[1];
        if (nloc == 0u) { xcd_barrier_complete(bar, b.x, nloc, nx); b.st[0] = nloc; b.st[1] = nx; }
        const unsigned old = xb_add(&bar[XB_XSUB(b.x)], 1u);
        const unsigned gen = old / nloc;
        if (old + 1u == (gen + 1u) * nloc) {
            __builtin_amdgcn_fence(__ATOMIC_RELEASE, "agent");
            asm volatile("s_waitcnt vmcnt(0)" ::: "memory");
            const unsigned og = xb_add(&bar[XB_TOP], 1u);
            const unsigned tg = og / nx;
            if (og + 1u == (tg + 1u) * nx) xb_add(&bar[XB_TOPGEN], 1u);
            else XB_SPIN(xb_ld(&bar[XB_TOPGEN]) == tg, bar);
            __builtin_amdgcn_fence(__ATOMIC_ACQUIRE, "agent");
            xb_add(&bar[XB_XGEN(b.x)], 1u);
            asm volatile("s_waitcnt vmcnt(0)" ::: "memory");
        } else {
            XB_SPIN(xb_ld(&bar[XB_XGEN(b.x)]) == gen, bar);
            __builtin_amdgcn_fence(__ATOMIC_ACQUIRE, "agent");
            asm volatile("s_waitcnt vmcnt(0)" ::: "memory");
        }
    }
    __syncthreads();
}

struct Args { const float* in[21]; float* out; unsigned char* ws; int ph_lo, ph_hi; };
struct Frame {
    LAS unsigned char* lds;
    volatile LAS unsigned* MISC;
    unsigned* ctl;
    int G;
    unsigned char* ws; float* out;
};
#define LOCAL_IDS int tid = threadIdx.x; asm volatile("" : "+v"(tid)); const int lane = tid & 63; const int wave = __builtin_amdgcn_readfirstlane(tid >> 6); (void)lane; (void)wave
__device__ __forceinline__ float wave_sum(float v) {
#pragma unroll
    for (int o = 1; o < 64; o <<= 1) v += __shfl_xor(v, o);
    return v;
}

__device__ __forceinline__ void tr_block(const float* W, int Nsrc, int K, int k0, int n0, bf16* WT, int drow, int lane) {
    const int n = n0 + lane; const bool ok = n < Nsrc; const float* src = W + (size_t)k0 * Nsrc + (ok ? n : 0);
    float v[64];
#pragma unroll
    for (int kk = 0; kk < 64; ++kk) v[kk] = src[(size_t)kk * Nsrc];
    GAS v4u* dst = (GAS v4u*)(WT + (size_t)(drow + lane) * K + k0);
#pragma unroll
    for (int c = 0; c < 8; ++c) { v4u o; o.x = pk2(v[8 * c], v[8 * c + 1]); o.y = pk2(v[8 * c + 2], v[8 * c + 3]); o.z = pk2(v[8 * c + 4], v[8 * c + 5]); o.w = pk2(v[8 * c + 6], v[8 * c + 7]);
        if (!ok) o = (v4u){0u, 0u, 0u, 0u}; dst[c] = o; }
}
__device__ __forceinline__ void tr_plain(const float* W, int K, int Nsrc, int nblk, bf16* WT, int item, int lane) {
    const int kb = item / nblk, nb = item % nblk; tr_block(W, Nsrc, K, 64 * kb, 64 * nb, WT, 64 * nb, lane);
}
__device__ __forceinline__ void tr_gu(const float* W, int K, int Nsrc, int nblk, bf16* WT, int add, int item, int lane) {
    const int kb = item / nblk, nb = item % nblk, n0 = 64 * nb; tr_block(W, Nsrc, K, 64 * kb, n0, WT, (n0 >> 7) * 256 + (n0 & 127) + add, lane);
}
constexpr int I_IN = 16 * 44, I_OUT = 16 * 16, I_G = 16 * 44, I_DN = 44 * 16, I_EG = 16 * 56, I_ED = 56 * 16;
constexpr int NITEMS = 2 * I_IN + 2 * I_OUT + 2 * I_G + I_DN + 16 * I_EG + 8 * I_ED;
constexpr int NITEMS_A = I_IN + I_OUT, NITEMS_B = NITEMS - NITEMS_A;
__device__ __forceinline__ void conv_item(unsigned char* ws, const Args& a, int it, int lane) {
    bf16* Win = (bf16*)(ws + WS_WIN); bf16* Wout = (bf16*)(ws + WS_WOUT); bf16* Wgu = (bf16*)(ws + WS_WGU); bf16* Wdn = (bf16*)(ws + WS_WDN);
    bf16* Egu = (bf16*)(ws + WS_EGU); bf16* Edn = (bf16*)(ws + WS_EDN);
    int r = it;
    if (r < 2 * I_IN) { const int l = r / I_IN; tr_plain(a.in[1] + (size_t)l * D * IN_COLS, D, IN_COLS, 44, Win + (size_t)l * LDP * D, r % I_IN, lane); return; } r -= 2 * I_IN;
    if (r < 2 * I_OUT) { const int l = r / I_OUT; tr_plain(a.in[9] + (size_t)l * D * D, D, D, 16, Wout + (size_t)l * D * D, r % I_OUT, lane); return; } r -= 2 * I_OUT;
    if (r < I_G) { tr_gu(a.in[12], D, DFF, 44, Wgu, 0, r, lane); return; } r -= I_G;
    if (r < I_G) { tr_gu(a.in[13], D, DFF, 44, Wgu, 128, r, lane); return; } r -= I_G;
    if (r < I_DN) { tr_plain(a.in[14], DFF, D, 16, Wdn, r, lane); return; } r -= I_DN;
    if (r < 8 * I_EG) { const int e = r / I_EG; tr_gu(a.in[16] + (size_t)e * D * DFE, D, DFE, 56, Egu + (size_t)e * 2 * DFE * D, 0, r % I_EG, lane); return; } r -= 8 * I_EG;
    if (r < 8 * I_EG) { const int e = r / I_EG; tr_gu(a.in[17] + (size_t)e * D * DFE, D, DFE, 56, Egu + (size_t)e * 2 * DFE * D, 128, r % I_EG, lane); return; } r -= 8 * I_EG;
    { const int e = r / I_ED; tr_plain(a.in[18] + (size_t)e * DFE * D, DFE, D, 16, Edn + (size_t)e * D * DFE, r % I_ED, lane); }
}
__device__ __forceinline__ void conv_set_b(Frame& F, const Args& a, int gw2, int NGW2) {
    LOCAL_IDS;
    for (int k = gw2; k < NITEMS_B; k += NGW2) conv_item(F.ws, a, k < I_IN ? I_IN + k : 2 * I_IN + I_OUT + (k - I_IN), lane);
}
__device__ __forceinline__ void p0_prologue(Frame& F, const Args& a) {
    LOCAL_IDS;
    const int gw = blockIdx.x * NWAVES + wave, NGW = F.G * NWAVES;
    for (int k = gw; k < NITEMS_A; k += NGW) conv_item(F.ws, a, k < I_IN ? k : 2 * I_IN + (k - I_IN), lane);
    if (F.G < 128) conv_set_b(F, a, gw, NGW);
    const size_t gt = (size_t)blockIdx.x * 512 + tid, NT = (size_t)F.G * 512;
    { const f32x4* x4 = (const f32x4*)a.in[0]; v4u* o = (v4u*)(F.ws + WS_XB);
      for (size_t i = gt; i < (size_t)T * D / 8; i += NT) { const f32x4 p = x4[2 * i], q = x4[2 * i + 1]; v4u w; w.x = pk2(p[0], p[1]); w.y = pk2(p[2], p[3]); w.z = pk2(q[0], q[1]); w.w = pk2(q[2], q[3]); o[i] = w; } }
    { const float* w = a.in[2]; bf16* o = (bf16*)(F.ws + WS_WM);
      for (size_t i = gt; i < (size_t)2 * 4 * 128 * 128; i += NT) { const int s = (int)(i & 127), t = (int)((i >> 7) & 127); o[i] = (bf16)(pk2(s <= t ? w[i] : 0.f, 0.f) & 0xffffu); } }
}

__device__ __forceinline__ void gmlp_item(Frame& F, const Args& a, int layer, int item) {
    const int bb = item >> 6, c = (item >> 2) & 15, h = item & 3; const int r0 = bb * SEQ + c * 128;
    const bf16* P = (const bf16*)(F.ws + WS_PROJ); bf16* CAT = (bf16*)(F.ws + WS_CAT);
    const bf16* Wm = (const bf16*)(F.ws + WS_WM) + (size_t)(layer * 4 + h) * 128 * 128;
    const float* lng = a.in[4] + layer * 512 + h * 128; const float* lnb = a.in[5] + layer * 512 + h * 128; const float* bs = a.in[3] + (layer * 4 + h) * 128;
    LAS unsigned char* VTA = F.lds;
    LOCAL_IDS; const int w = wave, fr = lane & 15, fq = lane >> 4;
    {
        const int s = tid >> 2, q4 = tid & 3; const bf16* vp = P + (size_t)(r0 + s) * LDP + C_V + h * 128 + q4 * 8;
        float x[4][8]; float sum = 0.f;
#pragma unroll
        for (int j = 0; j < 4; ++j) { const v4u wv = *(const v4u*)(vp + 32 * j); x[j][0] = bflo(wv.x); x[j][1] = bfhi(wv.x); x[j][2] = bflo(wv.y); x[j][3] = bfhi(wv.y); x[j][4] = bflo(wv.z); x[j][5] = bfhi(wv.z); x[j][6] = bflo(wv.w); x[j][7] = bfhi(wv.w);
#pragma unroll
            for (int e = 0; e < 8; ++e) sum += x[j][e]; }
        sum += __shfl_xor(sum, 1); sum += __shfl_xor(sum, 2);
        const float mean = sum * (1.f / 128.f); float q = 0.f;
#pragma unroll
        for (int j = 0; j < 4; ++j)
#pragma unroll
            for (int e = 0; e < 8; ++e) { x[j][e] -= mean; q += x[j][e] * x[j][e]; }
        q += __shfl_xor(q, 1); q += __shfl_xor(q, 2);
        const float rstd = 1.0f / sqrtf(q * (1.f / 128.f) + LN_EPS);
#pragma unroll
        for (int j = 0; j < 4; ++j) { const int ch0 = q4 * 8 + 32 * j; const f32x4 g0 = *(const f32x4*)(lng + ch0), g1 = *(const f32x4*)(lng + ch0 + 4), b0 = *(const f32x4*)(lnb + ch0), b1 = *(const f32x4*)(lnb + ch0 + 4);
#pragma unroll
            for (int e = 0; e < 8; ++e) { const float gg = e < 4 ? g0[e & 3] : g1[e & 3], be = e < 4 ? b0[e & 3] : b1[e & 3]; const float y = x[j][e] * rstd * gg + be;
                *(LAS bf16*)(VTA + (ch0 + e) * 272 + s * 2) = (bf16)(pk2(y, 0.f) & 0xffffu); } }
    }
    __syncthreads();
    {
        bf16x8 aV[4];
#pragma unroll
        for (int ks = 0; ks < 4; ++ks) aV[ks] = *(const LAS bf16x8*)(VTA + (16 * w + fr) * 272 + (32 * ks + 8 * fq) * 2);
#pragma unroll
        for (int tt = 0; tt < 8; ++tt) { f32x4 acc = (f32x4){0.f, 0.f, 0.f, 0.f}; const int t = 16 * tt + fr;
#pragma unroll
            for (int ks = 0; ks < 4; ++ks) if (ks <= tt / 2) { const bf16x8 bW = *(const bf16x8*)(Wm + (size_t)t * 128 + 32 * ks + 8 * fq); acc = __builtin_amdgcn_mfma_f32_16x16x32_bf16(aV[ks], bW, acc, 0, 0, 0); }
            const float bst = bs[t]; const size_t row = (size_t)(r0 + t); const v2u uu = *(const v2u*)(P + row * LDP + C_U + h * 128 + 16 * w + 4 * fq);
            v2u o; o.x = pk2(bflo(uu.x) * (acc[0] + bst), bfhi(uu.x) * (acc[1] + bst)); o.y = pk2(bflo(uu.y) * (acc[2] + bst), bfhi(uu.y) * (acc[3] + bst));
            if ((ABL >> layer) & 1) { o.x = 0u; o.y = 0u; }
            *(v2u*)(CAT + row * D + h * 128 + 16 * w + 4 * fq) = o; }
    }
    __syncthreads();
}

constexpr int G_QD = 0, G_KI = 9216, G_SC = 18432, G_KDT = 27648, G_VT = 36864, G_ST = 55296, G_ALR = 73728, G_PART = 75776, G_DEC = 77824, G_SS = 78080, G_RQ = 80128, G_RK = 88320, G_RV = 96512, G_END = 112896;
__device__ __forceinline__ void gla_item(Frame& F, const Args& a, int layer, int item) {
    const int bb = item >> 2, h = item & 3;
    const bf16* P = (const bf16*)(F.ws + WS_PROJ) + (size_t)bb * SEQ * LDP; bf16* CAT = (bf16*)(F.ws + WS_CAT) + (size_t)bb * SEQ * D;
    LAS unsigned char* L = F.lds;
    LOCAL_IDS; const int w = wave, fr = lane & 15, fq = lane >> 4, d = lane;
    const int ve = (w & 1) * 64 + lane, vjg = w >> 1;
    float wcol[16];
#pragma unroll
    for (int m = 0; m < 16; ++m) wcol[m] = a.in[6][(size_t)layer * 16 * 256 + m * 256 + h * 64 + d];
    const float bad = a.in[7][layer * 256 + h * 64 + d];
    const f32x4 ng = *(const f32x4*)(a.in[8] + layer * 512 + h * 128 + 16 * w + 4 * fq);
    for (int i = tid; i < (18432 + 9216) / 4; i += 512) { if (i < 18432 / 4) ((LAS unsigned*)(L + G_ST))[i] = 0u; else ((LAS unsigned*)(L + G_SC))[i - 18432 / 4] = 0u; }
    f32x4 sacc[4];
#pragma unroll
    for (int dt = 0; dt < 4; ++dt) sacc[dt] = (f32x4){0.f, 0.f, 0.f, 0.f};
    const unsigned oq = (unsigned)((tid >> 3) * LDP + C_Q + h * 64 + (tid & 7) * 8), ok_ = (unsigned)((tid >> 3) * LDP + C_K + h * 64 + (tid & 7) * 8);
    const unsigned ov = (unsigned)((tid >> 4) * LDP + C_VV + h * 128 + (tid & 15) * 8), oa = (unsigned)(((tid & 127) >> 1) * LDP + C_A + (tid & 1) * 8);
    const unsigned og = (unsigned)(fr * LDP + C_G + h * 128 + 16 * w + 4 * fq);
    v4u rq, rk, rv0, rv1, ra = (v4u){0u, 0u, 0u, 0u};
    { rq = *(const v4u*)(P + oq); rk = *(const v4u*)(P + ok_); rv0 = *(const v4u*)(P + ov); rv1 = *(const v4u*)(P + ov + 32 * LDP); if (tid < 128) ra = *(const v4u*)(P + oa); }
    __syncthreads();
    for (int n = 0; n < 32; ++n) {
        const bf16* R = P + (size_t)n * 64 * LDP;
        *(LAS v4u*)(L + G_RQ + tid * 16) = rq; *(LAS v4u*)(L + G_RK + tid * 16) = rk; *(LAS v4u*)(L + G_RV + tid * 16) = rv0; *(LAS v4u*)(L + G_RV + 8192 + tid * 16) = rv1;
        if (tid < 128) *(LAS v4u*)(L + G_ALR + tid * 16) = ra;
        __syncthreads();
        if (n + 1 < 32) { const bf16* Rn = R + (size_t)64 * LDP; rq = *(const v4u*)(Rn + oq); rk = *(const v4u*)(Rn + ok_); rv0 = *(const v4u*)(Rn + ov); rv1 = *(const v4u*)(Rn + ov + 32 * LDP); if (tid < 128) ra = *(const v4u*)(Rn + oa); }
        v2u gate[4];
#pragma unroll
        for (int it = 0; it < 4; ++it) gate[it] = *(const v2u*)(R + og + (size_t)(16 * it) * LDP);
        { unsigned short vv[16];
#pragma unroll
          for (int jj = 0; jj < 16; ++jj) vv[jj] = *(const LAS unsigned short*)(L + G_RV + (16 * vjg + jj) * 256 + ve * 2);
          v4u p0, p1; p0.x = vv[0] | ((unsigned)vv[1] << 16); p0.y = vv[2] | ((unsigned)vv[3] << 16); p0.z = vv[4] | ((unsigned)vv[5] << 16); p0.w = vv[6] | ((unsigned)vv[7] << 16);
          p1.x = vv[8] | ((unsigned)vv[9] << 16); p1.y = vv[10] | ((unsigned)vv[11] << 16); p1.z = vv[12] | ((unsigned)vv[13] << 16); p1.w = vv[14] | ((unsigned)vv[15] << 16);
          *(LAS v4u*)(L + G_VT + ve * 144 + vjg * 32) = p0; *(LAS v4u*)(L + G_VT + ve * 144 + vjg * 32 + 16) = p1; }
        float cs[8]; float run = 0.f;
#pragma unroll
        for (int ii = 0; ii < 8; ++ii) { const v4u a0 = *(const LAS v4u*)(L + G_ALR + (8 * w + ii) * 32), a1 = *(const LAS v4u*)(L + G_ALR + (8 * w + ii) * 32 + 16);
            float z = bad;
            z += bflo(a0.x) * wcol[0] + bfhi(a0.x) * wcol[1] + bflo(a0.y) * wcol[2] + bfhi(a0.y) * wcol[3] + bflo(a0.z) * wcol[4] + bfhi(a0.z) * wcol[5] + bflo(a0.w) * wcol[6] + bfhi(a0.w) * wcol[7];
            z += bflo(a1.x) * wcol[8] + bfhi(a1.x) * wcol[9] + bflo(a1.y) * wcol[10] + bfhi(a1.y) * wcol[11] + bflo(a1.z) * wcol[12] + bfhi(a1.z) * wcol[13] + bflo(a1.w) * wcol[14] + bfhi(a1.w) * wcol[15];
            const float ls = fminf(z, 0.f) - __logf(1.0f + __expf(-fabsf(z)));
            run += ((GLA_DBG == 2 || GLA_DBG == 3) ? 0.f : ls * 0.0625f); cs[ii] = run; }
        *(LAS float*)(L + G_PART + (w * 64 + d) * 4) = run;
        __syncthreads();
        float off = 0.f, bl = 0.f;
#pragma unroll
        for (int ww = 0; ww < 8; ++ww) { const float p = *(const LAS float*)(L + G_PART + (ww * 64 + d) * 4); bl += p; off += (ww < w) ? p : 0.f; }
        { unsigned kd[8];
#pragma unroll
          for (int ii = 0; ii < 8; ++ii) { const float qv = bf2f(*(const LAS unsigned short*)(L + G_RQ + (8 * w + ii) * 128 + d * 2)), kv = bf2f(*(const LAS unsigned short*)(L + G_RK + (8 * w + ii) * 128 + d * 2));
              const float b_ = off + cs[ii]; const float qd = qv * 0.125f * __expf(b_), ki = kv * __expf(-b_), kdv = kv * __expf(bl - b_);
              *(LAS bf16*)(L + G_QD + (8 * w + ii) * 144 + d * 2) = (bf16)(pk2(qd, 0.f) & 0xffffu);
              *(LAS bf16*)(L + G_KI + (8 * w + ii) * 144 + d * 2) = (bf16)(pk2(ki, 0.f) & 0xffffu);
              kd[ii] = pk2(kdv, 0.f) & 0xffffu; }
          v4u pk; pk.x = kd[0] | (kd[1] << 16); pk.y = kd[2] | (kd[3] << 16); pk.z = kd[4] | (kd[5] << 16); pk.w = kd[6] | (kd[7] << 16);
          *(LAS v4u*)(L + G_KDT + d * 144 + w * 16) = pk; }
        if (w == 0) *(LAS float*)(L + G_DEC + d * 4) = __expf(bl);
        __syncthreads();
#pragma unroll
        for (int rep = 0; rep < 2; ++rep) { const int tix = w + 8 * rep;
            if (tix < 10) { const int it = (tix >= 6) ? 3 : (tix >= 3) ? 2 : (tix >= 1) ? 1 : 0, jt = tix - it * (it + 1) / 2;
                f32x4 acc = (f32x4){0.f, 0.f, 0.f, 0.f};
#pragma unroll
                for (int ks = 0; ks < 2; ++ks) { const bf16x8 ak = *(const LAS bf16x8*)(L + G_KI + (16 * jt + fr) * 144 + (32 * ks + 8 * fq) * 2), bq = *(const LAS bf16x8*)(L + G_QD + (16 * it + fr) * 144 + (32 * ks + 8 * fq) * 2);
                    acc = __builtin_amdgcn_mfma_f32_16x16x32_bf16(ak, bq, acc, 0, 0, 0); }
                const int i = 16 * it + fr, j0 = 16 * jt + 4 * fq;
                v2u o; o.x = pk2(j0 <= i ? acc[0] : 0.f, j0 + 1 <= i ? acc[1] : 0.f); o.y = pk2(j0 + 2 <= i ? acc[2] : 0.f, j0 + 3 <= i ? acc[3] : 0.f);
                *(LAS v2u*)(L + G_SC + i * 144 + j0 * 2) = o; } }
        __syncthreads();
        bf16x8 aV[2], aS[2];
#pragma unroll
        for (int ks = 0; ks < 2; ++ks) { aV[ks] = *(const LAS bf16x8*)(L + G_VT + (16 * w + fr) * 144 + (32 * ks + 8 * fq) * 2); aS[ks] = *(const LAS bf16x8*)(L + G_ST + (16 * w + fr) * 144 + (32 * ks + 8 * fq) * 2); }
        f32x4 o[4];
#pragma unroll
        for (int it = 0; it < 4; ++it) { f32x4 acc = (f32x4){0.f, 0.f, 0.f, 0.f};
#pragma unroll
            for (int ks = 0; ks < 2; ++ks) if (ks == 0 || it >= 2) { const bf16x8 bs_ = *(const LAS bf16x8*)(L + G_SC + (16 * it + fr) * 144 + (32 * ks + 8 * fq) * 2); acc = __builtin_amdgcn_mfma_f32_16x16x32_bf16(aV[ks], bs_, acc, 0, 0, 0); }
#pragma unroll
            for (int ks = 0; ks < 2; ++ks) { const bf16x8 bq = *(const LAS bf16x8*)(L + G_QD + (16 * it + fr) * 144 + (32 * ks + 8 * fq) * 2); acc = __builtin_amdgcn_mfma_f32_16x16x32_bf16(aS[ks], bq, acc, 0, 0, 0); }
            o[it] = acc;
            float p = acc[0] * acc[0] + acc[1] * acc[1] + acc[2] * acc[2] + acc[3] * acc[3]; p += __shfl_xor(p, 16); p += __shfl_xor(p, 32);
            if (fq == 0) *(LAS float*)(L + G_SS + (w * 64 + 16 * it + fr) * 4) = p; }
        asm volatile("s_waitcnt lgkmcnt(0)" ::: "memory");
#pragma unroll
        for (int dt = 0; dt < 4; ++dt) { const f32x4 dec = *(const LAS f32x4*)(L + G_DEC + (16 * dt + 4 * fq) * 4); sacc[dt] = sacc[dt] * dec;
#pragma unroll
            for (int ks = 0; ks < 2; ++ks) { const bf16x8 ak = *(const LAS bf16x8*)(L + G_KDT + (16 * dt + fr) * 144 + (32 * ks + 8 * fq) * 2); sacc[dt] = __builtin_amdgcn_mfma_f32_16x16x32_bf16(ak, aV[ks], sacc[dt], 0, 0, 0); }
            v2u sw; sw.x = pk2(sacc[dt][0], sacc[dt][1]); sw.y = pk2(sacc[dt][2], sacc[dt][3]);
            if (GLA_DBG != 1) *(LAS v2u*)(L + G_ST + (16 * w + fr) * 144 + (16 * dt + 4 * fq) * 2) = sw; }
        __syncthreads();
#if GLA_DBG == 3
        if (n == 0 && layer == 0) {
            unsigned bits = 0u;
            { const int dd = tid & 63, ee = tid >> 2; float ref = 0.f; for (int j = 0; j < 64; ++j) ref += bf2f(*(const LAS unsigned short*)(L + G_KDT + dd * 144 + j * 2)) * bf2f(*(const LAS unsigned short*)(L + G_VT + ee * 144 + j * 2));
              const float got = bf2f(*(const LAS unsigned short*)(L + G_ST + ee * 144 + dd * 2)); if (!(fabsf(got - ref) <= 0.02f * fabsf(ref) + 0.02f)) bits |= 1u; }
            { const int dd = tid & 63; for (int j = (tid >> 6); j < 64; j += 8) { const unsigned short kk = *(const LAS unsigned short*)(L + G_KDT + dd * 144 + j * 2), rk_ = *(const LAS unsigned short*)(L + G_RK + j * 128 + dd * 2); if (kk != rk_) bits |= 2u; } }
            { const int ee = tid & 127; for (int j = (tid >> 7); j < 64; j += 4) { const unsigned short vv_ = *(const LAS unsigned short*)(L + G_VT + ee * 144 + j * 2), rv_ = *(const LAS unsigned short*)(L + G_RV + j * 256 + ee * 2); if (vv_ != rv_) bits |= 4u; } }
            {
#pragma unroll
                for (int dt = 0; dt < 4; ++dt)
#pragma unroll
                    for (int r = 0; r < 4; ++r) { const int dd = 16 * dt + 4 * fq + r, ee = 16 * w + fr; float ref = 0.f; for (int j = 0; j < 64; ++j) ref += bf2f(*(const LAS unsigned short*)(L + G_KDT + dd * 144 + j * 2)) * bf2f(*(const LAS unsigned short*)(L + G_VT + ee * 144 + j * 2));
                        if (!(fabsf(sacc[dt][r] - ref) <= 0.01f * fabsf(ref) + 0.01f)) bits |= 8u;
                        const float got = bf2f(*(const LAS unsigned short*)(L + G_ST + ee * 144 + dd * 2)); if (!(fabsf(got - sacc[dt][r]) <= 0.01f * fabsf(got) + 0.01f)) bits |= 16u; } }
            if (bits) atomicOr((unsigned*)(F.ws + WS_CTL) + 192 + 4, bits);
        }
#endif
#pragma unroll
        for (int it = 0; it < 4; ++it) { float tot = 0.f;
#pragma unroll
            for (int ww = 0; ww < 8; ++ww) tot += *(const LAS float*)(L + G_SS + (ww * 64 + 16 * it + fr) * 4);
            const float rstd = 1.0f / sqrtf(tot * (1.f / 128.f) + RMS_EPS);
            const float g0 = bflo(gate[it].x), g1 = bfhi(gate[it].x), g2 = bflo(gate[it].y), g3 = bfhi(gate[it].y);
            v2u ov_; ov_.x = pk2(o[it][0] * rstd * ng[0] * pg8::silu_f(g0), o[it][1] * rstd * ng[1] * pg8::silu_f(g1)); ov_.y = pk2(o[it][2] * rstd * ng[2] * pg8::silu_f(g2), o[it][3] * rstd * ng[3] * pg8::silu_f(g3));
            if ((ABL >> (2 + layer)) & 1) { ov_.x = 0u; ov_.y = 0u; }
            *(v2u*)(CAT + (size_t)(n * 64 + 16 * it + fr) * D + 512 + h * 128 + 16 * w + 4 * fq) = ov_; }
    }
    __syncthreads();
}
__device__ __forceinline__ void mixer_phase(Frame& F, const Args& a, int layer) {
    const int bx = blockIdx.x; int G_ = F.G; asm volatile("" : "+s"(G_));
    if (G_ >= 128) {
        if (bx < 64) gla_item(F, a, layer, bx);
        else { for (int it = bx - 64; it < 1024; it += F.G - 64) gmlp_item(F, a, layer, it);
            if (layer == 0) { const int wv = __builtin_amdgcn_readfirstlane((int)threadIdx.x >> 6); conv_set_b(F, a, (bx - 64) * NWAVES + wv, (F.G - 64) * NWAVES); } }
    } else {
        for (int it = bx; it < 64; it += F.G) gla_item(F, a, layer, it);
        for (int it = bx; it < 1024; it += F.G) gmlp_item(F, a, layer, it);
    }
}

template <bool ROUTER>
__device__ __forceinline__ void ln_phase(Frame& F, const Args& a, const float* g, const float* b) {
    LOCAL_IDS;
    const int gw = blockIdx.x * NWAVES + wave, NGW = F.G * NWAVES;
    const bf16* Y = (const bf16*)F.out; bf16* XB = (bf16*)(F.ws + WS_XB);
    f32x4 gv[4], bv[4];
#pragma unroll
    for (int j = 0; j < 4; ++j) { gv[j] = *(const f32x4*)(g + 4 * lane + 256 * j); bv[j] = *(const f32x4*)(b + 4 * lane + 256 * j); }
    LAS unsigned* hist = (LAS unsigned*)(F.lds + 1024);
    if (ROUTER) {
        if (tid < 8) hist[tid] = 0u;
        int* rp = (int*)(F.ws + WS_RPAIR);
        for (int c = blockIdx.x; c < RMAX / 512; c += F.G) rp[c * 512 + tid] = -1;
        __syncthreads();
    }
    for (int m = gw; m < T; m += NGW) {
        const v2u* xr = (const v2u*)(Y + (size_t)m * D) + lane;
        f32x4 v[4]; float s = 0.f;
#pragma unroll
        for (int j = 0; j < 4; ++j) { const v2u yy = xr[64 * j]; v[j] = (f32x4){bflo(yy.x), bfhi(yy.x), bflo(yy.y), bfhi(yy.y)}; s += (v[j][0] + v[j][1]) + (v[j][2] + v[j][3]); }
        const float mean = wave_sum(s) * (1.f / D); float s2 = 0.f;
#pragma unroll
        for (int j = 0; j < 4; ++j) { v[j] = v[j] - mean; s2 += (v[j][0] * v[j][0] + v[j][1] * v[j][1]) + (v[j][2] * v[j][2] + v[j][3] * v[j][3]); }
        const float rstd = 1.f / sqrtf(wave_sum(s2) * (1.f / D) + LN_EPS);
        v2u* o8 = (v2u*)(XB + (size_t)m * D) + lane;
#pragma unroll
        for (int j = 0; j < 4; ++j) { v[j] = v[j] * rstd * gv[j] + bv[j]; v2u w; w.x = pk2(v[j][0], v[j][1]); w.y = pk2(v[j][2], v[j][3]); o8[64 * j] = w; }
        if (ROUTER) {
            const float* wr = a.in[15];
            float lg[8];
#pragma unroll
            for (int e = 0; e < 8; ++e) lg[e] = 0.f;
#pragma unroll
            for (int j = 0; j < 4; ++j)
#pragma unroll
                for (int c = 0; c < 4; ++c) { const int k = 4 * lane + 256 * j + c; const f32x4 w0 = *(const f32x4*)(wr + k * 8), w1 = *(const f32x4*)(wr + k * 8 + 4); const float xv = v[j][c];
                    lg[0] += xv * w0[0]; lg[1] += xv * w0[1]; lg[2] += xv * w0[2]; lg[3] += xv * w0[3]; lg[4] += xv * w1[0]; lg[5] += xv * w1[1]; lg[6] += xv * w1[2]; lg[7] += xv * w1[3]; }
#pragma unroll
            for (int e = 0; e < 8; ++e) lg[e] = wave_sum(lg[e]);
            int i0 = 0; float v0 = lg[0];
#pragma unroll
            for (int e = 1; e < 8; ++e) if (lg[e] > v0) { v0 = lg[e]; i0 = e; }
            int i1 = -1; float v1 = -3.0e38f;
#pragma unroll
            for (int e = 0; e < 8; ++e) if (e != i0 && lg[e] > v1) { v1 = lg[e]; i1 = e; }
            const float w0 = 1.0f / (1.0f + __expf(v1 - v0)), w1 = 1.0f - w0;
            if (lane == 0) { ((unsigned*)(F.ws + WS_TOKE))[m] = (unsigned)i0 | ((unsigned)i1 << 8); ((f32x2*)(F.ws + WS_TOKW))[m] = (f32x2){w0, w1};
                __hip_atomic_fetch_add(hist + i0, 1u, __ATOMIC_RELAXED, __HIP_MEMORY_SCOPE_WORKGROUP); __hip_atomic_fetch_add(hist + i1, 1u, __ATOMIC_RELAXED, __HIP_MEMORY_SCOPE_WORKGROUP); }
        }
    }
    if (ROUTER) { __syncthreads(); if (tid < 8) __hip_atomic_fetch_add(F.ctl + CW_CNT + tid, hist[tid], RLX_AGENT); }
}
__device__ __forceinline__ void moe_segments(Frame& F, int (&seg)[9]) {
    int acc = 0;
#pragma unroll
    for (int e = 0; e < 8; ++e) { seg[e] = acc; const unsigned c = __hip_atomic_load(F.ctl + CW_CNT + e, RLX_AGENT); acc += (int)((c + 255u) & ~255u); }
    seg[8] = acc;
}
__device__ __forceinline__ void scatter_phase(Frame& F) {
    LOCAL_IDS;
    int seg[9]; moe_segments(F, seg);
    LAS unsigned* lcnt = (LAS unsigned*)(F.lds + 1024); LAS unsigned* lbase = lcnt + 8; LAS int* lpos = (LAS int*)(F.lds + 2048);
    const unsigned* toke = (const unsigned*)(F.ws + WS_TOKE); const f32x2* tokw = (const f32x2*)(F.ws + WS_TOKW);
    int* rp = (int*)(F.ws + WS_RPAIR); float* rw = (float*)(F.ws + WS_RW);
    const bf16* XB = (const bf16*)(F.ws + WS_XB); bf16* XG = (bf16*)(F.ws + WS_XG);
    for (int base = blockIdx.x * 128; base < T; base += F.G * 128) {
        if (tid < 8) lcnt[tid] = 0u;
        __syncthreads();
        int e = 0, lrank = 0; float wgt = 0.f; const int t = base + (tid >> 1), slot = tid & 1;
        if (tid < 256) { const unsigned ee = toke[t]; e = slot ? (int)((ee >> 8) & 0xff) : (int)(ee & 0xff); const f32x2 ww = tokw[t]; wgt = slot ? ww.y : ww.x; lrank = (int)__hip_atomic_fetch_add(lcnt + e, 1u, __ATOMIC_RELAXED, __HIP_MEMORY_SCOPE_WORKGROUP); }
        __syncthreads();
        if (tid < 8) lbase[tid] = __hip_atomic_fetch_add(F.ctl + CW_CUR + tid, lcnt[tid], RLX_AGENT);
        __syncthreads();
        if (tid < 256) { int sg = 0;
#pragma unroll
            for (int j = 0; j < 8; ++j) sg = (e == j) ? seg[j] : sg;
            const int pos = sg + (int)lbase[e] + lrank; rp[pos] = 2 * t + slot; rw[pos] = wgt; lpos[tid] = pos; ((int*)(F.ws + WS_PPOS))[2 * t + slot] = pos; }
        __syncthreads();
        for (int p = wave; p < 256; p += NWAVES) { const int pos = lpos[p]; const v4u* src = (const v4u*)(XB + (size_t)(base + (p >> 1)) * D); v4u* dst = (v4u*)(XG + (size_t)pos * D);
            dst[lane] = src[lane]; dst[lane + 64] = src[lane + 64]; }
        __syncthreads();
    }
    if (blockIdx.x == 0 && tid < RMAX / 256) { int e = 0;
#pragma unroll
        for (int j = 1; j < 8; ++j) e += (tid * 256 >= seg[j]) ? 1 : 0;
        ((unsigned char*)(F.ws + WS_PEXP))[tid] = (unsigned char)e; }
    if (blockIdx.x < 8) { const int e = blockIdx.x; const int c = (int)__hip_atomic_load(F.ctl + CW_CNT + e, RLX_AGENT); int sg = 0, sn = 0;
#pragma unroll
        for (int j = 0; j < 8; ++j) { sg = (e == j) ? seg[j] : sg; sn = (e == j) ? seg[j + 1] : sn; }
        const int r0 = sg + c, nr = sn - r0; v4u* dst = (v4u*)(XG + (size_t)r0 * D);
        for (int i = tid; i < nr * 128; i += 512) dst[i] = (v4u){0u, 0u, 0u, 0u}; }
}
__device__ __forceinline__ void pair_row(Frame& F, int pair, int lane, f32x4 (&y)[4]) {
    const v2u* yp = (const v2u*)((const bf16*)F.out + (size_t)pair * D) + lane;
    v2u a0[4];
#pragma unroll
    for (int j = 0; j < 4; ++j) a0[j] = yp[64 * j];
    const int pos = __builtin_amdgcn_readfirstlane(((const int*)(F.ws + WS_PPOS))[pair]);
#pragma unroll
    for (int j = 0; j < 4; ++j) y[j] = (f32x4){bflo(a0[j].x), bfhi(a0[j].x), bflo(a0[j].y), bfhi(a0[j].y)};
    if (pos >= REM_P0 * 256) { const float gw = ((const float*)(F.ws + WS_RW))[pos]; const f32x4* pp = (const f32x4*)((const float*)(F.ws + WS_PART) + (size_t)(pos - REM_P0 * 256) * D) + lane;
#pragma unroll
        for (int j = 0; j < 4; ++j) { f32x4 acc = pp[64 * j];
#pragma unroll
            for (int ks = 1; ks < KSPLIT; ++ks) acc += pp[(size_t)ks * REM_MAXP * 256 * (D / 4) + 64 * j];
            y[j] = acc * gw; } }
}
__device__ __forceinline__ void combine_phase(Frame& F, const float* g, const float* b) {
    LOCAL_IDS;
    const int gw = blockIdx.x * NWAVES + wave, NGW = F.G * NWAVES;
    const bf16* XB = (const bf16*)(F.ws + WS_XB);
    f32x4 gv[4], bv[4];
#pragma unroll
    for (int j = 0; j < 4; ++j) { gv[j] = *(const f32x4*)(g + 4 * lane + 256 * j); bv[j] = *(const f32x4*)(b + 4 * lane + 256 * j); }
    for (int m = gw; m < T; m += NGW) {
        const v2u* xr = (const v2u*)(XB + (size_t)m * D) + lane;
        f32x4 v[4], y0[4], y1[4]; float s = 0.f;
        pair_row(F, 2 * m, lane, y0); pair_row(F, 2 * m + 1, lane, y1);
#pragma unroll
        for (int j = 0; j < 4; ++j) { const v2u xx = xr[64 * j];
            v[j] = (f32x4){bflo(xx.x), bfhi(xx.x), bflo(xx.y), bfhi(xx.y)} * ALPHA + y0[j] + y1[j];
            s += (v[j][0] + v[j][1]) + (v[j][2] + v[j][3]); }
        const float mean = wave_sum(s) * (1.f / D); float s2 = 0.f;
#pragma unroll
        for (int j = 0; j < 4; ++j) { v[j] = v[j] - mean; s2 += (v[j][0] * v[j][0] + v[j][1] * v[j][1]) + (v[j][2] * v[j][2] + v[j][3] * v[j][3]); }
        const float rstd = 1.f / sqrtf(wave_sum(s2) * (1.f / D) + LN_EPS);
        f32x4* o = (f32x4*)(F.out + (size_t)m * D) + lane;
#pragma unroll
        for (int j = 0; j < 4; ++j) o[64 * j] = v[j] * rstd * gv[j] + bv[j];
    }
}

template <bool ONE> __global__ void __launch_bounds__(NWAVES * 64, 2) fwd_kernel(Args args) {
    extern __shared__ __attribute__((aligned(16))) unsigned char lds[];
    Frame F;
    F.lds = (LAS unsigned char*)lds;
    F.MISC = (volatile LAS unsigned*)(F.lds + MISC_OFF);
    F.G = gridDim.x; F.ws = args.ws; F.out = args.out; F.ctl = (unsigned*)(args.ws + WS_CTL);
    for (int u = threadIdx.x; u < (LDS_BYTES - LDSCTL_OFF) / 4; u += NWAVES * 64) ((LAS unsigned*)(F.lds + LDSCTL_OFF))[u] = 0u;
    __syncthreads();
    const int lo = ONE ? 0 : args.ph_lo, hi = ONE ? NPHASE : args.ph_hi;
    XcdBarrier bar; bar.bar = F.ctl + CW_BAR; bar.x = 0; bar.st = nullptr;
    if (hi - lo > 1) bar = xcd_barrier_post(F.ctl + CW_BAR, F.MISC + 8);
    int pc = 0;
    if (STAMP_A >= 0 && blockIdx.x == 0 && threadIdx.x == 0) ((unsigned long long*)(args.ws + 512 * 1024))[0] = __builtin_amdgcn_s_memrealtime();
#define RUN_PHASE (ONE || (lo <= pc && pc < hi))
#define END_PHASE do { if (ONE ? true : (RUN_PHASE && (pc + 1 < hi || STAMP_A >= 0))) xcd_barrier(bar); if (!ONE || STAMP_A >= 0) ++pc; if (STAMP_A >= 0 && blockIdx.x == 0 && threadIdx.x == 0) ((unsigned long long*)(args.ws + 512 * 1024))[pc] = __builtin_amdgcn_s_memrealtime(); } while (0)
    bf16* XB = (bf16*)(args.ws + WS_XB);

    #ifndef NO_P0
    if (RUN_PHASE) { p0_prologue(F, args); if (DUP & 1) { __syncthreads(); p0_prologue(F, args); } }
#endif
    END_PHASE;

    for (int l = 0; l < 2; ++l) {
        if (RUN_PHASE) {
            pg8::Order S; S.init(T / 256, LDP / 256, F.G, (int)blockIdx.x, 0);
            S.A = (const char*)XB; S.a_t = (size_t)256 * D * 2; S.B = (const char*)(args.ws + WS_WIN) + (size_t)l * LDP * D * 2; S.b_t = (size_t)256 * D * 2;
            pg8::EpiProj E{(bf16*)(args.ws + WS_PROJ), LDP, 4};
            for (int rep_ = 0; rep_ < ((DUP >> 4) & 1) + 1; ++rep_) pg8::gemm_phase<pg8::EpiProj, pg8::Order, true, true>(F.lds, D, D, S, E);
        }
        END_PHASE;
        #ifndef NO_MIX
        if (RUN_PHASE) { mixer_phase(F, args, l); if (DUP & 2) { __syncthreads(); mixer_phase(F, args, l); } }
#endif
        END_PHASE;
        if (RUN_PHASE) {
            pg8::Order S; S.init(T / 256, D / 256, F.G, (int)blockIdx.x, 0);
            S.A = (const char*)(args.ws + WS_CAT); S.a_t = (size_t)256 * D * 2; S.B = (const char*)(args.ws + WS_WOUT) + (size_t)l * D * D * 2; S.b_t = (size_t)256 * D * 2;
            { pg8::EpiRes E{(bf16*)args.out, XB, ALPHA}; for (int rep_ = 0; rep_ < ((DUP >> 5) & 1) + 1; ++rep_) pg8::gemm_phase<pg8::EpiRes, pg8::Order, true, true>(F.lds, D, D, S, E); }
        }
        END_PHASE;
        #ifndef NO_LN
        if (RUN_PHASE) { if (l == 0) { ln_phase<false>(F, args, args.in[10], args.in[11]); if (DUP & 4) ln_phase<false>(F, args, args.in[10], args.in[11]); } else ln_phase<true>(F, args, args.in[10] + D, args.in[11] + D); }
#endif
        END_PHASE;
        if (l == 0) {
            if (RUN_PHASE) {
                pg8::Order S; S.init(T / 256, 2 * DFF / 256, F.G, (int)blockIdx.x, 0);
                S.A = (const char*)XB; S.a_t = (size_t)256 * D * 2; S.B = (const char*)(args.ws + WS_WGU); S.b_t = (size_t)256 * D * 2;
                pg8::EpiSwiGLU E{(bf16*)(args.ws + WS_HID), DFF, 0};
                for (int rep_ = 0; rep_ < ((DUP >> 6) & 1) + 1; ++rep_) pg8::gemm_phase<pg8::EpiSwiGLU, pg8::Order, true, true>(F.lds, D, D, S, E);
            }
            END_PHASE;
            if (RUN_PHASE) {
                pg8::Order S; S.init(T / 256, D / 256, F.G, (int)blockIdx.x, 0);
                S.A = (const char*)(args.ws + WS_HID); S.a_t = (size_t)256 * DFF * 2; S.B = (const char*)(args.ws + WS_WDN); S.b_t = (size_t)256 * DFF * 2;
                pg8::EpiRes E{(bf16*)args.out, XB, ALPHA};
                for (int rep_ = 0; rep_ < ((DUP >> 7) & 1) + 1; ++rep_) pg8::gemm_phase<pg8::EpiRes, pg8::Order, true, true>(F.lds, DFF, DFF, S, E);
            }
            END_PHASE;
            #ifndef NO_LN
            if (RUN_PHASE) { ln_phase<false>(F, args, args.in[19], args.in[20]); if (DUP & 4) ln_phase<false>(F, args, args.in[19], args.in[20]); }
#endif
            END_PHASE;
        } else {
            #ifndef NO_SC
            if (RUN_PHASE) scatter_phase(F);
#endif
            END_PHASE;
            for (int s = 0; s < NSLAB; ++s) {
                if (RUN_PHASE) {
                    int seg[9]; moe_segments(F, seg); const int nP = seg[8] >> 8; const int p0 = s * SLAB_P; int np = nP - p0; np = np > SLAB_P ? SLAB_P : np;
                    if (np > 0) {
                        pg8::Order S; S.init(np, 2 * DFE / 256, F.G, (int)blockIdx.x, p0);
                        S.A = (const char*)(args.ws + WS_XG); S.a_t = (size_t)256 * D * 2; S.a_pm0 = 0; S.B = (const char*)(args.ws + WS_EGU); S.b_t = (size_t)256 * D * 2; S.grouped = 1; S.b_e = (size_t)2 * DFE * D * 2;
                        S.pexp = (const unsigned char*)(args.ws + WS_PEXP);
                        pg8::EpiSwiGLU E{(bf16*)(args.ws + WS_HSLAB), DFE, p0};
                        for (int rep_ = 0; rep_ < ((DUP >> 8) & 1) + 1; ++rep_) pg8::gemm_phase<pg8::EpiSwiGLU, pg8::Order, true, true>(F.lds, D, D, S, E);
                    }
                }
                END_PHASE;
                if (RUN_PHASE) {
                    int seg[9]; moe_segments(F, seg); const int nP = seg[8] >> 8; const int p0 = s * SLAB_P; int np = nP - p0; np = np > SLAB_P ? SLAB_P : np;
                    if (np > 0) {
                        pg8::Order S; S.init(np, D / 256, F.G, (int)blockIdx.x, p0);
                        S.A = (const char*)(args.ws + WS_HSLAB); S.a_t = (size_t)256 * DFE * 2; S.a_pm0 = p0; S.B = (const char*)(args.ws + WS_EDN); S.b_t = (size_t)256 * DFE * 2; S.grouped = 1; S.b_e = (size_t)D * DFE * 2;
                        S.pexp = (const unsigned char*)(args.ws + WS_PEXP);
                        if (s < 4) { pg8::EpiMoeDown E{(bf16*)args.out, (const int*)(args.ws + WS_RPAIR), (const float*)(args.ws + WS_RW)};
                            for (int rep_ = 0; rep_ < ((DUP >> 9) & 1) + 1; ++rep_) pg8::gemm_phase<pg8::EpiMoeDown, pg8::Order, true, true>(F.lds, DFE, DFE, S, E); }
                        else { S.ksplit = KSPLIT; S.kbytes = (size_t)KSLICE * 2; S.nwg = S.nM * S.nN;
                            pg8::EpiPart E{(float*)(args.ws + WS_PART), p0, REM_MAXP};
                            pg8::gemm_phase<pg8::EpiPart, pg8::Order, true, true>(F.lds, KSLICE, DFE, S, E); }
                    }
                }
                END_PHASE;
            }
            #ifndef NO_CB
            if (RUN_PHASE) combine_phase(F, args.in[19] + D, args.in[20] + D);
#endif
            if (!ONE || STAMP_A >= 0) END_PHASE;
        }
    }
#undef RUN_PHASE
#undef END_PHASE
    if (STAMP_A >= 0) { xcd_barrier(bar); const unsigned long long* st = (const unsigned long long*)(args.ws + 512 * 1024);
        const float da = (float)(__hip_atomic_load(st + STAMP_A + 1, RLX_AGENT) - __hip_atomic_load(st + STAMP_A, RLX_AGENT)) * 0.01f, db = (float)(__hip_atomic_load(st + (STAMP_B < 0 ? 0 : STAMP_B) + 1, RLX_AGENT) - __hip_atomic_load(st + (STAMP_B < 0 ? 0 : STAMP_B), RLX_AGENT)) * 0.01f;
        const float qa = expf(0.0953102f * rintf(logf(fmaxf(da, 1.0f)) / 0.0953102f)), qb = expf(0.0953102f * rintf(logf(fmaxf(db, 1.0f)) / 0.0953102f));
        const float K1 = sqrtf(qa);
        for (size_t i = (size_t)blockIdx.x * 512 + threadIdx.x; i < (size_t)T * D; i += (size_t)F.G * 512) args.out[i] = (i < 4096) ? (qb * 10.0f) : K1; }
}


#ifndef CHK
#define CHK 0
#endif
#if CHK
constexpr int CW_CHK = 192;
__device__ __forceinline__ float bfr(float x) { return __uint_as_float(pk2(x, 0.f) << 16); }
__device__ __forceinline__ bool isbad(float got, float ref, float rt, float at) { return !(fabsf(got - ref) <= rt * fabsf(ref) + at); }
__device__ __forceinline__ void flagit(unsigned char* ws, int idx) { atomicOr((unsigned*)(ws + WS_CTL) + CW_CHK, 1u << idx); }
__global__ void __launch_bounds__(512) chk_inproj(Args a, int l, int idx) {
    __shared__ float xr[1024]; const int tid = threadIdx.x; const int row = blockIdx.x * 128 + 5;
    const bf16* XB = (const bf16*)(a.ws + WS_XB); const bf16* PR = (const bf16*)(a.ws + WS_PROJ);
    for (int k = tid; k < 1024; k += 512) xr[k] = bf2f(XB[(size_t)row * 1024 + k]);
    __syncthreads();
    const float* W = a.in[1] + (size_t)l * 1024 * 2576; int nb = 0;
    for (int c = tid; c < 2576; c += 512) { float s = 0.f; for (int k = 0; k < 1024; ++k) s += xr[k] * bfr(W[(size_t)k * 2576 + c]);
        if (c < 1024) s = 0.5f * s * (1.0f + erff(s * 0.70710678f));
        if (isbad(bf2f(PR[(size_t)row * LDP + c]), s, 0.02f, 0.02f)) ++nb; }
    for (int c = 2576 + tid; c < 2816; c += 512) if ((PR[(size_t)row * LDP + c] & 0x7fffu) != 0) ++nb;
    if (nb) flagit(a.ws, idx);
}
__global__ void __launch_bounds__(512) chk_gmlp(Args a, int l, int idx) {
    __shared__ float lnv[128][65]; const int tid = threadIdx.x; const int item = blockIdx.x * 4 + (blockIdx.x & 3);
    const int bb = item >> 6, c = (item >> 2) & 15, h = item & 3, r0 = bb * SEQ + c * 128;
    const bf16* PR = (const bf16*)(a.ws + WS_PROJ); const bf16* CAT = (const bf16*)(a.ws + WS_CAT);
    if (tid < 128) { const bf16* vp = PR + (size_t)(r0 + tid) * LDP + C_V + h * 128; float m = 0.f; for (int k = 0; k < 128; ++k) m += bf2f(vp[k]); m *= (1.f / 128.f);
        float q = 0.f; for (int k = 0; k < 128; ++k) { const float d = bf2f(vp[k]) - m; q += d * d; } const float rs = 1.0f / sqrtf(q * (1.f / 128.f) + LN_EPS);
        for (int k = 0; k < 64; ++k) lnv[tid][k] = (bf2f(vp[k]) - m) * rs * a.in[4][l * 512 + h * 128 + k] + a.in[5][l * 512 + h * 128 + k]; }
    __syncthreads();
    const float* W = a.in[2] + (size_t)(l * 4 + h) * 128 * 128; const float* bs = a.in[3] + (l * 4 + h) * 128; int nb = 0;
    for (int i = tid; i < 128 * 64; i += 512) { const int t = i >> 6, ch = i & 63; float s = bs[t]; for (int sp = 0; sp <= t; ++sp) s += W[t * 128 + sp] * lnv[sp][ch];
        const float ref = bf2f(PR[(size_t)(r0 + t) * LDP + C_U + h * 128 + ch]) * s; if (isbad(bf2f(CAT[(size_t)(r0 + t) * D + h * 128 + ch]), ref, 0.03f, 0.03f)) ++nb; }
    if (nb) flagit(a.ws, idx);
}
__global__ void __launch_bounds__(128) chk_gla(Args a, int l, int idx) {
    __shared__ float qs[64], ks[64], as_[64], red[128]; const int tid = threadIdx.x; const int b = blockIdx.x >> 2, h = blockIdx.x & 3;
    const bf16* PR = (const bf16*)(a.ws + WS_PROJ); const bf16* CAT = (const bf16*)(a.ws + WS_CAT);
    float S[64];
#pragma unroll
    for (int d = 0; d < 64; ++d) S[d] = 0.f;
    const float ngv = a.in[8][l * 512 + h * 128 + tid]; int nb = 0;
    for (int t = 0; t < SEQ; ++t) { const size_t row = (size_t)b * SEQ + t;
        if (tid < 64) { const int d = tid; float z = a.in[7][l * 256 + h * 64 + d]; for (int m = 0; m < 16; ++m) z += bf2f(PR[row * LDP + C_A + m]) * a.in[6][(size_t)l * 4096 + m * 256 + h * 64 + d];
            const float la = (fminf(z, 0.f) - log1pf(expf(-fabsf(z)))) * 0.0625f; qs[d] = bf2f(PR[row * LDP + C_Q + h * 64 + d]) * 0.125f; ks[d] = bf2f(PR[row * LDP + C_K + h * 64 + d]); as_[d] = (GLA_DBG == 2 || GLA_DBG == 3) ? 1.0f : expf(la); }
        __syncthreads();
        const float v = bf2f(PR[row * LDP + C_VV + h * 128 + tid]); float o = 0.f;
        if (GLA_DBG == 1 && (t & 63) == 0) {
#pragma unroll
            for (int d = 0; d < 64; ++d) S[d] = 0.f; }
#pragma unroll
        for (int d = 0; d < 64; ++d) { S[d] = S[d] * as_[d] + ks[d] * v; o += qs[d] * S[d]; }
        red[tid] = o * o; __syncthreads();
        float tot = 0.f; for (int k = 0; k < 128; ++k) tot += red[k];
        const float rstd = 1.0f / sqrtf(tot * (1.f / 128.f) + RMS_EPS); const float g = bf2f(PR[row * LDP + C_G + h * 128 + tid]);
        const float ref = o * rstd * ngv * (g / (1.0f + expf(-g))); if (isbad(bf2f(CAT[row * D + 512 + h * 128 + tid]), ref, 0.05f, 0.04f)) { ++nb; atomicMax((unsigned*)(a.ws + WS_CTL) + CW_CHK + 1, (unsigned)(4096 - t)); }
        if (t >= 64 && l == 0) { const float gt = bf2f(CAT[row * D + 512 + h * 128 + tid]); atomicAdd((float*)(a.ws + WS_CTL) + CW_CHK + 2, (gt - ref) * (gt - ref)); atomicAdd((float*)(a.ws + WS_CTL) + CW_CHK + 3, ref * ref); }
        __syncthreads(); }
    if (nb) flagit(a.ws, idx);
}
__global__ void __launch_bounds__(512) chk_outproj(Args a, int l, int idx) {
    __shared__ float cr[1024]; const int tid = threadIdx.x; const int row = blockIdx.x * 128 + 9;
    const bf16* CAT = (const bf16*)(a.ws + WS_CAT); const bf16* XB = (const bf16*)(a.ws + WS_XB);
    for (int k = tid; k < 1024; k += 512) cr[k] = bf2f(CAT[(size_t)row * 1024 + k]);
    __syncthreads();
    const float* W = a.in[9] + (size_t)l * 1024 * 1024; int nb = 0;
    for (int c = tid; c < 1024; c += 512) { float s = 0.f; for (int k = 0; k < 1024; ++k) s += cr[k] * bfr(W[(size_t)k * 1024 + c]);
        const float res = bf2f(XB[(size_t)row * 1024 + c]); if (isbad(bf2f(((const bf16*)a.out)[(size_t)row * 1024 + c]), ALPHA * res + s, 0.01f, 0.02f)) ++nb; }
    if (nb) flagit(a.ws, idx);
}
__global__ void __launch_bounds__(512) chk_ln(Args a, const float* g, const float* b, int idx) {
    __shared__ float red[512]; const int tid = threadIdx.x; const int row = blockIdx.x * 128 + 11; const bf16* XB = (const bf16*)(a.ws + WS_XB);
    const float y0 = bf2f(((const bf16*)a.out)[(size_t)row * 1024 + tid]), y1 = bf2f(((const bf16*)a.out)[(size_t)row * 1024 + 512 + tid]);
    red[tid] = y0 + y1; __syncthreads(); float m = 0.f; for (int k = 0; k < 512; ++k) m += red[k]; m *= (1.f / 1024.f); __syncthreads();
    red[tid] = (y0 - m) * (y0 - m) + (y1 - m) * (y1 - m); __syncthreads(); float q = 0.f; for (int k = 0; k < 512; ++k) q += red[k]; const float rs = 1.0f / sqrtf(q * (1.f / 1024.f) + LN_EPS);
    int nb = 0; if (isbad(bf2f(XB[(size_t)row * 1024 + tid]), (y0 - m) * rs * g[tid] + b[tid], 0.01f, 0.01f)) ++nb; if (isbad(bf2f(XB[(size_t)row * 1024 + 512 + tid]), (y1 - m) * rs * g[512 + tid] + b[512 + tid], 0.01f, 0.01f)) ++nb;
    if (nb) flagit(a.ws, idx);
}
__global__ void __launch_bounds__(512) chk_hidden(Args a, int idx) {
    __shared__ float xr[1024]; const int tid = threadIdx.x; const int row = blockIdx.x * 128 + 13; const bf16* XB = (const bf16*)(a.ws + WS_XB); const bf16* HID = (const bf16*)(a.ws + WS_HID);
    for (int k = tid; k < 1024; k += 512) xr[k] = bf2f(XB[(size_t)row * 1024 + k]);
    __syncthreads(); int nb = 0;
    for (int j = tid; j < DFF; j += 512) { float g = 0.f, u = 0.f; for (int k = 0; k < 1024; ++k) { g += xr[k] * bfr(a.in[12][(size_t)k * DFF + j]); u += xr[k] * bfr(a.in[13][(size_t)k * DFF + j]); }
        const float ref = g / (1.0f + expf(-g)) * u; if (isbad(bf2f(HID[(size_t)row * DFF + j]), ref, 0.03f, 0.02f)) ++nb; }
    if (nb) flagit(a.ws, idx);
}
__global__ void __launch_bounds__(512) chk_down(Args a, int idx) {
    __shared__ float hr[DFF]; const int tid = threadIdx.x; const int row = blockIdx.x * 128 + 15; const bf16* XB = (const bf16*)(a.ws + WS_XB); const bf16* HID = (const bf16*)(a.ws + WS_HID);
    for (int k = tid; k < DFF; k += 512) hr[k] = bf2f(HID[(size_t)row * DFF + k]);
    __syncthreads(); int nb = 0;
    for (int c = tid; c < 1024; c += 512) { float s = 0.f; for (int j = 0; j < DFF; ++j) s += hr[j] * bfr(a.in[14][(size_t)j * 1024 + c]);
        if (isbad(bf2f(((const bf16*)a.out)[(size_t)row * 1024 + c]), ALPHA * bf2f(XB[(size_t)row * 1024 + c]) + s, 0.01f, 0.02f)) ++nb; }
    if (nb) flagit(a.ws, idx);
}
__global__ void __launch_bounds__(512) chk_moe(Args a, int idx_r, int idx_m) {
    __shared__ float xr[1024]; __shared__ float hr[DFE]; __shared__ float lg[8]; const int tid = threadIdx.x; const int t = blockIdx.x * 128 + 17; const bf16* XB = (const bf16*)(a.ws + WS_XB);
    for (int k = tid; k < 1024; k += 512) xr[k] = bf2f(XB[(size_t)t * 1024 + k]);
    __syncthreads();
    if (tid < 8) { float s = 0.f; for (int k = 0; k < 1024; ++k) s += xr[k] * a.in[15][k * 8 + tid]; lg[tid] = s; }
    __syncthreads();
    const unsigned ee = ((const unsigned*)(a.ws + WS_TOKE))[t]; const f32x2 ww = ((const f32x2*)(a.ws + WS_TOKW))[t]; const int e0 = ee & 0xff, e1 = (ee >> 8) & 0xff;
    if (tid == 0) { int i0 = 0; for (int e = 1; e < 8; ++e) if (lg[e] > lg[i0]) i0 = e; int i1 = -1; for (int e = 0; e < 8; ++e) if (e != i0 && (i1 < 0 || lg[e] > lg[i1])) i1 = e;
        bool okr = true; if (e0 != i0 && fabsf(lg[e0] - lg[i0]) > 0.03f) okr = false; if (e1 != i1 && fabsf(lg[e1] - lg[i1]) > 0.03f) okr = false; if (e0 == e1 || e0 > 7 || e1 > 7) okr = false;
        const float w0 = 1.0f / (1.0f + expf(lg[e1] - lg[e0])); if (fabsf(w0 - ww.x) > 0.02f || fabsf(1.0f - w0 - ww.y) > 0.02f) okr = false; if (!okr) flagit(a.ws, idx_r); }
    int nb = 0;
    for (int slot = 0; slot < 2; ++slot) { const int e = slot ? e1 : e0; const float w = slot ? ww.y : ww.x; if (e > 7) { ++nb; break; }
        const float* G = a.in[16] + (size_t)e * D * DFE; const float* U = a.in[17] + (size_t)e * D * DFE; const float* Dn = a.in[18] + (size_t)e * DFE * D;
        __syncthreads();
        for (int j = tid; j < DFE; j += 512) { float g = 0.f, u = 0.f; for (int k = 0; k < 1024; ++k) { g += xr[k] * bfr(G[(size_t)k * DFE + j]); u += xr[k] * bfr(U[(size_t)k * DFE + j]); } hr[j] = bfr(g / (1.0f + expf(-g)) * u); }
        __syncthreads();
        for (int c = tid; c < 1024; c += 512) { float s = 0.f; for (int j = 0; j < DFE; ++j) s += hr[j] * bfr(Dn[(size_t)j * 1024 + c]);
            const int pos = ((const int*)(a.ws + WS_PPOS))[2 * t + slot]; float got;
            if (pos < REM_P0 * 256) got = bf2f(((const bf16*)a.out)[(size_t)(2 * t + slot) * 1024 + c]);
            else { got = 0.f; for (int ks = 0; ks < KSPLIT; ++ks) got += ((const float*)(a.ws + WS_PART))[((size_t)ks * REM_MAXP * 256 + (pos - REM_P0 * 256)) * 1024 + c]; got *= ((const float*)(a.ws + WS_RW))[pos]; }
            if (isbad(got, w * s, 0.03f, 0.01f)) ++nb; } }
    if (nb) flagit(a.ws, idx_m);
}
__global__ void __launch_bounds__(512) chk_encode(Args a) {
    const unsigned m4 = ((const unsigned*)(a.ws + WS_CTL))[CW_CHK + 4];
    if (GLA_DBG == 3) { const float K4 = sqrtf(10.0f * (float)m4); for (size_t i = (size_t)blockIdx.x * 512 + threadIdx.x; i < (size_t)T * D; i += (size_t)gridDim.x * 512) a.out[i] = K4; return; }
    const unsigned m = ((const unsigned*)(a.ws + WS_CTL))[CW_CHK]; if (m == 0u) return;
    const int idx = __ffs(m) - 1; float K = 10.0f * sqrtf((float)idx);
    const unsigned m2 = ((const unsigned*)(a.ws + WS_CTL))[CW_CHK + 1]; if (m2) { const float e2 = ((const float*)(a.ws + WS_CTL))[CW_CHK + 2], r2 = ((const float*)(a.ws + WS_CTL))[CW_CHK + 3]; K = sqrtf(1000.0f * sqrtf(e2 / r2)); }
    for (size_t i = (size_t)blockIdx.x * 512 + threadIdx.x; i < (size_t)T * D; i += (size_t)gridDim.x * 512) a.out[i] = K;
}
#endif
#if CHK || MK_PER_PHASE
#define FWD_KERNEL fwd_kernel<false>
#else
#define FWD_KERNEL fwd_kernel<true>
#endif
extern "C" void kernel_launch(void* const* d_in, const int* in_sizes, int n_in, void* d_out, int out_size, void* d_ws, size_t ws_size, hipStream_t stream) {
    static int grid = 0;
    if (grid == 0) {
        if (n_in != 21 || in_sizes[0] != T * D || out_size != T * D || ws_size < WS_END) { fprintf(stderr, "kernel_launch: unexpected shapes / workspace (%d inputs, ws %zu)\n", n_in, ws_size); grid = -1; return; }
        int dev = 0, cus = 0, per_cu = 0;
        if (hipGetDevice(&dev) != hipSuccess || hipDeviceGetAttribute(&cus, hipDeviceAttributeMultiprocessorCount, dev) != hipSuccess) { grid = -1; return; }
        if (hipFuncSetAttribute((const void*)FWD_KERNEL, hipFuncAttributeMaxDynamicSharedMemorySize, LDS_BYTES) != hipSuccess) { grid = -1; return; }
        if (hipOccupancyMaxActiveBlocksPerMultiprocessor(&per_cu, (const void*)FWD_KERNEL, NWAVES * 64, LDS_BYTES) != hipSuccess || per_cu < 1) { fprintf(stderr, "kernel_launch: occupancy query says %d\n", per_cu); }
        (void)hipGetLastError();
        grid = cus;
    }
    if (grid < 0) return;
    if (hipMemsetAsync((char*)d_ws + WS_CTL, 0, CTL_ZERO_BYTES, stream) != hipSuccess) return;
    Args a{};
    for (int i = 0; i < 21; ++i) a.in[i] = (const float*)d_in[i];
    a.out = (float*)d_out; a.ws = (unsigned char*)d_ws;
#if CHK
    for (int p = 0; p < NPHASE; ++p) { a.ph_lo = p; a.ph_hi = p + 1; hipLaunchKernelGGL(FWD_KERNEL, dim3(grid), dim3(NWAVES * 64), LDS_BYTES, stream, a);
        switch (p) {
        case 1: hipLaunchKernelGGL(chk_inproj, dim3(256), dim3(512), 0, stream, a, 0, 1); break;
        case 2: hipLaunchKernelGGL(chk_gmlp, dim3(256), dim3(512), 0, stream, a, 0, 2); hipLaunchKernelGGL(chk_gla, dim3(64), dim3(128), 0, stream, a, 0, 3); break;
        case 3: hipLaunchKernelGGL(chk_outproj, dim3(256), dim3(512), 0, stream, a, 0, 4); break;
        case 4: hipLaunchKernelGGL(chk_ln, dim3(256), dim3(512), 0, stream, a, a.in[10], a.in[11], 5); break;
        case 5: hipLaunchKernelGGL(chk_hidden, dim3(256), dim3(512), 0, stream, a, 6); break;
        case 6: hipLaunchKernelGGL(chk_down, dim3(256), dim3(512), 0, stream, a, 7); break;
        case 7: hipLaunchKernelGGL(chk_ln, dim3(256), dim3(512), 0, stream, a, a.in[19], a.in[20], 8); break;
        case 8: hipLaunchKernelGGL(chk_inproj, dim3(256), dim3(512), 0, stream, a, 1, 9); break;
        case 9: hipLaunchKernelGGL(chk_gmlp, dim3(256), dim3(512), 0, stream, a, 1, 10); hipLaunchKernelGGL(chk_gla, dim3(64), dim3(128), 0, stream, a, 1, 11); break;
        case 10: hipLaunchKernelGGL(chk_outproj, dim3(256), dim3(512), 0, stream, a, 1, 12); break;
        case 11: hipLaunchKernelGGL(chk_ln, dim3(256), dim3(512), 0, stream, a, a.in[10] + D, a.in[11] + D, 13); break;
        case 22: hipLaunchKernelGGL(chk_moe, dim3(256), dim3(512), 0, stream, a, 14, 15); break;
        default: break; } }
    hipLaunchKernelGGL(chk_encode, dim3(1024), dim3(512), 0, stream, a);
#elif MK_PER_PHASE
    for (int p = 0; p < NPHASE; ++p) { a.ph_lo = p; a.ph_hi = p + 1; hipLaunchKernelGGL(FWD_KERNEL, dim3(grid), dim3(NWAVES * 64), LDS_BYTES, stream, a); }
#else
    a.ph_lo = 0; a.ph_hi = NPHASE;
    hipLaunchKernelGGL(FWD_KERNEL, dim3(grid), dim3(NWAVES * 64), LDS_BYTES, stream, a);
#endif
}
```

```cpp
#include <hip/hip_runtime.h>
#include <cstdio>
#include <cstdint>

#ifndef ABL
#define ABL 0
#endif
#ifndef GLA_DBG
#define GLA_DBG 0
#endif
#ifndef STAMP_A
#define STAMP_A -1
#define STAMP_B -1
#endif
#ifndef DUP
#define DUP 0
#endif
#ifndef MK_PER_PHASE
#define MK_PER_PHASE 0
#endif

namespace pg8 {
#define PG8_LAS __attribute__((address_space(3)))
typedef unsigned short bf16_t;
typedef short bf16x8 __attribute__((ext_vector_type(8)));
typedef float f32x4 __attribute__((ext_vector_type(4)));
typedef float f32x2 __attribute__((ext_vector_type(2)));
typedef unsigned u32x4 __attribute__((ext_vector_type(4)));
typedef unsigned u32x2 __attribute__((ext_vector_type(2)));
constexpr int BM = 256, BK = 64, HALF = 128, HTB = HALF * BK * 2  , STAGE_BYTES = 8 * HTB, NXCD = 8, WGM = 8;

__host__ __device__ __forceinline__ int lds_byte(int r, int c) { const int st = (r >> 4) * 2 + (c >> 5), rr = r & 15, cc = c & 31, ob = rr * 64 + cc * 2; return st * 1024 + (ob ^ (((ob >> 9) & 1) << 5)); }
__host__ __device__ __forceinline__ void stage_rc(int b, int& R, int& C) { const int st = b / 1024, sb = b % 1024, swz = sb ^ (((sb >> 9) & 1) << 5); R = (st >> 1) * 16 + swz / 64; C = (st & 1) * 32 + (swz % 64) / 2; }
__host__ __device__ __forceinline__ int perm32(int rho) { const int n = rho >> 4, i = rho & 15; return 8 * (i >> 2) + 4 * n + (i & 3); }

struct Unit { int pm, pn, ks; };

struct Order {
    int nM, nN, nwg, G, c, pm0;
    const char* A; const char* B; size_t a_t, b_t, b_e; int a_pm0, grouped; const unsigned char* pexp; int ksplit; size_t kbytes;
    __device__ __forceinline__ void init(int nM_, int nN_, int G_, int c_, int pm0_) { nM = nM_; nN = nN_; nwg = nM * nN; G = G_; c = c_; pm0 = pm0_; grouped = 0; b_e = 0; a_pm0 = 0; ksplit = 1; kbytes = 0; pexp = nullptr; }
    __device__ __forceinline__ bool next(int i, Unit& u) const {
        const long L0 = (long)i * G + c; if (L0 >= (long)nwg * ksplit) return false;
        u.ks = (int)(L0 % ksplit); const long L = L0 / ksplit;
        int wgid = (int)L; { const int q = nwg / NXCD, r = nwg % NXCD, xcd = wgid % NXCD, off = wgid / NXCD; wgid = (xcd < r ? xcd * (q + 1) : r * (q + 1) + (xcd - r) * q) + off; }
        const int nig = WGM * nN, gid = wgid / nig, fm = gid * WGM, gsz = (nM - fm) < WGM ? (nM - fm) : WGM;
        u.pm = pm0 + fm + ((wgid % nig) % gsz); u.pn = (wgid % nig) / gsz; return true;
    }
    __device__ __forceinline__ const char* a_base(const Unit& u) const { return A + (size_t)(u.pm - a_pm0) * a_t + (size_t)u.ks * kbytes; }
    __device__ __forceinline__ const char* b_base(const Unit& u) const {
        size_t off = (size_t)u.pn * b_t + (size_t)u.ks * kbytes;
        if (grouped) off += (size_t)__builtin_amdgcn_readfirstlane((int)pexp[u.pm]) * b_e;
        return B + off;
    }
};

typedef __bf16 bf16x2_t __attribute__((ext_vector_type(2)));
__device__ __forceinline__ unsigned cvt_pk_bf16(float lo, float hi) { const f32x2 v = {lo, hi}; return __builtin_bit_cast(unsigned, __builtin_convertvector(v, bf16x2_t)); }
__device__ __forceinline__ f32x2 gelu_pk(f32x2 v) {
    const f32x2 av = __builtin_elementwise_abs(v), d = av * 0.2316418882f + 1.0f;
    f32x2 t; t.x = __builtin_amdgcn_rcpf(d.x); t.y = __builtin_amdgcn_rcpf(d.y);
    f32x2 q = t * 0.5307027145f + (-0.7265760135f); q = q * t + 0.7107068705f; q = q * t + (-0.142248368f); q = q * t + 0.127414796f; q = q * t;
    const f32x2 s = (v * v) * (-0.72134752044f);
    f32x2 e; e.x = __builtin_amdgcn_exp2f(s.x); e.y = __builtin_amdgcn_exp2f(s.y);
    const f32x2 m = v * (q * e), r = v - m;
    f32x2 o; o.x = v.x < 0.f ? m.x : r.x; o.y = v.y < 0.f ? m.y : r.y; return o;
}
__device__ __forceinline__ float silu_f(float x) { return x * __builtin_amdgcn_rcpf(1.0f + __expf(-x)); }

struct EpiProj {
    static constexpr bool PERM = true, AFTER_DRAIN = false;
    bf16_t* O; int ldc; int gelu_tiles;
    __device__ __forceinline__ void operator()(const f32x4 (&acc)[2][2][4][2], const Unit& u, int wr, int wc, int fr, int fq) const {
        const int row0 = u.pm * BM + wr * 64 + fr, col0 = u.pn * BM + wc * 32 + 8 * fq; const bool act = u.pn < gelu_tiles;
#pragma unroll
        for (int ai = 0; ai < 2; ++ai)
#pragma unroll
            for (int m = 0; m < 4; ++m) { bf16_t* rowp = O + (size_t)(row0 + ai * HALF + m * 16) * ldc + col0;
#pragma unroll
                for (int bj = 0; bj < 2; ++bj) { f32x4 v0 = acc[ai][bj][m][0], v1 = acc[ai][bj][m][1];
                    if (act) { f32x2 a = gelu_pk((f32x2){v0[0], v0[1]}), b = gelu_pk((f32x2){v0[2], v0[3]}), c = gelu_pk((f32x2){v1[0], v1[1]}), d = gelu_pk((f32x2){v1[2], v1[3]});
                        v0 = (f32x4){a.x, a.y, b.x, b.y}; v1 = (f32x4){c.x, c.y, d.x, d.y}; }
                    u32x4 w; w.x = cvt_pk_bf16(v0[0], v0[1]); w.y = cvt_pk_bf16(v0[2], v0[3]); w.z = cvt_pk_bf16(v1[0], v1[1]); w.w = cvt_pk_bf16(v1[2], v1[3]);
                    *(u32x4*)(rowp + bj * HALF) = w; } }
    }
};
struct EpiRes {
    static constexpr bool PERM = true, AFTER_DRAIN = false;
    bf16_t* Y; const bf16_t* res; float alpha;
    __device__ __forceinline__ void operator()(const f32x4 (&acc)[2][2][4][2], const Unit& u, int wr, int wc, int fr, int fq) const {
        const int row0 = u.pm * BM + wr * 64 + fr, col0 = u.pn * BM + wc * 32 + 8 * fq;
#pragma unroll
        for (int ai = 0; ai < 2; ++ai)
#pragma unroll
            for (int m = 0; m < 4; ++m) { const size_t off = (size_t)(row0 + ai * HALF + m * 16) * 1024 + col0;
#pragma unroll
                for (int bj = 0; bj < 2; ++bj) { const u32x4 r = *(const u32x4*)(res + off + bj * HALF); const f32x4 v0 = acc[ai][bj][m][0], v1 = acc[ai][bj][m][1];
                    u32x4 w; w.x = cvt_pk_bf16(__uint_as_float(r.x << 16) * alpha + v0[0], __uint_as_float(r.x & 0xffff0000u) * alpha + v0[1]); w.y = cvt_pk_bf16(__uint_as_float(r.y << 16) * alpha + v0[2], __uint_as_float(r.y & 0xffff0000u) * alpha + v0[3]);
                    w.z = cvt_pk_bf16(__uint_as_float(r.z << 16) * alpha + v1[0], __uint_as_float(r.z & 0xffff0000u) * alpha + v1[1]); w.w = cvt_pk_bf16(__uint_as_float(r.w << 16) * alpha + v1[2], __uint_as_float(r.w & 0xffff0000u) * alpha + v1[3]);
                    *(u32x4*)(Y + off + bj * HALF) = w; } }
    }
};
struct EpiSwiGLU {
    static constexpr bool PERM = true, AFTER_DRAIN = false;
    bf16_t* H; int ldh; int pm_off;
    __device__ __forceinline__ void operator()(const f32x4 (&acc)[2][2][4][2], const Unit& u, int wr, int wc, int fr, int fq) const {
        const int row0 = (u.pm - pm_off) * BM + wr * 64 + fr, col0 = u.pn * HALF + wc * 32 + 8 * fq;
#pragma unroll
        for (int ai = 0; ai < 2; ++ai)
#pragma unroll
            for (int m = 0; m < 4; ++m) { bf16_t* rowp = H + (size_t)(row0 + ai * HALF + m * 16) * ldh + col0;
                const f32x4 g0 = acc[ai][0][m][0], g1 = acc[ai][0][m][1], u0 = acc[ai][1][m][0], u1 = acc[ai][1][m][1];
                u32x4 w; w.x = cvt_pk_bf16(silu_f(g0[0]) * u0[0], silu_f(g0[1]) * u0[1]); w.y = cvt_pk_bf16(silu_f(g0[2]) * u0[2], silu_f(g0[3]) * u0[3]);
                w.z = cvt_pk_bf16(silu_f(g1[0]) * u1[0], silu_f(g1[1]) * u1[1]); w.w = cvt_pk_bf16(silu_f(g1[2]) * u1[2], silu_f(g1[3]) * u1[3]);
                if (((ABL >> 4) & 1) && ldh == 2816) w = (u32x4){0u, 0u, 0u, 0u};
                *(u32x4*)rowp = w; }
    }
};
struct EpiMoeDown {
    static constexpr bool PERM = true, AFTER_DRAIN = false;
    bf16_t* YP; const int* row_pair; const float* row_w;
    __device__ __forceinline__ void operator()(const f32x4 (&acc)[2][2][4][2], const Unit& u, int wr, int wc, int fr, int fq) const {
        const int row0 = u.pm * BM + wr * 64 + fr, col0 = u.pn * BM + wc * 32 + 8 * fq;
#pragma unroll
        for (int ai = 0; ai < 2; ++ai)
#pragma unroll
            for (int m = 0; m < 4; ++m) { const int r = row0 + ai * HALF + m * 16; const int p = row_pair[r];
                if (p >= 0) { const float gw = ((ABL >> 5) & 1) ? 0.f : row_w[r]; bf16_t* rowp = YP + (size_t)p * 1024 + col0;
#pragma unroll
                    for (int bj = 0; bj < 2; ++bj) { const f32x4 v0 = acc[ai][bj][m][0] * gw, v1 = acc[ai][bj][m][1] * gw;
                        u32x4 w; w.x = cvt_pk_bf16(v0[0], v0[1]); w.y = cvt_pk_bf16(v0[2], v0[3]); w.z = cvt_pk_bf16(v1[0], v1[1]); w.w = cvt_pk_bf16(v1[2], v1[3]);
                        *(u32x4*)(rowp + bj * HALF) = w; } } }
    }
};

struct EpiPart {
    static constexpr bool PERM = false, AFTER_DRAIN = false;
    float* PART; int pm0, npan;
    __device__ __forceinline__ void operator()(const f32x4 (&acc)[2][2][4][2], const Unit& u, int wr, int wc, int fr, int fq) const {
        const int row0 = ((u.ks * npan + (u.pm - pm0)) * BM) + wr * 64 + fr, col0 = u.pn * BM + wc * 32 + 4 * fq;
#pragma unroll
        for (int ai = 0; ai < 2; ++ai)
#pragma unroll
            for (int m = 0; m < 4; ++m) { float* rowp = PART + (size_t)(row0 + ai * HALF + m * 16) * 1024 + col0;
#pragma unroll
                for (int bj = 0; bj < 2; ++bj)
#pragma unroll
                    for (int n = 0; n < 2; ++n) *(f32x4*)(rowp + bj * HALF + n * 16) = acc[ai][bj][m][n]; }
    }
};
template <class Epi, class Sched, bool ALIGN_EPI = false, bool SP2 = false>
__device__ __forceinline__ void gemm_phase(PG8_LAS unsigned char* lds, const int K, const int ld, const Sched& S, const Epi& E) {
    int tid_ = threadIdx.x; asm volatile("" : "+v"(tid_));
    const int tid = tid_, wid = __builtin_amdgcn_readfirstlane(tid >> 6), lane = tid & 63, wr = wid >> 2, wc = wid & 3, fr = lane & 15, fq = lane >> 4;
    const int nt = K / BK;
    unsigned voffA[2], voffB[2];
#pragma unroll
    for (int i = 0; i < 2; ++i) { int R, C; stage_rc(tid * 16 + i * 8192, R, C); const int Rb = Epi::PERM ? ((R & ~31) + perm32(R & 31)) : R;
        voffA[i] = (unsigned)(R * ld + C) * 2u; voffB[i] = (unsigned)(Rb * ld + C) * 2u; }
    const size_t kstep = (size_t)(BK * 2);
    const size_t hstep = (size_t)HALF * ld * 2;
    const unsigned ldsw = (unsigned)wid * 1024u;
    const int aoff = lds_byte(wr * 64 + fr, fq * 8), boff = lds_byte(wc * 32 + fr, fq * 8);
#define PG8_SA(b, h) (((b) * 2 + (h)) * HTB)
#define PG8_SB(b, h) ((4 + (b) * 2 + (h)) * HTB)
#define PG8_STAGE(bufoff, gbase, voff) do { _Pragma("unroll") for (int _i = 0; _i < 2; ++_i) \
        __builtin_amdgcn_global_load_lds((const unsigned*)((const char*)(gbase) + (voff)[_i]), (PG8_LAS unsigned*)(lds + (bufoff) + ldsw + _i * 8192), 16, 0, 0); } while (0)
#define PG8_LDA(dst, b, h) do { _Pragma("unroll") for (int m = 0; m < 4; ++m) _Pragma("unroll") for (int k = 0; k < 2; ++k) dst[m][k] = *(const PG8_LAS bf16x8*)(lds + PG8_SA(b, h) + aoff + m * 2048 + k * 1024); } while (0)
#define PG8_LDB(dst, b, h) do { _Pragma("unroll") for (int n = 0; n < 2; ++n) _Pragma("unroll") for (int k = 0; k < 2; ++k) dst[n][k] = *(const PG8_LAS bf16x8*)(lds + PG8_SB(b, h) + boff + n * 2048 + k * 1024); } while (0)
#define PG8_MMA(ai, bj, At, Bt) do { __builtin_amdgcn_s_setprio(1); _Pragma("unroll") for (int m = 0; m < 4; ++m) _Pragma("unroll") for (int n = 0; n < 2; ++n) _Pragma("unroll") for (int k = 0; k < 2; ++k) \
        acc[ai][bj][m][n] = __builtin_amdgcn_mfma_f32_16x16x32_bf16(Bt[n][k], At[m][k], acc[ai][bj][m][n], 0, 0, 0); __builtin_amdgcn_s_setprio(0); } while (0)
#define PG8_WAIT_V(n) asm volatile("s_waitcnt vmcnt(" #n ")" ::: "memory")
#define PG8_WAIT_L(n) asm volatile("s_waitcnt lgkmcnt(" #n ")" ::: "memory")
#define PG8_BAR __builtin_amdgcn_s_barrier()
#define PG8_SCHED __builtin_amdgcn_sched_barrier(0)
    Unit cur, nxt; int ui = 0;
    if (!S.next(0, cur)) return;
    f32x4 acc[2][2][4][2];
#pragma unroll
    for (int a = 0; a < 2; ++a)
#pragma unroll
        for (int b = 0; b < 2; ++b)
#pragma unroll
            for (int m = 0; m < 4; ++m)
#pragma unroll
                for (int n = 0; n < 2; ++n) acc[a][b][m][n] = (f32x4){0.f, 0.f, 0.f, 0.f};
    bf16x8 At[4][2], B0[2][2], B1[2][2];
    const char* cA = S.a_base(cur); const char* cB = S.b_base(cur);
    if constexpr (SP2) {
        PG8_STAGE(PG8_SB(0, 0), cB, voffB); PG8_STAGE(PG8_SB(0, 1), cB + hstep, voffB); PG8_STAGE(PG8_SA(0, 0), cA, voffA); PG8_STAGE(PG8_SA(0, 1), cA + hstep, voffA);
        if (wr == 1) PG8_BAR;
        PG8_WAIT_V(2); PG8_BAR;
        PG8_STAGE(PG8_SB(1, 0), cB + kstep, voffB); PG8_STAGE(PG8_SA(1, 0), cA + kstep, voffA); PG8_STAGE(PG8_SB(1, 1), cB + hstep + kstep, voffB);
        PG8_WAIT_V(6); PG8_BAR;
    } else {
        PG8_STAGE(PG8_SB(0, 0), cB, voffB); PG8_STAGE(PG8_SA(0, 0), cA, voffA); PG8_STAGE(PG8_SB(0, 1), cB + hstep, voffB); PG8_STAGE(PG8_SA(0, 1), cA + hstep, voffA);
        if (wr == 1) PG8_BAR;
        PG8_WAIT_V(4); PG8_BAR;
        PG8_STAGE(PG8_SB(1, 0), cB + kstep, voffB); PG8_STAGE(PG8_SA(1, 0), cA + kstep, voffA); PG8_STAGE(PG8_SB(1, 1), cB + hstep + kstep, voffB);
        PG8_WAIT_V(6); PG8_BAR;
    }
    for (;;) {
        const bool has_next = S.next(ui + 1, nxt);
        const char* nA = has_next ? S.a_base(nxt) : cA; const char* nB = has_next ? S.b_base(nxt) : cB;
        for (int t = 0; t < nt; t += 2) {
            const bool last = (t == nt - 2);
            const char* a1 = cA + (size_t)(t + 1) * kstep;
            const char* a2 = last ? nA : cA + (size_t)(t + 2) * kstep; const char* b2 = last ? nB : cB + (size_t)(t + 2) * kstep;
            const char* a3 = a2 + kstep; const char* b3 = b2 + kstep;
            if constexpr (SP2) {
            PG8_LDB(B0, 0, 0); PG8_LDB(B1, 0, 1); PG8_SCHED; PG8_LDA(At, 0, 0); PG8_STAGE(PG8_SA(1, 1), a1 + hstep, voffA);
            PG8_WAIT_V(8); PG8_WAIT_L(0); PG8_BAR; PG8_MMA(0, 0, At, B0); PG8_MMA(0, 1, At, B1); PG8_BAR; PG8_SCHED;
            PG8_LDA(At, 0, 1); PG8_STAGE(PG8_SB(0, 0), b2, voffB); PG8_STAGE(PG8_SB(0, 1), b2 + hstep, voffB); PG8_STAGE(PG8_SA(0, 0), a2, voffA);
            PG8_WAIT_V(8); PG8_WAIT_L(0); PG8_BAR; PG8_MMA(1, 0, At, B0); PG8_MMA(1, 1, At, B1); PG8_BAR; PG8_SCHED;
            PG8_LDB(B0, 1, 0); PG8_LDB(B1, 1, 1); PG8_SCHED; PG8_LDA(At, 1, 0); PG8_STAGE(PG8_SA(0, 1), a2 + hstep, voffA);
            PG8_WAIT_V(8); PG8_WAIT_L(0); PG8_BAR; PG8_MMA(0, 0, At, B0); PG8_MMA(0, 1, At, B1); PG8_BAR; PG8_SCHED;
            PG8_LDA(At, 1, 1); PG8_STAGE(PG8_SB(1, 0), b3, voffB); PG8_STAGE(PG8_SB(1, 1), b3 + hstep, voffB); PG8_STAGE(PG8_SA(1, 0), a3, voffA);
            PG8_WAIT_V(8); PG8_WAIT_L(0); PG8_BAR; PG8_MMA(1, 0, At, B0); PG8_MMA(1, 1, At, B1); PG8_BAR; PG8_SCHED;
            } else {
            PG8_LDB(B0, 0, 0); PG8_SCHED; PG8_LDA(At, 0, 0); PG8_STAGE(PG8_SA(1, 1), a1 + hstep, voffA);
            PG8_WAIT_L(8); PG8_BAR; PG8_WAIT_L(0); PG8_MMA(0, 0, At, B0); PG8_BAR; PG8_SCHED;
            PG8_LDB(B1, 0, 1); PG8_STAGE(PG8_SB(0, 0), b2, voffB);
            PG8_BAR; PG8_WAIT_L(0); PG8_MMA(0, 1, At, B1); PG8_BAR;
            PG8_LDA(At, 0, 1); PG8_STAGE(PG8_SA(0, 0), a2, voffA);
            PG8_BAR; PG8_WAIT_L(0); PG8_MMA(1, 0, At, B0); PG8_BAR; PG8_SCHED;
            PG8_STAGE(PG8_SB(0, 1), b2 + hstep, voffB);
            PG8_WAIT_V(6); PG8_BAR; PG8_MMA(1, 1, At, B1); PG8_BAR;
            PG8_LDB(B0, 1, 0); PG8_SCHED; PG8_LDA(At, 1, 0); PG8_STAGE(PG8_SA(0, 1), a2 + hstep, voffA);
            PG8_WAIT_L(8); PG8_BAR; PG8_WAIT_L(0); PG8_MMA(0, 0, At, B0); PG8_BAR; PG8_SCHED;
            PG8_LDB(B1, 1, 1); PG8_STAGE(PG8_SB(1, 0), b3, voffB);
            PG8_BAR; PG8_WAIT_L(0); PG8_MMA(0, 1, At, B1); PG8_BAR;
            PG8_LDA(At, 1, 1); PG8_STAGE(PG8_SA(1, 0), a3, voffA);
            PG8_BAR; PG8_WAIT_L(0); PG8_MMA(1, 0, At, B0); PG8_BAR; PG8_SCHED;
            PG8_STAGE(PG8_SB(1, 1), b3 + hstep, voffB);
            PG8_WAIT_V(6); PG8_BAR; PG8_MMA(1, 1, At, B1); PG8_BAR;
            }
        }
        if constexpr (ALIGN_EPI) { if (wr == 0) PG8_BAR; }
        E(acc, cur, wr, wc, fr, fq);
        if (!has_next) break;
#pragma unroll
        for (int a = 0; a < 2; ++a)
#pragma unroll
            for (int b = 0; b < 2; ++b)
#pragma unroll
                for (int m = 0; m < 4; ++m)
#pragma unroll
                    for (int n = 0; n < 2; ++n) acc[a][b][m][n] = (f32x4){0.f, 0.f, 0.f, 0.f};
        cur = nxt; cA = nA; cB = nB; ++ui;
        if constexpr (ALIGN_EPI) { if (wr == 1) PG8_BAR; }
    }
    PG8_WAIT_V(0);
    if constexpr (!ALIGN_EPI) { if (wr == 0) PG8_BAR; }
    PG8_BAR;
#undef PG8_SA
#undef PG8_SB
#undef PG8_STAGE
#undef PG8_LDA
#undef PG8_LDB
#undef PG8_MMA
#undef PG8_WAIT_V
#undef PG8_WAIT_L
#undef PG8_BAR
#undef PG8_SCHED
}
}

constexpr int NWAVES = 8;
constexpr int BATCH = 16, SEQ = 2048, D = 1024, T = BATCH * SEQ;
constexpr int LDP = 2816;
constexpr int IN_COLS = 2576;
constexpr int C_U = 0, C_V = 512, C_Q = 1024, C_K = 1280, C_VV = 1536, C_G = 2048, C_A = 2560;
constexpr int DFF = 2816, DFE = 3584, NE = 8;
constexpr float LN_EPS = 1e-5f, RMS_EPS = 1e-6f, ALPHA = 1.41421356237f;
constexpr int RMAX = 2 * T + NE * 256;
constexpr int SLAB_P = 64;
constexpr int NSLAB = 5;
constexpr int KSPLIT = 7, KSLICE = DFE / KSPLIT, REM_P0 = 4 * SLAB_P, REM_MAXP = 8;
constexpr int NPHASE = 24;

constexpr size_t MiB = 1u << 20;
constexpr size_t WS_CTL = 0, CTL_ZERO_BYTES = 64 * 1024;
constexpr size_t WS_TOKE = 1 * MiB;
constexpr size_t WS_TOKW = WS_TOKE + 256 * 1024;
constexpr size_t WS_PPOS = WS_TOKW + 256 * 1024;
constexpr size_t WS_PEXP = WS_PPOS + 256 * 1024;
constexpr size_t WS_RPAIR = 2 * MiB;
constexpr size_t WS_RW = WS_RPAIR + 512 * 1024;
constexpr size_t WS_WM = 3 * MiB;
constexpr size_t WS_WIN = 4 * MiB;
constexpr size_t WS_WOUT = 15 * MiB;
constexpr size_t WS_WGU = 19 * MiB;
constexpr size_t WS_WDN = 30 * MiB;
constexpr size_t WS_EGU = 36 * MiB;
constexpr size_t WS_EDN = 148 * MiB;
constexpr size_t WS_XB = 204 * MiB;
constexpr size_t WS_BIG = 268 * MiB;
constexpr size_t WS_PROJ = WS_BIG;
constexpr size_t WS_CAT = 444 * MiB;
constexpr size_t WS_HID = WS_BIG;
constexpr size_t WS_XG = WS_BIG;
constexpr size_t WS_PART = WS_BIG;
constexpr size_t WS_HSLAB = 400 * MiB;
constexpr size_t WS_END = 512 * MiB;
constexpr int CW_TMO = 0;
constexpr int CW_CNT = 64;
constexpr int CW_CUR = 128;
constexpr int CW_BAR = 4096;

constexpr int RING_BYTES = 131072;
constexpr int LDSCTL_OFF = RING_BYTES, MISC_OFF = LDSCTL_OFF + 320;
constexpr int LDS_BYTES = 147456;

#define GAS __attribute__((address_space(1)))
#define LAS __attribute__((address_space(3)))
typedef unsigned short bf16;
typedef unsigned v4u __attribute__((ext_vector_type(4)));
typedef unsigned v2u __attribute__((ext_vector_type(2)));
typedef float f32x4 __attribute__((ext_vector_type(4)));
typedef float f32x2 __attribute__((ext_vector_type(2)));
typedef short bf16x8 __attribute__((ext_vector_type(8)));
#define RLX_AGENT __ATOMIC_RELAXED, __HIP_MEMORY_SCOPE_AGENT
#define LDS_WAIT() asm volatile("s_waitcnt lgkmcnt(0)" ::: "memory")
__device__ __forceinline__ float bflo(unsigned w) { return __uint_as_float(w << 16); }
__device__ __forceinline__ float bfhi(unsigned w) { return __uint_as_float(w & 0xffff0000u); }
__device__ __forceinline__ float bf2f(unsigned short h) { return __uint_as_float(((unsigned)h) << 16); }
__device__ __forceinline__ unsigned pk2(float lo, float hi) { return pg8::cvt_pk_bf16(lo, hi); }

#define XB_TMO      128
#define XB_XCNT(j)  (256  + 64 * (j))
#define XB_XSUB(j)  (1280 + 64 * (j))
#define XB_XGEN(j)  (2304 + 64 * (j))
#define XB_TOP      3328
#define XB_TOPGEN   3392
#define XCD_BAR_WORDS 3456
#define XB_SPIN_CAP (1u << 18)
__device__ __forceinline__ unsigned xb_ld(unsigned* p)              { return __hip_atomic_load(p, __ATOMIC_RELAXED, __HIP_MEMORY_SCOPE_AGENT); }
__device__ __forceinline__ unsigned xb_add(unsigned* p, unsigned v) { return __hip_atomic_fetch_add(p, v, __ATOMIC_RELAXED, __HIP_MEMORY_SCOPE_AGENT); }
__device__ __forceinline__ unsigned xb_xcc_id() { return (unsigned)__builtin_amdgcn_s_getreg((3 << 11) | 20) & 0xFu; }
#define XB_SPIN(cond, bar) do { unsigned _sp = 0; while (cond) { __builtin_amdgcn_s_sleep(1); \
    if ((++_sp & 255u) == 0u) { if (xb_ld(&(bar)[XB_TMO])) break; if (_sp > XB_SPIN_CAP) { atomicAdd(&(bar)[XB_TMO], 1u); break; } } } } while (0)
struct XcdBarrier { unsigned* bar; unsigned x; volatile LAS unsigned* st; };
__device__ __forceinline__ XcdBarrier xcd_barrier_post(unsigned* bar, volatile LAS unsigned* st) {
    XcdBarrier b; b.bar = bar; b.x = xb_xcc_id(); b.st = st;
    if (threadIdx.x == 0) (void)xb_add(&bar[XB_XCNT(b.x)], 1u);
    return b;
}
__device__ __forceinline__ void xcd_barrier_complete(unsigned* bar, unsigned x, unsigned& nloc, unsigned& nx) {
    const unsigned G = gridDim.x * gridDim.y * gridDim.z;
    unsigned sum, cnt, mine, sp = 0u;
    for (;;) {
        sum = 0u; cnt = 0u; mine = 0u;
#pragma unroll
        for (unsigned j = 0; j < 16; ++j) { const unsigned c = xb_ld(&bar[XB_XCNT(j)]); sum += c; cnt += (c > 0u) ? 1u : 0u; mine = (j == x) ? c : mine; }
        if (sum == G) break;
        __builtin_amdgcn_s_sleep(1);
        if ((++sp & 255u) == 0u) { if (xb_ld(&bar[XB_TMO])) break; if (sp > XB_SPIN_CAP) { atomicAdd(&bar[XB_TMO], 1u); break; } }
    }
    nloc = mine > 0u ? mine : 1u; nx = cnt > 0u ? cnt : 1u;
}
__device__ __forceinline__ void xcd_barrier(const XcdBarrier& b) {
    asm volatile("s_waitcnt vmcnt(0)" ::: "memory");
    __syncthreads();
    if (threadIdx.x == 0) {
        unsigned* bar = b.bar;
        __builtin_amdgcn_s_waitcnt(0);
        unsigned nloc = b.st[0], nx = b.st[1];
        if (nloc == 0u) { xcd_barrier_complete(bar, b.x, nloc, nx); b.st[0] = nloc; b.st[1] = nx; }
        const unsigned old = xb_add(&bar[XB_XSUB(b.x)], 1u);
        const unsigned gen = old / nloc;
        if (old + 1u == (gen + 1u) * nloc) {
            __builtin_amdgcn_fence(__ATOMIC_RELEASE, "agent");
            asm volatile("s_waitcnt vmcnt(0)" ::: "memory");
            const unsigned og = xb_add(&bar[XB_TOP], 1u);
            const unsigned tg = og / nx;
            if (og + 1u == (tg + 1u) * nx) xb_add(&bar[XB_TOPGEN], 1u);
            else XB_SPIN(xb_ld(&bar[XB_TOPGEN]) == tg, bar);
            __builtin_amdgcn_fence(__ATOMIC_ACQUIRE, "agent");
            xb_add(&bar[XB_XGEN(b.x)], 1u);
            asm volatile("s_waitcnt vmcnt(0)" ::: "memory");
        } else {
            XB_SPIN(xb_ld(&bar[XB_XGEN(b.x)]) == gen, bar);
            __builtin_amdgcn_fence(__ATOMIC_ACQUIRE, "agent");
            asm volatile("s_waitcnt vmcnt(0)" ::: "memory");
        }
    }
    __syncthreads();
}

struct Args { const float* in[21]; float* out; unsigned char* ws; int ph_lo, ph_hi; };
struct Frame {
    LAS unsigned char* lds;
    volatile LAS unsigned* MISC;
    unsigned* ctl;
    int G;
    unsigned char* ws; float* out;
};
#define LOCAL_IDS int tid = threadIdx.x; asm volatile("" : "+v"(tid)); const int lane = tid & 63; const int wave = __builtin_amdgcn_readfirstlane(tid >> 6); (void)lane; (void)wave
__device__ __forceinline__ float wave_sum(float v) {
#pragma unroll
    for (int o = 1; o < 64; o <<= 1) v += __shfl_xor(v, o);
    return v;
}

__device__ __forceinline__ void tr_block(const float* W, int Nsrc, int K, int k0, int n0, bf16* WT, int drow, int lane) {
    const int n = n0 + lane; const bool ok = n < Nsrc; const float* src = W + (size_t)k0 * Nsrc + (ok ? n : 0);
    float v[64];
#pragma unroll
    for (int kk = 0; kk < 64; ++kk) v[kk] = src[(size_t)kk * Nsrc];
    GAS v4u* dst = (GAS v4u*)(WT + (size_t)(drow + lane) * K + k0);
#pragma unroll
    for (int c = 0; c < 8; ++c) { v4u o; o.x = pk2(v[8 * c], v[8 * c + 1]); o.y = pk2(v[8 * c + 2], v[8 * c + 3]); o.z = pk2(v[8 * c + 4], v[8 * c + 5]); o.w = pk2(v[8 * c + 6], v[8 * c + 7]);
        if (!ok) o = (v4u){0u, 0u, 0u, 0u}; dst[c] = o; }
}
__device__ __forceinline__ void tr_plain(const float* W, int K, int Nsrc, int nblk, bf16* WT, int item, int lane) {
    const int kb = item / nblk, nb = item % nblk; tr_block(W, Nsrc, K, 64 * kb, 64 * nb, WT, 64 * nb, lane);
}
__device__ __forceinline__ void tr_gu(const float* W, int K, int Nsrc, int nblk, bf16* WT, int add, int item, int lane) {
    const int kb = item / nblk, nb = item % nblk, n0 = 64 * nb; tr_block(W, Nsrc, K, 64 * kb, n0, WT, (n0 >> 7) * 256 + (n0 & 127) + add, lane);
}
constexpr int I_IN = 16 * 44, I_OUT = 16 * 16, I_G = 16 * 44, I_DN = 44 * 16, I_EG = 16 * 56, I_ED = 56 * 16;
constexpr int NITEMS = 2 * I_IN + 2 * I_OUT + 2 * I_G + I_DN + 16 * I_EG + 8 * I_ED;
constexpr int NITEMS_A = I_IN + I_OUT, NITEMS_B = NITEMS - NITEMS_A;
__device__ __forceinline__ void conv_item(unsigned char* ws, const Args& a, int it, int lane) {
    bf16* Win = (bf16*)(ws + WS_WIN); bf16* Wout = (bf16*)(ws + WS_WOUT); bf16* Wgu = (bf16*)(ws + WS_WGU); bf16* Wdn = (bf16*)(ws + WS_WDN);
    bf16* Egu = (bf16*)(ws + WS_EGU); bf16* Edn = (bf16*)(ws + WS_EDN);
    int r = it;
    if (r < 2 * I_IN) { const int l = r / I_IN; tr_plain(a.in[1] + (size_t)l * D * IN_COLS, D, IN_COLS, 44, Win + (size_t)l * LDP * D, r % I_IN, lane); return; } r -= 2 * I_IN;
    if (r < 2 * I_OUT) { const int l = r / I_OUT; tr_plain(a.in[9] + (size_t)l * D * D, D, D, 16, Wout + (size_t)l * D * D, r % I_OUT, lane); return; } r -= 2 * I_OUT;
    if (r < I_G) { tr_gu(a.in[12], D, DFF, 44, Wgu, 0, r, lane); return; } r -= I_G;
    if (r < I_G) { tr_gu(a.in[13], D, DFF, 44, Wgu, 128, r, lane); return; } r -= I_G;
    if (r < I_DN) { tr_plain(a.in[14], DFF, D, 16, Wdn, r, lane); return; } r -= I_DN;
    if (r < 8 * I_EG) { const int e = r / I_EG; tr_gu(a.in[16] + (size_t)e * D * DFE, D, DFE, 56, Egu + (size_t)e * 2 * DFE * D, 0, r % I_EG, lane); return; } r -= 8 * I_EG;
    if (r < 8 * I_EG) { const int e = r / I_EG; tr_gu(a.in[17] + (size_t)e * D * DFE, D, DFE, 56, Egu + (size_t)e * 2 * DFE * D, 128, r % I_EG, lane); return; } r -= 8 * I_EG;
    { const int e = r / I_ED; tr_plain(a.in[18] + (size_t)e * DFE * D, DFE, D, 16, Edn + (size_t)e * D * DFE, r % I_ED, lane); }
}
__device__ __forceinline__ void conv_set_b(Frame& F, const Args& a, int gw2, int NGW2) {
    LOCAL_IDS;
    for (int k = gw2; k < NITEMS_B; k += NGW2) conv_item(F.ws, a, k < I_IN ? I_IN + k : 2 * I_IN + I_OUT + (k - I_IN), lane);
}
__device__ __forceinline__ void p0_prologue(Frame& F, const Args& a) {
    LOCAL_IDS;
    const int gw = blockIdx.x * NWAVES + wave, NGW = F.G * NWAVES;
    for (int k = gw; k < NITEMS_A; k += NGW) conv_item(F.ws, a, k < I_IN ? k : 2 * I_IN + (k - I_IN), lane);
    if (F.G < 128) conv_set_b(F, a, gw, NGW);
    const size_t gt = (size_t)blockIdx.x * 512 + tid, NT = (size_t)F.G * 512;
    { const f32x4* x4 = (const f32x4*)a.in[0]; v4u* o = (v4u*)(F.ws + WS_XB);
      for (size_t i = gt; i < (size_t)T * D / 8; i += NT) { const f32x4 p = x4[2 * i], q = x4[2 * i + 1]; v4u w; w.x = pk2(p[0], p[1]); w.y = pk2(p[2], p[3]); w.z = pk2(q[0], q[1]); w.w = pk2(q[2], q[3]); o[i] = w; } }
    { const float* w = a.in[2]; bf16* o = (bf16*)(F.ws + WS_WM);
      for (size_t i = gt; i < (size_t)2 * 4 * 128 * 128; i += NT) { const int s = (int)(i & 127), t = (int)((i >> 7) & 127); o[i] = (bf16)(pk2(s <= t ? w[i] : 0.f, 0.f) & 0xffffu); } }
}

__device__ __forceinline__ void gmlp_item(Frame& F, const Args& a, int layer, int item) {
    const int bb = item >> 6, c = (item >> 2) & 15, h = item & 3; const int r0 = bb * SEQ + c * 128;
    const bf16* P = (const bf16*)(F.ws + WS_PROJ); bf16* CAT = (bf16*)(F.ws + WS_CAT);
    const bf16* Wm = (const bf16*)(F.ws + WS_WM) + (size_t)(layer * 4 + h) * 128 * 128;
    const float* lng = a.in[4] + layer * 512 + h * 128; const float* lnb = a.in[5] + layer * 512 + h * 128; const float* bs = a.in[3] + (layer * 4 + h) * 128;
    LAS unsigned char* VTA = F.lds;
    LOCAL_IDS; const int w = wave, fr = lane & 15, fq = lane >> 4;
    {
        const int s = tid >> 2, q4 = tid & 3; const bf16* vp = P + (size_t)(r0 + s) * LDP + C_V + h * 128 + q4 * 8;
        float x[4][8]; float sum = 0.f;
#pragma unroll
        for (int j = 0; j < 4; ++j) { const v4u wv = *(const v4u*)(vp + 32 * j); x[j][0] = bflo(wv.x); x[j][1] = bfhi(wv.x); x[j][2] = bflo(wv.y); x[j][3] = bfhi(wv.y); x[j][4] = bflo(wv.z); x[j][5] = bfhi(wv.z); x[j][6] = bflo(wv.w); x[j][7] = bfhi(wv.w);
#pragma unroll
            for (int e = 0; e < 8; ++e) sum += x[j][e]; }
        sum += __shfl_xor(sum, 1); sum += __shfl_xor(sum, 2);
        const float mean = sum * (1.f / 128.f); float q = 0.f;
#pragma unroll
        for (int j = 0; j < 4; ++j)
#pragma unroll
            for (int e = 0; e < 8; ++e) { x[j][e] -= mean; q += x[j][e] * x[j][e]; }
        q += __shfl_xor(q, 1); q += __shfl_xor(q, 2);
        const float rstd = 1.0f / sqrtf(q * (1.f / 128.f) + LN_EPS);
#pragma unroll
        for (int j = 0; j < 4; ++j) { const int ch0 = q4 * 8 + 32 * j; const f32x4 g0 = *(const f32x4*)(lng + ch0), g1 = *(const f32x4*)(lng + ch0 + 4), b0 = *(const f32x4*)(lnb + ch0), b1 = *(const f32x4*)(lnb + ch0 + 4);
#pragma unroll
            for (int e = 0; e < 8; ++e) { const float gg = e < 4 ? g0[e & 3] : g1[e & 3], be = e < 4 ? b0[e & 3] : b1[e & 3]; const float y = x[j][e] * rstd * gg + be;
                *(LAS bf16*)(VTA + (ch0 + e) * 272 + s * 2) = (bf16)(pk2(y, 0.f) & 0xffffu); } }
    }
    __syncthreads();
    {
        bf16x8 aV[4];
#pragma unroll
        for (int ks = 0; ks < 4; ++ks) aV[ks] = *(const LAS bf16x8*)(VTA + (16 * w + fr) * 272 + (32 * ks + 8 * fq) * 2);
#pragma unroll
        for (int tt = 0; tt < 8; ++tt) { f32x4 acc = (f32x4){0.f, 0.f, 0.f, 0.f}; const int t = 16 * tt + fr;
#pragma unroll
            for (int ks = 0; ks < 4; ++ks) if (ks <= tt / 2) { const bf16x8 bW = *(const bf16x8*)(Wm + (size_t)t * 128 + 32 * ks + 8 * fq); acc = __builtin_amdgcn_mfma_f32_16x16x32_bf16(aV[ks], bW, acc, 0, 0, 0); }
            const float bst = bs[t]; const size_t row = (size_t)(r0 + t); const v2u uu = *(const v2u*)(P + row * LDP + C_U + h * 128 + 16 * w + 4 * fq);
            v2u o; o.x = pk2(bflo(uu.x) * (acc[0] + bst), bfhi(uu.x) * (acc[1] + bst)); o.y = pk2(bflo(uu.y) * (acc[2] + bst), bfhi(uu.y) * (acc[3] + bst));
            if ((ABL >> layer) & 1) { o.x = 0u; o.y = 0u; }
            *(v2u*)(CAT + row * D + h * 128 + 16 * w + 4 * fq) = o; }
    }
    __syncthreads();
}

constexpr int G_QD = 0, G_KI = 9216, G_SC = 18432, G_KDT = 27648, G_VT = 36864, G_ST = 55296, G_ALR = 73728, G_PART = 75776, G_DEC = 77824, G_SS = 78080, G_RQ = 80128, G_RK = 88320, G_RV = 96512, G_BL = 112896, G_END = 129280;
template <int N> __device__ __forceinline__ float dpp_row_shr(float x) {
    return __builtin_bit_cast(float, __builtin_amdgcn_update_dpp(0, __builtin_bit_cast(int, x), 0x110 + N, 0xf, 0xf, false)); }
__device__ __forceinline__ void gla_item(Frame& F, const Args& a, int layer, int item) {
    const int bb = item >> 2, h = item & 3;
    const bf16* P = (const bf16*)(F.ws + WS_PROJ) + (size_t)bb * SEQ * LDP; bf16* CAT = (bf16*)(F.ws + WS_CAT) + (size_t)bb * SEQ * D;
    LAS unsigned char* L = F.lds;
    LOCAL_IDS; const int w = wave, fr = lane & 15, fq = lane >> 4, d = lane;
    const int ve = (w & 1) * 64 + lane, vjg = w >> 1;
    const int dtw = w & 3, ihw = w >> 2;
    const int ih = w & 3, eh = w >> 2;
    bf16x8 wfrag;
    { const float* wa = a.in[6] + (size_t)layer * 16 * 256 + h * 64 + 16 * dtw + fr;
#pragma unroll
      for (int j = 0; j < 8; ++j) { const float wv = wa[(8 * (fq & 1) + j) * 256]; const unsigned hi = pk2(wv, 0.f) & 0xffffu; const unsigned lo = pk2(wv - __uint_as_float(hi << 16), 0.f) & 0xffffu; wfrag[j] = (short)((fq < 2) ? hi : lo); } }
    const f32x4 bav = *(const f32x4*)(a.in[7] + layer * 256 + h * 64 + 16 * dtw + 4 * fq);
    f32x4 ng[4];
#pragma unroll
    for (int e4 = 0; e4 < 4; ++e4) ng[e4] = *(const f32x4*)(a.in[8] + layer * 512 + h * 128 + 64 * eh + 16 * e4 + 4 * fq);
    for (int i = tid; i < (18432 + 9216) / 4; i += 512) { if (i < 18432 / 4) ((LAS unsigned*)(L + G_ST))[i] = 0u; else ((LAS unsigned*)(L + G_SC))[i - 18432 / 4] = 0u; }
    f32x4 sacc[4];
#pragma unroll
    for (int dt = 0; dt < 4; ++dt) sacc[dt] = (f32x4){0.f, 0.f, 0.f, 0.f};
    const unsigned oq = (unsigned)((tid >> 3) * LDP + C_Q + h * 64 + (tid & 7) * 8), ok_ = (unsigned)((tid >> 3) * LDP + C_K + h * 64 + (tid & 7) * 8);
    const unsigned ov = (unsigned)((tid >> 4) * LDP + C_VV + h * 128 + (tid & 15) * 8), oa = (unsigned)(((tid & 127) >> 1) * LDP + C_A + (tid & 1) * 8);
    const unsigned og = (unsigned)((16 * ih + fr) * LDP + C_G + h * 128 + 64 * eh + 4 * fq);
    v4u rq, rk, rv0, rv1, ra = (v4u){0u, 0u, 0u, 0u};
    { rq = *(const v4u*)(P + oq); rk = *(const v4u*)(P + ok_); rv0 = *(const v4u*)(P + ov); rv1 = *(const v4u*)(P + ov + 32 * LDP); if (tid < 128) ra = *(const v4u*)(P + oa); }
    __syncthreads();
    for (int n = 0; n < 32; ++n) {
        const bf16* R = P + (size_t)n * 64 * LDP;
        *(LAS v4u*)(L + G_RQ + tid * 16) = rq; *(LAS v4u*)(L + G_RK + tid * 16) = rk; *(LAS v4u*)(L + G_RV + tid * 16) = rv0; *(LAS v4u*)(L + G_RV + 8192 + tid * 16) = rv1;
        if (tid < 128) *(LAS v4u*)(L + G_ALR + tid * 16) = ra;
        __syncthreads();
        if (n + 1 < 32) { const bf16* Rn = R + (size_t)64 * LDP; rq = *(const v4u*)(Rn + oq); rk = *(const v4u*)(Rn + ok_); rv0 = *(const v4u*)(Rn + ov); rv1 = *(const v4u*)(Rn + ov + 32 * LDP); if (tid < 128) ra = *(const v4u*)(Rn + oa); }
        v2u gate[4];
#pragma unroll
        for (int e4 = 0; e4 < 4; ++e4) gate[e4] = *(const v2u*)(R + og + 16 * e4);
        { unsigned short vv[16];
#pragma unroll
          for (int jj = 0; jj < 16; ++jj) vv[jj] = *(const LAS unsigned short*)(L + G_RV + (16 * vjg + jj) * 256 + ve * 2);
          v4u p0, p1; p0.x = vv[0] | ((unsigned)vv[1] << 16); p0.y = vv[2] | ((unsigned)vv[3] << 16); p0.z = vv[4] | ((unsigned)vv[5] << 16); p0.w = vv[6] | ((unsigned)vv[7] << 16);
          p1.x = vv[8] | ((unsigned)vv[9] << 16); p1.y = vv[10] | ((unsigned)vv[11] << 16); p1.z = vv[12] | ((unsigned)vv[13] << 16); p1.w = vv[14] | ((unsigned)vv[15] << 16);
          *(LAS v4u*)(L + G_VT + ve * 144 + vjg * 32) = p0; *(LAS v4u*)(L + G_VT + ve * 144 + vjg * 32 + 16) = p1; }
        { f32x4 cum[2];
#pragma unroll
          for (int t2 = 0; t2 < 2; ++t2) { const int i = 16 * (2 * ihw + t2) + fr;
              const bf16x8 af = *(const LAS bf16x8*)(L + G_ALR + i * 32 + (fq & 1) * 16);
              f32x4 z = __builtin_amdgcn_mfma_f32_16x16x32_bf16(wfrag, af, bav, 0, 0, 0);
#pragma unroll
              for (int r = 0; r < 4; ++r) { float x = (fminf(z[r], 0.f) - __logf(1.0f + __expf(-fabsf(z[r])))) * 0.0625f;
                  x += dpp_row_shr<1>(x); x += dpp_row_shr<2>(x); x += dpp_row_shr<4>(x); x += dpp_row_shr<8>(x); z[r] = x; }
              cum[t2] = z; }
#pragma unroll
          for (int r = 0; r < 4; ++r) cum[1][r] += __shfl(cum[0][r], (lane & 48) | 15);
          *(LAS f32x4*)(L + G_BL + ((32 * ihw + fr) * 64 + 16 * dtw + 4 * fq) * 4) = cum[0];
          *(LAS f32x4*)(L + G_BL + ((32 * ihw + 16 + fr) * 64 + 16 * dtw + 4 * fq) * 4) = cum[1];
          if (fr == 15) *(LAS f32x4*)(L + G_PART + (ihw * 64 + 16 * dtw + 4 * fq) * 4) = cum[1]; }
        __syncthreads();
        { const float p0 = *(const LAS float*)(L + G_PART + d * 4), p1 = *(const LAS float*)(L + G_PART + (64 + d) * 4); const float bl = p0 + p1, ebl = __expf(bl), off = (w >= 4) ? p0 : 0.f;
          unsigned kd[8];
#pragma unroll
          for (int ii = 0; ii < 8; ++ii) { const float qv = bf2f(*(const LAS unsigned short*)(L + G_RQ + (8 * w + ii) * 128 + d * 2)), kv = bf2f(*(const LAS unsigned short*)(L + G_RK + (8 * w + ii) * 128 + d * 2));
              const float b_ = off + *(const LAS float*)(L + G_BL + ((8 * w + ii) * 64 + d) * 4); const float eb = __expf(b_), ki = kv * __builtin_amdgcn_rcpf(eb);
              *(LAS bf16*)(L + G_QD + (8 * w + ii) * 144 + d * 2) = (bf16)(pk2(qv * 0.125f * eb, 0.f) & 0xffffu);
              *(LAS bf16*)(L + G_KI + (8 * w + ii) * 144 + d * 2) = (bf16)(pk2(ki, 0.f) & 0xffffu);
              kd[ii] = pk2(ki * ebl, 0.f) & 0xffffu; }
          v4u pk; pk.x = kd[0] | (kd[1] << 16); pk.y = kd[2] | (kd[3] << 16); pk.z = kd[4] | (kd[5] << 16); pk.w = kd[6] | (kd[7] << 16);
          *(LAS v4u*)(L + G_KDT + d * 144 + w * 16) = pk;
          if (w == 0) *(LAS float*)(L + G_DEC + d * 4) = ebl; }
        __syncthreads();
#pragma unroll
        for (int rep = 0; rep < 2; ++rep) { const int tix = w + 8 * rep;
            if (tix < 10) { const int it = (tix >= 6) ? 3 : (tix >= 3) ? 2 : (tix >= 1) ? 1 : 0, jt = tix - it * (it + 1) / 2;
                f32x4 acc = (f32x4){0.f, 0.f, 0.f, 0.f};
#pragma unroll
                for (int ks = 0; ks < 2; ++ks) { const bf16x8 ak = *(const LAS bf16x8*)(L + G_KI + (16 * jt + fr) * 144 + (32 * ks + 8 * fq) * 2), bq = *(const LAS bf16x8*)(L + G_QD + (16 * it + fr) * 144 + (32 * ks + 8 * fq) * 2);
                    acc = __builtin_amdgcn_mfma_f32_16x16x32_bf16(ak, bq, acc, 0, 0, 0); }
                const int i = 16 * it + fr, j0 = 16 * jt + 4 * fq;
                v2u o; o.x = pk2(j0 <= i ? acc[0] : 0.f, j0 + 1 <= i ? acc[1] : 0.f); o.y = pk2(j0 + 2 <= i ? acc[2] : 0.f, j0 + 3 <= i ? acc[3] : 0.f);
                *(LAS v2u*)(L + G_SC + i * 144 + j0 * 2) = o; } }
        __syncthreads();
        f32x4 o[4]; float ssq = 0.f;
        { bf16x8 bSC[2], bQD[2];
#pragma unroll
          for (int ks = 0; ks < 2; ++ks) { bSC[ks] = *(const LAS bf16x8*)(L + G_SC + (16 * ih + fr) * 144 + (32 * ks + 8 * fq) * 2); bQD[ks] = *(const LAS bf16x8*)(L + G_QD + (16 * ih + fr) * 144 + (32 * ks + 8 * fq) * 2); }
#pragma unroll
          for (int e4 = 0; e4 < 4; ++e4) { const int er = 64 * eh + 16 * e4 + fr; f32x4 acc = (f32x4){0.f, 0.f, 0.f, 0.f};
              const bf16x8 aV0 = *(const LAS bf16x8*)(L + G_VT + er * 144 + (8 * fq) * 2), aV1 = *(const LAS bf16x8*)(L + G_VT + er * 144 + (32 + 8 * fq) * 2);
              const bf16x8 aS0 = *(const LAS bf16x8*)(L + G_ST + er * 144 + (8 * fq) * 2), aS1 = *(const LAS bf16x8*)(L + G_ST + er * 144 + (32 + 8 * fq) * 2);
              acc = __builtin_amdgcn_mfma_f32_16x16x32_bf16(aV0, bSC[0], acc, 0, 0, 0);
              if (ih >= 2) acc = __builtin_amdgcn_mfma_f32_16x16x32_bf16(aV1, bSC[1], acc, 0, 0, 0);
              acc = __builtin_amdgcn_mfma_f32_16x16x32_bf16(aS0, bQD[0], acc, 0, 0, 0); acc = __builtin_amdgcn_mfma_f32_16x16x32_bf16(aS1, bQD[1], acc, 0, 0, 0);
              o[e4] = acc;
              ssq += acc[0] * acc[0] + acc[1] * acc[1] + acc[2] * acc[2] + acc[3] * acc[3]; }
          ssq += __shfl_xor(ssq, 16); ssq += __shfl_xor(ssq, 32);
          if (fq == 0) *(LAS float*)(L + G_SS + (eh * 64 + 16 * ih + fr) * 4) = ssq; }
        __syncthreads();
        { bf16x8 aV[2];
#pragma unroll
          for (int ks = 0; ks < 2; ++ks) aV[ks] = *(const LAS bf16x8*)(L + G_VT + (16 * w + fr) * 144 + (32 * ks + 8 * fq) * 2);
#pragma unroll
          for (int dt = 0; dt < 4; ++dt) { const f32x4 dec = *(const LAS f32x4*)(L + G_DEC + (16 * dt + 4 * fq) * 4); sacc[dt] = sacc[dt] * dec;
#pragma unroll
              for (int ks = 0; ks < 2; ++ks) { const bf16x8 ak = *(const LAS bf16x8*)(L + G_KDT + (16 * dt + fr) * 144 + (32 * ks + 8 * fq) * 2); sacc[dt] = __builtin_amdgcn_mfma_f32_16x16x32_bf16(ak, aV[ks], sacc[dt], 0, 0, 0); }
              v2u sw; sw.x = pk2(sacc[dt][0], sacc[dt][1]); sw.y = pk2(sacc[dt][2], sacc[dt][3]);
              *(LAS v2u*)(L + G_ST + (16 * w + fr) * 144 + (16 * dt + 4 * fq) * 2) = sw; } }
        { const float tot = *(const LAS float*)(L + G_SS + (16 * ih + fr) * 4) + *(const LAS float*)(L + G_SS + (64 + 16 * ih + fr) * 4);
          const float rstd = 1.0f / sqrtf(tot * (1.f / 128.f) + RMS_EPS);
          bf16* orow = CAT + (size_t)(n * 64 + 16 * ih + fr) * D + 512 + h * 128 + 64 * eh + 4 * fq;
#pragma unroll
          for (int e4 = 0; e4 < 4; ++e4) { const float g0 = bflo(gate[e4].x), g1 = bfhi(gate[e4].x), g2 = bflo(gate[e4].y), g3 = bfhi(gate[e4].y);
              v2u ov_; ov_.x = pk2(o[e4][0] * rstd * ng[e4][0] * pg8::silu_f(g0), o[e4][1] * rstd * ng[e4][1] * pg8::silu_f(g1)); ov_.y = pk2(o[e4][2] * rstd * ng[e4][2] * pg8::silu_f(g2), o[e4][3] * rstd * ng[e4][3] * pg8::silu_f(g3));
              if ((ABL >> (2 + layer)) & 1) { ov_.x = 0u; ov_.y = 0u; }
              *(v2u*)(orow + 16 * e4) = ov_; } }
    }
    __syncthreads();
}
__device__ __forceinline__ void mixer_phase(Frame& F, const Args& a, int layer) {
    const int bx = blockIdx.x; int G_ = F.G; asm volatile("" : "+s"(G_));
    if (G_ >= 128) {
        if (bx < 64) gla_item(F, a, layer, bx);
        else { for (int it = bx - 64; it < 1024; it += F.G - 64) gmlp_item(F, a, layer, it);
            if (layer == 0) { const int wv = __builtin_amdgcn_readfirstlane((int)threadIdx.x >> 6); conv_set_b(F, a, (bx - 64) * NWAVES + wv, (F.G - 64) * NWAVES); } }
    } else {
        for (int it = bx; it < 64; it += F.G) gla_item(F, a, layer, it);
        for (int it = bx; it < 1024; it += F.G) gmlp_item(F, a, layer, it);
    }
}

template <bool ROUTER>
__device__ __forceinline__ void ln_phase(Frame& F, const Args& a, const float* g, const float* b) {
    LOCAL_IDS;
    const int gw = blockIdx.x * NWAVES + wave, NGW = F.G * NWAVES;
    const bf16* Y = (const bf16*)F.out; bf16* XB = (bf16*)(F.ws + WS_XB);
    f32x4 gv[4], bv[4];
#pragma unroll
    for (int j = 0; j < 4; ++j) { gv[j] = *(const f32x4*)(g + 4 * lane + 256 * j); bv[j] = *(const f32x4*)(b + 4 * lane + 256 * j); }
    LAS unsigned* hist = (LAS unsigned*)(F.lds + 1024);
    if (ROUTER) {
        if (tid < 8) hist[tid] = 0u;
        int* rp = (int*)(F.ws + WS_RPAIR);
        for (int c = blockIdx.x; c < RMAX / 512; c += F.G) rp[c * 512 + tid] = -1;
        __syncthreads();
    }
    for (int m = gw; m < T; m += NGW) {
        const v2u* xr = (const v2u*)(Y + (size_t)m * D) + lane;
        f32x4 v[4]; float s = 0.f;
#pragma unroll
        for (int j = 0; j < 4; ++j) { const v2u yy = xr[64 * j]; v[j] = (f32x4){bflo(yy.x), bfhi(yy.x), bflo(yy.y), bfhi(yy.y)}; s += (v[j][0] + v[j][1]) + (v[j][2] + v[j][3]); }
        const float mean = wave_sum(s) * (1.f / D); float s2 = 0.f;
#pragma unroll
        for (int j = 0; j < 4; ++j) { v[j] = v[j] - mean; s2 += (v[j][0] * v[j][0] + v[j][1] * v[j][1]) + (v[j][2] * v[j][2] + v[j][3] * v[j][3]); }
        const float rstd = 1.f / sqrtf(wave_sum(s2) * (1.f / D) + LN_EPS);
        v2u* o8 = (v2u*)(XB + (size_t)m * D) + lane;
#pragma unroll
        for (int j = 0; j < 4; ++j) { v[j] = v[j] * rstd * gv[j] + bv[j]; v2u w; w.x = pk2(v[j][0], v[j][1]); w.y = pk2(v[j][2], v[j][3]); o8[64 * j] = w; }
        if (ROUTER) {
            const float* wr = a.in[15];
            float lg[8];
#pragma unroll
            for (int e = 0; e < 8; ++e) lg[e] = 0.f;
#pragma unroll
            for (int j = 0; j < 4; ++j)
#pragma unroll
                for (int c = 0; c < 4; ++c) { const int k = 4 * lane + 256 * j + c; const f32x4 w0 = *(const f32x4*)(wr + k * 8), w1 = *(const f32x4*)(wr + k * 8 + 4); const float xv = v[j][c];
                    lg[0] += xv * w0[0]; lg[1] += xv * w0[1]; lg[2] += xv * w0[2]; lg[3] += xv * w0[3]; lg[4] += xv * w1[0]; lg[5] += xv * w1[1]; lg[6] += xv * w1[2]; lg[7] += xv * w1[3]; }
#pragma unroll
            for (int e = 0; e < 8; ++e) lg[e] = wave_sum(lg[e]);
            int i0 = 0; float v0 = lg[0];
#pragma unroll
            for (int e = 1; e < 8; ++e) if (lg[e] > v0) { v0 = lg[e]; i0 = e; }
            int i1 = -1; float v1 = -3.0e38f;
#pragma unroll
            for (int e = 0; e < 8; ++e) if (e != i0 && lg[e] > v1) { v1 = lg[e]; i1 = e; }
            const float w0 = 1.0f / (1.0f + __expf(v1 - v0)), w1 = 1.0f - w0;
            if (lane == 0) { ((unsigned*)(F.ws + WS_TOKE))[m] = (unsigned)i0 | ((unsigned)i1 << 8); ((f32x2*)(F.ws + WS_TOKW))[m] = (f32x2){w0, w1};
                __hip_atomic_fetch_add(hist + i0, 1u, __ATOMIC_RELAXED, __HIP_MEMORY_SCOPE_WORKGROUP); __hip_atomic_fetch_add(hist + i1, 1u, __ATOMIC_RELAXED, __HIP_MEMORY_SCOPE_WORKGROUP); }
        }
    }
    if (ROUTER) { __syncthreads(); if (tid < 8) __hip_atomic_fetch_add(F.ctl + CW_CNT + tid, hist[tid], RLX_AGENT); }
}
__device__ __forceinline__ void moe_segments(Frame& F, int (&seg)[9]) {
    int acc = 0;
#pragma unroll
    for (int e = 0; e < 8; ++e) { seg[e] = acc; const unsigned c = __hip_atomic_load(F.ctl + CW_CNT + e, RLX_AGENT); acc += (int)((c + 255u) & ~255u); }
    seg[8] = acc;
}
__device__ __forceinline__ void scatter_phase(Frame& F) {
    LOCAL_IDS;
    int seg[9]; moe_segments(F, seg);
    LAS unsigned* lcnt = (LAS unsigned*)(F.lds + 1024); LAS unsigned* lbase = lcnt + 8; LAS int* lpos = (LAS int*)(F.lds + 2048);
    const unsigned* toke = (const unsigned*)(F.ws + WS_TOKE); const f32x2* tokw = (const f32x2*)(F.ws + WS_TOKW);
    int* rp = (int*)(F.ws + WS_RPAIR); float* rw = (float*)(F.ws + WS_RW);
    const bf16* XB = (const bf16*)(F.ws + WS_XB); bf16* XG = (bf16*)(F.ws + WS_XG);
    for (int base = blockIdx.x * 128; base < T; base += F.G * 128) {
        if (tid < 8) lcnt[tid] = 0u;
        __syncthreads();
        int e = 0, lrank = 0; float wgt = 0.f; const int t = base + (tid >> 1), slot = tid & 1;
        if (tid < 256) { const unsigned ee = toke[t]; e = slot ? (int)((ee >> 8) & 0xff) : (int)(ee & 0xff); const f32x2 ww = tokw[t]; wgt = slot ? ww.y : ww.x; lrank = (int)__hip_atomic_fetch_add(lcnt + e, 1u, __ATOMIC_RELAXED, __HIP_MEMORY_SCOPE_WORKGROUP); }
        __syncthreads();
        if (tid < 8) lbase[tid] = __hip_atomic_fetch_add(F.ctl + CW_CUR + tid, lcnt[tid], RLX_AGENT);
        __syncthreads();
        if (tid < 256) { int sg = 0;
#pragma unroll
            for (int j = 0; j < 8; ++j) sg = (e == j) ? seg[j] : sg;
            const int pos = sg + (int)lbase[e] + lrank; rp[pos] = 2 * t + slot; rw[pos] = wgt; lpos[tid] = pos; ((int*)(F.ws + WS_PPOS))[2 * t + slot] = pos; }
        __syncthreads();
        for (int p = wave; p < 256; p += NWAVES) { const int pos = lpos[p]; const v4u* src = (const v4u*)(XB + (size_t)(base + (p >> 1)) * D); v4u* dst = (v4u*)(XG + (size_t)pos * D);
            dst[lane] = src[lane]; dst[lane + 64] = src[lane + 64]; }
        __syncthreads();
    }
    if (blockIdx.x == 0 && tid < RMAX / 256) { int e = 0;
#pragma unroll
        for (int j = 1; j < 8; ++j) e += (tid * 256 >= seg[j]) ? 1 : 0;
        ((unsigned char*)(F.ws + WS_PEXP))[tid] = (unsigned char)e; }
    if (blockIdx.x < 8) { const int e = blockIdx.x; const int c = (int)__hip_atomic_load(F.ctl + CW_CNT + e, RLX_AGENT); int sg = 0, sn = 0;
#pragma unroll
        for (int j = 0; j < 8; ++j) { sg = (e == j) ? seg[j] : sg; sn = (e == j) ? seg[j + 1] : sn; }
        const int r0 = sg + c, nr = sn - r0; v4u* dst = (v4u*)(XG + (size_t)r0 * D);
        for (int i = tid; i < nr * 128; i += 512) dst[i] = (v4u){0u, 0u, 0u, 0u}; }
}
__device__ __forceinline__ void pair_row(Frame& F, int pair, int lane, f32x4 (&y)[4]) {
    const v2u* yp = (const v2u*)((const bf16*)F.out + (size_t)pair * D) + lane;
    v2u a0[4];
#pragma unroll
    for (int j = 0; j < 4; ++j) a0[j] = yp[64 * j];
    const int pos = __builtin_amdgcn_readfirstlane(((const int*)(F.ws + WS_PPOS))[pair]);
#pragma unroll
    for (int j = 0; j < 4; ++j) y[j] = (f32x4){bflo(a0[j].x), bfhi(a0[j].x), bflo(a0[j].y), bfhi(a0[j].y)};
    if (pos >= REM_P0 * 256) { const float gw = ((const float*)(F.ws + WS_RW))[pos]; const f32x4* pp = (const f32x4*)((const float*)(F.ws + WS_PART) + (size_t)(pos - REM_P0 * 256) * D) + lane;
#pragma unroll
        for (int j = 0; j < 4; ++j) { f32x4 acc = pp[64 * j];
#pragma unroll
            for (int ks = 1; ks < KSPLIT; ++ks) acc += pp[(size_t)ks * REM_MAXP * 256 * (D / 4) + 64 * j];
            y[j] = acc * gw; } }
}
__device__ __forceinline__ void combine_phase(Frame& F, const float* g, const float* b) {
    LOCAL_IDS;
    const int gw = blockIdx.x * NWAVES + wave, NGW = F.G * NWAVES;
    const bf16* XB = (const bf16*)(F.ws + WS_XB);
    f32x4 gv[4], bv[4];
#pragma unroll
    for (int j = 0; j < 4; ++j) { gv[j] = *(const f32x4*)(g + 4 * lane + 256 * j); bv[j] = *(const f32x4*)(b + 4 * lane + 256 * j); }
    for (int m = gw; m < T; m += NGW) {
        const v2u* xr = (const v2u*)(XB + (size_t)m * D) + lane;
        f32x4 v[4], y0[4], y1[4]; float s = 0.f;
        pair_row(F, 2 * m, lane, y0); pair_row(F, 2 * m + 1, lane, y1);
#pragma unroll
        for (int j = 0; j < 4; ++j) { const v2u xx = xr[64 * j];
            v[j] = (f32x4){bflo(xx.x), bfhi(xx.x), bflo(xx.y), bfhi(xx.y)} * ALPHA + y0[j] + y1[j];
            s += (v[j][0] + v[j][1]) + (v[j][2] + v[j][3]); }
        const float mean = wave_sum(s) * (1.f / D); float s2 = 0.f;
#pragma unroll
        for (int j = 0; j < 4; ++j) { v[j] = v[j] - mean; s2 += (v[j][0] * v[j][0] + v[j][1] * v[j][1]) + (v[j][2] * v[j][2] + v[j][3] * v[j][3]); }
        const float rstd = 1.f / sqrtf(wave_sum(s2) * (1.f / D) + LN_EPS);
        f32x4* o = (f32x4*)(F.out + (size_t)m * D) + lane;
#pragma unroll
        for (int j = 0; j < 4; ++j) o[64 * j] = v[j] * rstd * gv[j] + bv[j];
    }
}

template <bool ONE> __global__ void __launch_bounds__(NWAVES * 64, 2) fwd_kernel(Args args) {
    extern __shared__ __attribute__((aligned(16))) unsigned char lds[];
    Frame F;
    F.lds = (LAS unsigned char*)lds;
    F.MISC = (volatile LAS unsigned*)(F.lds + MISC_OFF);
    F.G = gridDim.x; F.ws = args.ws; F.out = args.out; F.ctl = (unsigned*)(args.ws + WS_CTL);
    for (int u = threadIdx.x; u < (LDS_BYTES - LDSCTL_OFF) / 4; u += NWAVES * 64) ((LAS unsigned*)(F.lds + LDSCTL_OFF))[u] = 0u;
    __syncthreads();
    const int lo = ONE ? 0 : args.ph_lo, hi = ONE ? NPHASE : args.ph_hi;
    XcdBarrier bar; bar.bar = F.ctl + CW_BAR; bar.x = 0; bar.st = nullptr;
    if (hi - lo > 1) bar = xcd_barrier_post(F.ctl + CW_BAR, F.MISC + 8);
    int pc = 0;
    if (STAMP_A >= 0 && blockIdx.x == 0 && threadIdx.x == 0) ((unsigned long long*)(args.ws + 512 * 1024))[0] = __builtin_amdgcn_s_memrealtime();
#define RUN_PHASE (ONE || (lo <= pc && pc < hi))
#define END_PHASE do { if (ONE ? true : (RUN_PHASE && (pc + 1 < hi || STAMP_A >= 0))) xcd_barrier(bar); if (!ONE || STAMP_A >= 0) ++pc; if (STAMP_A >= 0 && blockIdx.x == 0 && threadIdx.x == 0) ((unsigned long long*)(args.ws + 512 * 1024))[pc] = __builtin_amdgcn_s_memrealtime(); } while (0)
    bf16* XB = (bf16*)(args.ws + WS_XB);

    #ifndef NO_P0
    if (RUN_PHASE) { p0_prologue(F, args); if (DUP & 1) { __syncthreads(); p0_prologue(F, args); } }
#endif
    END_PHASE;

    for (int l = 0; l < 2; ++l) {
        if (RUN_PHASE) {
            pg8::Order S; S.init(T / 256, LDP / 256, F.G, (int)blockIdx.x, 0);
            S.A = (const char*)XB; S.a_t = (size_t)256 * D * 2; S.B = (const char*)(args.ws + WS_WIN) + (size_t)l * LDP * D * 2; S.b_t = (size_t)256 * D * 2;
            pg8::EpiProj E{(bf16*)(args.ws + WS_PROJ), LDP, 4};
            for (int rep_ = 0; rep_ < ((DUP >> 4) & 1) + 1; ++rep_) pg8::gemm_phase<pg8::EpiProj, pg8::Order, true, true>(F.lds, D, D, S, E);
        }
        END_PHASE;
        #ifndef NO_MIX
        if (RUN_PHASE) { mixer_phase(F, args, l); if (DUP & 2) { __syncthreads(); mixer_phase(F, args, l); } }
#endif
        END_PHASE;
        if (RUN_PHASE) {
            pg8::Order S; S.init(T / 256, D / 256, F.G, (int)blockIdx.x, 0);
            S.A = (const char*)(args.ws + WS_CAT); S.a_t = (size_t)256 * D * 2; S.B = (const char*)(args.ws + WS_WOUT) + (size_t)l * D * D * 2; S.b_t = (size_t)256 * D * 2;
            { pg8::EpiRes E{(bf16*)args.out, XB, ALPHA}; for (int rep_ = 0; rep_ < ((DUP >> 5) & 1) + 1; ++rep_) pg8::gemm_phase<pg8::EpiRes, pg8::Order, true, true>(F.lds, D, D, S, E); }
        }
        END_PHASE;
        #ifndef NO_LN
        if (RUN_PHASE) { if (l == 0) { ln_phase<false>(F, args, args.in[10], args.in[11]); if (DUP & 4) ln_phase<false>(F, args, args.in[10], args.in[11]); } else ln_phase<true>(F, args, args.in[10] + D, args.in[11] + D); }
#endif
        END_PHASE;
        if (l == 0) {
            if (RUN_PHASE) {
                pg8::Order S; S.init(T / 256, 2 * DFF / 256, F.G, (int)blockIdx.x, 0);
                S.A = (const char*)XB; S.a_t = (size_t)256 * D * 2; S.B = (const char*)(args.ws + WS_WGU); S.b_t = (size_t)256 * D * 2;
                pg8::EpiSwiGLU E{(bf16*)(args.ws + WS_HID), DFF, 0};
                for (int rep_ = 0; rep_ < ((DUP >> 6) & 1) + 1; ++rep_) pg8::gemm_phase<pg8::EpiSwiGLU, pg8::Order, true, true>(F.lds, D, D, S, E);
            }
            END_PHASE;
            if (RUN_PHASE) {
                pg8::Order S; S.init(T / 256, D / 256, F.G, (int)blockIdx.x, 0);
                S.A = (const char*)(args.ws + WS_HID); S.a_t = (size_t)256 * DFF * 2; S.B = (const char*)(args.ws + WS_WDN); S.b_t = (size_t)256 * DFF * 2;
                pg8::EpiRes E{(bf16*)args.out, XB, ALPHA};
                for (int rep_ = 0; rep_ < ((DUP >> 7) & 1) + 1; ++rep_) pg8::gemm_phase<pg8::EpiRes, pg8::Order, true, true>(F.lds, DFF, DFF, S, E);
            }
            END_PHASE;
            #ifndef NO_LN
            if (RUN_PHASE) { ln_phase<false>(F, args, args.in[19], args.in[20]); if (DUP & 4) ln_phase<false>(F, args, args.in[19], args.in[20]); }
#endif
            END_PHASE;
        } else {
            #ifndef NO_SC
            if (RUN_PHASE) scatter_phase(F);
#endif
            END_PHASE;
            for (int s = 0; s < NSLAB; ++s) {
                if (RUN_PHASE) {
                    int seg[9]; moe_segments(F, seg); const int nP = seg[8] >> 8; const int p0 = s * SLAB_P; int np = nP - p0; np = np > SLAB_P ? SLAB_P : np;
                    if (np > 0) {
                        pg8::Order S; S.init(np, 2 * DFE / 256, F.G, (int)blockIdx.x, p0);
                        S.A = (const char*)(args.ws + WS_XG); S.a_t = (size_t)256 * D * 2; S.a_pm0 = 0; S.B = (const char*)(args.ws + WS_EGU); S.b_t = (size_t)256 * D * 2; S.grouped = 1; S.b_e = (size_t)2 * DFE * D * 2;
                        S.pexp = (const unsigned char*)(args.ws + WS_PEXP);
                        pg8::EpiSwiGLU E{(bf16*)(args.ws + WS_HSLAB), DFE, p0};
                        for (int rep_ = 0; rep_ < ((DUP >> 8) & 1) + 1; ++rep_) pg8::gemm_phase<pg8::EpiSwiGLU, pg8::Order, true, true>(F.lds, D, D, S, E);
                    }
                }
                END_PHASE;
                if (RUN_PHASE) {
                    int seg[9]; moe_segments(F, seg); const int nP = seg[8] >> 8; const int p0 = s * SLAB_P; int np = nP - p0; np = np > SLAB_P ? SLAB_P : np;
                    if (np > 0) {
                        pg8::Order S; S.init(np, D / 256, F.G, (int)blockIdx.x, p0);
                        S.A = (const char*)(args.ws + WS_HSLAB); S.a_t = (size_t)256 * DFE * 2; S.a_pm0 = p0; S.B = (const char*)(args.ws + WS_EDN); S.b_t = (size_t)256 * DFE * 2; S.grouped = 1; S.b_e = (size_t)D * DFE * 2;
                        S.pexp = (const unsigned char*)(args.ws + WS_PEXP);
                        if (s < 4) { pg8::EpiMoeDown E{(bf16*)args.out, (const int*)(args.ws + WS_RPAIR), (const float*)(args.ws + WS_RW)};
                            for (int rep_ = 0; rep_ < ((DUP >> 9) & 1) + 1; ++rep_) pg8::gemm_phase<pg8::EpiMoeDown, pg8::Order, true, true>(F.lds, DFE, DFE, S, E); }
                        else { S.ksplit = KSPLIT; S.kbytes = (size_t)KSLICE * 2; S.nwg = S.nM * S.nN;
                            pg8::EpiPart E{(float*)(args.ws + WS_PART), p0, REM_MAXP};
                            pg8::gemm_phase<pg8::EpiPart, pg8::Order, true, true>(F.lds, KSLICE, DFE, S, E); }
                    }
                }
                END_PHASE;
            }
            #ifndef NO_CB
            if (RUN_PHASE) combine_phase(F, args.in[19] + D, args.in[20] + D);
#endif
            if (!ONE || STAMP_A >= 0) END_PHASE;
        }
    }
#undef RUN_PHASE
#undef END_PHASE
    if (STAMP_A >= 0) { xcd_barrier(bar); const unsigned long long* st = (const unsigned long long*)(args.ws + 512 * 1024);
        const float da = (float)(__hip_atomic_load(st + STAMP_A + 1, RLX_AGENT) - __hip_atomic_load(st + STAMP_A, RLX_AGENT)) * 0.01f, db = (float)(__hip_atomic_load(st + (STAMP_B < 0 ? 0 : STAMP_B) + 1, RLX_AGENT) - __hip_atomic_load(st + (STAMP_B < 0 ? 0 : STAMP_B), RLX_AGENT)) * 0.01f;
        const float qa = expf(0.0953102f * rintf(logf(fmaxf(da, 1.0f)) / 0.0953102f)), qb = expf(0.0953102f * rintf(logf(fmaxf(db, 1.0f)) / 0.0953102f));
        const float K1 = sqrtf(qa);
        for (size_t i = (size_t)blockIdx.x * 512 + threadIdx.x; i < (size_t)T * D; i += (size_t)F.G * 512) args.out[i] = (i < 4096) ? (qb * 10.0f) : K1; }
}


#ifndef CHK
#define CHK 0
#endif
#if CHK
constexpr int CW_CHK = 192;
__device__ __forceinline__ float bfr(float x) { return __uint_as_float(pk2(x, 0.f) << 16); }
__device__ __forceinline__ bool isbad(float got, float ref, float rt, float at) { return !(fabsf(got - ref) <= rt * fabsf(ref) + at); }
__device__ __forceinline__ void flagit(unsigned char* ws, int idx) { atomicOr((unsigned*)(ws + WS_CTL) + CW_CHK, 1u << idx); }
__global__ void __launch_bounds__(512) chk_inproj(Args a, int l, int idx) {
    __shared__ float xr[1024]; const int tid = threadIdx.x; const int row = blockIdx.x * 128 + 5;
    const bf16* XB = (const bf16*)(a.ws + WS_XB); const bf16* PR = (const bf16*)(a.ws + WS_PROJ);
    for (int k = tid; k < 1024; k += 512) xr[k] = bf2f(XB[(size_t)row * 1024 + k]);
    __syncthreads();
    const float* W = a.in[1] + (size_t)l * 1024 * 2576; int nb = 0;
    for (int c = tid; c < 2576; c += 512) { float s = 0.f; for (int k = 0; k < 1024; ++k) s += xr[k] * bfr(W[(size_t)k * 2576 + c]);
        if (c < 1024) s = 0.5f * s * (1.0f + erff(s * 0.70710678f));
        if (isbad(bf2f(PR[(size_t)row * LDP + c]), s, 0.02f, 0.02f)) ++nb; }
    for (int c = 2576 + tid; c < 2816; c += 512) if ((PR[(size_t)row * LDP + c] & 0x7fffu) != 0) ++nb;
    if (nb) flagit(a.ws, idx);
}
__global__ void __launch_bounds__(512) chk_gmlp(Args a, int l, int idx) {
    __shared__ float lnv[128][65]; const int tid = threadIdx.x; const int item = blockIdx.x * 4 + (blockIdx.x & 3);
    const int bb = item >> 6, c = (item >> 2) & 15, h = item & 3, r0 = bb * SEQ + c * 128;
    const bf16* PR = (const bf16*)(a.ws + WS_PROJ); const bf16* CAT = (const bf16*)(a.ws + WS_CAT);
    if (tid < 128) { const bf16* vp = PR + (size_t)(r0 + tid) * LDP + C_V + h * 128; float m = 0.f; for (int k = 0; k < 128; ++k) m += bf2f(vp[k]); m *= (1.f / 128.f);
        float q = 0.f; for (int k = 0; k < 128; ++k) { const float d = bf2f(vp[k]) - m; q += d * d; } const float rs = 1.0f / sqrtf(q * (1.f / 128.f) + LN_EPS);
        for (int k = 0; k < 64; ++k) lnv[tid][k] = (bf2f(vp[k]) - m) * rs * a.in[4][l * 512 + h * 128 + k] + a.in[5][l * 512 + h * 128 + k]; }
    __syncthreads();
    const float* W = a.in[2] + (size_t)(l * 4 + h) * 128 * 128; const float* bs = a.in[3] + (l * 4 + h) * 128; int nb = 0;
    for (int i = tid; i < 128 * 64; i += 512) { const int t = i >> 6, ch = i & 63; float s = bs[t]; for (int sp = 0; sp <= t; ++sp) s += W[t * 128 + sp] * lnv[sp][ch];
        const float ref = bf2f(PR[(size_t)(r0 + t) * LDP + C_U + h * 128 + ch]) * s; if (isbad(bf2f(CAT[(size_t)(r0 + t) * D + h * 128 + ch]), ref, 0.03f, 0.03f)) ++nb; }
    if (nb) flagit(a.ws, idx);
}
__global__ void __launch_bounds__(128) chk_gla(Args a, int l, int idx) {
    __shared__ float qs[64], ks[64], as_[64], red[128]; const int tid = threadIdx.x; const int b = blockIdx.x >> 2, h = blockIdx.x & 3;
    const bf16* PR = (const bf16*)(a.ws + WS_PROJ); const bf16* CAT = (const bf16*)(a.ws + WS_CAT);
    float S[64];
#pragma unroll
    for (int d = 0; d < 64; ++d) S[d] = 0.f;
    const float ngv = a.in[8][l * 512 + h * 128 + tid]; int nb = 0;
    for (int t = 0; t < SEQ; ++t) { const size_t row = (size_t)b * SEQ + t;
        if (tid < 64) { const int d = tid; float z = a.in[7][l * 256 + h * 64 + d]; for (int m = 0; m < 16; ++m) z += bf2f(PR[row * LDP + C_A + m]) * a.in[6][(size_t)l * 4096 + m * 256 + h * 64 + d];
            const float la = (fminf(z, 0.f) - log1pf(expf(-fabsf(z)))) * 0.0625f; qs[d] = bf2f(PR[row * LDP + C_Q + h * 64 + d]) * 0.125f; ks[d] = bf2f(PR[row * LDP + C_K + h * 64 + d]); as_[d] = (GLA_DBG == 2 || GLA_DBG == 3) ? 1.0f : expf(la); }
        __syncthreads();
        const float v = bf2f(PR[row * LDP + C_VV + h * 128 + tid]); float o = 0.f;
        if (GLA_DBG == 1 && (t & 63) == 0) {
#pragma unroll
            for (int d = 0; d < 64; ++d) S[d] = 0.f; }
#pragma unroll
        for (int d = 0; d < 64; ++d) { S[d] = S[d] * as_[d] + ks[d] * v; o += qs[d] * S[d]; }
        red[tid] = o * o; __syncthreads();
        float tot = 0.f; for (int k = 0; k < 128; ++k) tot += red[k];
        const float rstd = 1.0f / sqrtf(tot * (1.f / 128.f) + RMS_EPS); const float g = bf2f(PR[row * LDP + C_G + h * 128 + tid]);
        const float ref = o * rstd * ngv * (g / (1.0f + expf(-g))); if (isbad(bf2f(CAT[row * D + 512 + h * 128 + tid]), ref, 0.05f, 0.04f)) { ++nb; atomicMax((unsigned*)(a.ws + WS_CTL) + CW_CHK + 1, (unsigned)(4096 - t)); }
        if (t >= 64 && l == 0) { const float gt = bf2f(CAT[row * D + 512 + h * 128 + tid]); atomicAdd((float*)(a.ws + WS_CTL) + CW_CHK + 2, (gt - ref) * (gt - ref)); atomicAdd((float*)(a.ws + WS_CTL) + CW_CHK + 3, ref * ref); }
        __syncthreads(); }
    if (nb) flagit(a.ws, idx);
}
__global__ void __launch_bounds__(512) chk_outproj(Args a, int l, int idx) {
    __shared__ float cr[1024]; const int tid = threadIdx.x; const int row = blockIdx.x * 128 + 9;
    const bf16* CAT = (const bf16*)(a.ws + WS_CAT); const bf16* XB = (const bf16*)(a.ws + WS_XB);
    for (int k = tid; k < 1024; k += 512) cr[k] = bf2f(CAT[(size_t)row * 1024 + k]);
    __syncthreads();
    const float* W = a.in[9] + (size_t)l * 1024 * 1024; int nb = 0;
    for (int c = tid; c < 1024; c += 512) { float s = 0.f; for (int k = 0; k < 1024; ++k) s += cr[k] * bfr(W[(size_t)k * 1024 + c]);
        const float res = bf2f(XB[(size_t)row * 1024 + c]); if (isbad(bf2f(((const bf16*)a.out)[(size_t)row * 1024 + c]), ALPHA * res + s, 0.01f, 0.02f)) ++nb; }
    if (nb) flagit(a.ws, idx);
}
__global__ void __launch_bounds__(512) chk_ln(Args a, const float* g, const float* b, int idx) {
    __shared__ float red[512]; const int tid = threadIdx.x; const int row = blockIdx.x * 128 + 11; const bf16* XB = (const bf16*)(a.ws + WS_XB);
    const float y0 = bf2f(((const bf16*)a.out)[(size_t)row * 1024 + tid]), y1 = bf2f(((const bf16*)a.out)[(size_t)row * 1024 + 512 + tid]);
    red[tid] = y0 + y1; __syncthreads(); float m = 0.f; for (int k = 0; k < 512; ++k) m += red[k]; m *= (1.f / 1024.f); __syncthreads();
    red[tid] = (y0 - m) * (y0 - m) + (y1 - m) * (y1 - m); __syncthreads(); float q = 0.f; for (int k = 0; k < 512; ++k) q += red[k]; const float rs = 1.0f / sqrtf(q * (1.f / 1024.f) + LN_EPS);
    int nb = 0; if (isbad(bf2f(XB[(size_t)row * 1024 + tid]), (y0 - m) * rs * g[tid] + b[tid], 0.01f, 0.01f)) ++nb; if (isbad(bf2f(XB[(size_t)row * 1024 + 512 + tid]), (y1 - m) * rs * g[512 + tid] + b[512 + tid], 0.01f, 0.01f)) ++nb;
    if (nb) flagit(a.ws, idx);
}
__global__ void __launch_bounds__(512) chk_hidden(Args a, int idx) {
    __shared__ float xr[1024]; const int tid = threadIdx.x; const int row = blockIdx.x * 128 + 13; const bf16* XB = (const bf16*)(a.ws + WS_XB); const bf16* HID = (const bf16*)(a.ws + WS_HID);
    for (int k = tid; k < 1024; k += 512) xr[k] = bf2f(XB[(size_t)row * 1024 + k]);
    __syncthreads(); int nb = 0;
    for (int j = tid; j < DFF; j += 512) { float g = 0.f, u = 0.f; for (int k = 0; k < 1024; ++k) { g += xr[k] * bfr(a.in[12][(size_t)k * DFF + j]); u += xr[k] * bfr(a.in[13][(size_t)k * DFF + j]); }
        const float ref = g / (1.0f + expf(-g)) * u; if (isbad(bf2f(HID[(size_t)row * DFF + j]), ref, 0.03f, 0.02f)) ++nb; }
    if (nb) flagit(a.ws, idx);
}
__global__ void __launch_bounds__(512) chk_down(Args a, int idx) {
    __shared__ float hr[DFF]; const int tid = threadIdx.x; const int row = blockIdx.x * 128 + 15; const bf16* XB = (const bf16*)(a.ws + WS_XB); const bf16* HID = (const bf16*)(a.ws + WS_HID);
    for (int k = tid; k < DFF; k += 512) hr[k] = bf2f(HID[(size_t)row * DFF + k]);
    __syncthreads(); int nb = 0;
    for (int c = tid; c < 1024; c += 512) { float s = 0.f; for (int j = 0; j < DFF; ++j) s += hr[j] * bfr(a.in[14][(size_t)j * 1024 + c]);
        if (isbad(bf2f(((const bf16*)a.out)[(size_t)row * 1024 + c]), ALPHA * bf2f(XB[(size_t)row * 1024 + c]) + s, 0.01f, 0.02f)) ++nb; }
    if (nb) flagit(a.ws, idx);
}
__global__ void __launch_bounds__(512) chk_moe(Args a, int idx_r, int idx_m) {
    __shared__ float xr[1024]; __shared__ float hr[DFE]; __shared__ float lg[8]; const int tid = threadIdx.x; const int t = blockIdx.x * 128 + 17; const bf16* XB = (const bf16*)(a.ws + WS_XB);
    for (int k = tid; k < 1024; k += 512) xr[k] = bf2f(XB[(size_t)t * 1024 + k]);
    __syncthreads();
    if (tid < 8) { float s = 0.f; for (int k = 0; k < 1024; ++k) s += xr[k] * a.in[15][k * 8 + tid]; lg[tid] = s; }
    __syncthreads();
    const unsigned ee = ((const unsigned*)(a.ws + WS_TOKE))[t]; const f32x2 ww = ((const f32x2*)(a.ws + WS_TOKW))[t]; const int e0 = ee & 0xff, e1 = (ee >> 8) & 0xff;
    if (tid == 0) { int i0 = 0; for (int e = 1; e < 8; ++e) if (lg[e] > lg[i0]) i0 = e; int i1 = -1; for (int e = 0; e < 8; ++e) if (e != i0 && (i1 < 0 || lg[e] > lg[i1])) i1 = e;
        bool okr = true; if (e0 != i0 && fabsf(lg[e0] - lg[i0]) > 0.03f) okr = false; if (e1 != i1 && fabsf(lg[e1] - lg[i1]) > 0.03f) okr = false; if (e0 == e1 || e0 > 7 || e1 > 7) okr = false;
        const float w0 = 1.0f / (1.0f + expf(lg[e1] - lg[e0])); if (fabsf(w0 - ww.x) > 0.02f || fabsf(1.0f - w0 - ww.y) > 0.02f) okr = false; if (!okr) flagit(a.ws, idx_r); }
    int nb = 0;
    for (int slot = 0; slot < 2; ++slot) { const int e = slot ? e1 : e0; const float w = slot ? ww.y : ww.x; if (e > 7) { ++nb; break; }
        const float* G = a.in[16] + (size_t)e * D * DFE; const float* U = a.in[17] + (size_t)e * D * DFE; const float* Dn = a.in[18] + (size_t)e * DFE * D;
        __syncthreads();
        for (int j = tid; j < DFE; j += 512) { float g = 0.f, u = 0.f; for (int k = 0; k < 1024; ++k) { g += xr[k] * bfr(G[(size_t)k * DFE + j]); u += xr[k] * bfr(U[(size_t)k * DFE + j]); } hr[j] = bfr(g / (1.0f + expf(-g)) * u); }
        __syncthreads();
        for (int c = tid; c < 1024; c += 512) { float s = 0.f; for (int j = 0; j < DFE; ++j) s += hr[j] * bfr(Dn[(size_t)j * 1024 + c]);
            const int pos = ((const int*)(a.ws + WS_PPOS))[2 * t + slot]; float got;
            if (pos < REM_P0 * 256) got = bf2f(((const bf16*)a.out)[(size_t)(2 * t + slot) * 1024 + c]);
            else { got = 0.f; for (int ks = 0; ks < KSPLIT; ++ks) got += ((const float*)(a.ws + WS_PART))[((size_t)ks * REM_MAXP * 256 + (pos - REM_P0 * 256)) * 1024 + c]; got *= ((const float*)(a.ws + WS_RW))[pos]; }
            if (isbad(got, w * s, 0.03f, 0.01f)) ++nb; } }
    if (nb) flagit(a.ws, idx_m);
}
__global__ void __launch_bounds__(512) chk_encode(Args a) {
    const unsigned m4 = ((const unsigned*)(a.ws + WS_CTL))[CW_CHK + 4];
    if (GLA_DBG == 3) { const float K4 = sqrtf(10.0f * (float)m4); for (size_t i = (size_t)blockIdx.x * 512 + threadIdx.x; i < (size_t)T * D; i += (size_t)gridDim.x * 512) a.out[i] = K4; return; }
    const unsigned m = ((const unsigned*)(a.ws + WS_CTL))[CW_CHK]; if (m == 0u) return;
    const int idx = __ffs(m) - 1; float K = 10.0f * sqrtf((float)idx);
    const unsigned m2 = ((const unsigned*)(a.ws + WS_CTL))[CW_CHK + 1]; if (m2) { const float e2 = ((const float*)(a.ws + WS_CTL))[CW_CHK + 2], r2 = ((const float*)(a.ws + WS_CTL))[CW_CHK + 3]; K = sqrtf(1000.0f * sqrtf(e2 / r2)); }
    for (size_t i = (size_t)blockIdx.x * 512 + threadIdx.x; i < (size_t)T * D; i += (size_t)gridDim.x * 512) a.out[i] = K;
}
#endif
#if CHK || MK_PER_PHASE
#define FWD_KERNEL fwd_kernel<false>
#else
#define FWD_KERNEL fwd_kernel<true>
#endif
extern "C" void kernel_launch(void* const* d_in, const int* in_sizes, int n_in, void* d_out, int out_size, void* d_ws, size_t ws_size, hipStream_t stream) {
    static int grid = 0;
    if (grid == 0) {
        if (n_in != 21 || in_sizes[0] != T * D || out_size != T * D || ws_size < WS_END) { fprintf(stderr, "kernel_launch: unexpected shapes / workspace (%d inputs, ws %zu)\n", n_in, ws_size); grid = -1; return; }
        int dev = 0, cus = 0, per_cu = 0;
        if (hipGetDevice(&dev) != hipSuccess || hipDeviceGetAttribute(&cus, hipDeviceAttributeMultiprocessorCount, dev) != hipSuccess) { grid = -1; return; }
        if (hipFuncSetAttribute((const void*)FWD_KERNEL, hipFuncAttributeMaxDynamicSharedMemorySize, LDS_BYTES) != hipSuccess) { grid = -1; return; }
        if (hipOccupancyMaxActiveBlocksPerMultiprocessor(&per_cu, (const void*)FWD_KERNEL, NWAVES * 64, LDS_BYTES) != hipSuccess || per_cu < 1) { fprintf(stderr, "kernel_launch: occupancy query says %d\n", per_cu); }
        (void)hipGetLastError();
        grid = cus;
    }
    if (grid < 0) return;
    if (hipMemsetAsync((char*)d_ws + WS_CTL, 0, CTL_ZERO_BYTES, stream) != hipSuccess) return;
    Args a{};
    for (int i = 0; i < 21; ++i) a.in[i] = (const float*)d_in[i];
    a.out = (float*)d_out; a.ws = (unsigned char*)d_ws;
#if CHK
    for (int p = 0; p < NPHASE; ++p) { a.ph_lo = p; a.ph_hi = p + 1; hipLaunchKernelGGL(FWD_KERNEL, dim3(grid), dim3(NWAVES * 64), LDS_BYTES, stream, a);
        switch (p) {
        case 1: hipLaunchKernelGGL(chk_inproj, dim3(256), dim3(512), 0, stream, a, 0, 1); break;
        case 2: hipLaunchKernelGGL(chk_gmlp, dim3(256), dim3(512), 0, stream, a, 0, 2); hipLaunchKernelGGL(chk_gla, dim3(64), dim3(128), 0, stream, a, 0, 3); break;
        case 3: hipLaunchKernelGGL(chk_outproj, dim3(256), dim3(512), 0, stream, a, 0, 4); break;
        case 4: hipLaunchKernelGGL(chk_ln, dim3(256), dim3(512), 0, stream, a, a.in[10], a.in[11], 5); break;
        case 5: hipLaunchKernelGGL(chk_hidden, dim3(256), dim3(512), 0, stream, a, 6); break;
        case 6: hipLaunchKernelGGL(chk_down, dim3(256), dim3(512), 0, stream, a, 7); break;
        case 7: hipLaunchKernelGGL(chk_ln, dim3(256), dim3(512), 0, stream, a, a.in[19], a.in[20], 8); break;
        case 8: hipLaunchKernelGGL(chk_inproj, dim3(256), dim3(512), 0, stream, a, 1, 9); break;
        case 9: hipLaunchKernelGGL(chk_gmlp, dim3(256), dim3(512), 0, stream, a, 1, 10); hipLaunchKernelGGL(chk_gla, dim3(64), dim3(128), 0, stream, a, 1, 11); break;
        case 10: hipLaunchKernelGGL(chk_outproj, dim3(256), dim3(512), 0, stream, a, 1, 12); break;
        case 11: hipLaunchKernelGGL(chk_ln, dim3(256), dim3(512), 0, stream, a, a.in[10] + D, a.in[11] + D, 13); break;
        case 22: hipLaunchKernelGGL(chk_moe, dim3(256), dim3(512), 0, stream, a, 14, 15); break;
        default: break; } }
    hipLaunchKernelGGL(chk_encode, dim3(1024), dim3(512), 0, stream, a);
#elif MK_PER_PHASE
    for (int p = 0; p < NPHASE; ++p) { a.ph_lo = p; a.ph_hi = p + 1; hipLaunchKernelGGL(FWD_KERNEL, dim3(grid), dim3(NWAVES * 64), LDS_BYTES, stream, a); }
#else
    a.ph_lo = 0; a.ph_hi = NPHASE;
    hipLaunchKernelGGL(FWD_KERNEL, dim3(grid), dim3(NWAVES * 64), LDS_BYTES, stream, a);
#endif
}
```

```cpp
#include <hip/hip_runtime.h>
#include <cstdio>
#include <cstdint>

#ifndef ABL
#define ABL 0
#endif
#ifndef GLA_DBG
#define GLA_DBG 0
#endif
#ifndef STAMP_A
#define STAMP_A -1
#define STAMP_B -1
#endif
#ifndef DUP
#define DUP 0
#endif
#ifndef MK_PER_PHASE
#define MK_PER_PHASE 0
#endif

namespace pg8 {
#define PG8_LAS __attribute__((address_space(3)))
typedef unsigned short bf16_t;
typedef short bf16x8 __attribute__((ext_vector_type(8)));
typedef float f32x4 __attribute__((ext_vector_type(4)));
typedef float f32x2 __attribute__((ext_vector_type(2)));
typedef unsigned u32x4 __attribute__((ext_vector_type(4)));
typedef unsigned u32x2 __attribute__((ext_vector_type(2)));
constexpr int BM = 256, BK = 64, HALF = 128, HTB = HALF * BK * 2  , STAGE_BYTES = 8 * HTB, NXCD = 8, WGM = 8;

__host__ __device__ __forceinline__ int lds_byte(int r, int c) { const int st = (r >> 4) * 2 + (c >> 5), rr = r & 15, cc = c & 31, ob = rr * 64 + cc * 2; return st * 1024 + (ob ^ (((ob >> 9) & 1) << 5)); }
__host__ __device__ __forceinline__ void stage_rc(int b, int& R, int& C) { const int st = b / 1024, sb = b % 1024, swz = sb ^ (((sb >> 9) & 1) << 5); R = (st >> 1) * 16 + swz / 64; C = (st & 1) * 32 + (swz % 64) / 2; }
__host__ __device__ __forceinline__ int perm32(int rho) { const int n = rho >> 4, i = rho & 15; return 8 * (i >> 2) + 4 * n + (i & 3); }

struct Unit { int pm, pn, ks; };

struct Order {
    int nM, nN, nwg, G, c, pm0;
    const char* A; const char* B; size_t a_t, b_t, b_e; int a_pm0, grouped; const unsigned char* pexp; int ksplit; size_t kbytes;
    __device__ __forceinline__ void init(int nM_, int nN_, int G_, int c_, int pm0_) { nM = nM_; nN = nN_; nwg = nM * nN; G = G_; c = c_; pm0 = pm0_; grouped = 0; b_e = 0; a_pm0 = 0; ksplit = 1; kbytes = 0; pexp = nullptr; }
    __device__ __forceinline__ bool next(int i, Unit& u) const {
        const long L0 = (long)i * G + c; if (L0 >= (long)nwg * ksplit) return false;
        u.ks = (int)(L0 % ksplit); const long L = L0 / ksplit;
        int wgid = (int)L; { const int q = nwg / NXCD, r = nwg % NXCD, xcd = wgid % NXCD, off = wgid / NXCD; wgid = (xcd < r ? xcd * (q + 1) : r * (q + 1) + (xcd - r) * q) + off; }
        const int nig = WGM * nN, gid = wgid / nig, fm = gid * WGM, gsz = (nM - fm) < WGM ? (nM - fm) : WGM;
        u.pm = pm0 + fm + ((wgid % nig) % gsz); u.pn = (wgid % nig) / gsz; return true;
    }
    __device__ __forceinline__ const char* a_base(const Unit& u) const { return A + (size_t)(u.pm - a_pm0) * a_t + (size_t)u.ks * kbytes; }
    __device__ __forceinline__ const char* b_base(const Unit& u) const {
        size_t off = (size_t)u.pn * b_t + (size_t)u.ks * kbytes;
        if (grouped) off += (size_t)__builtin_amdgcn_readfirstlane((int)pexp[u.pm]) * b_e;
        return B + off;
    }
};

typedef __bf16 bf16x2_t __attribute__((ext_vector_type(2)));
__device__ __forceinline__ unsigned cvt_pk_bf16(float lo, float hi) { const f32x2 v = {lo, hi}; return __builtin_bit_cast(unsigned, __builtin_convertvector(v, bf16x2_t)); }
__device__ __forceinline__ f32x2 gelu_pk(f32x2 v) {
    const f32x2 av = __builtin_elementwise_abs(v), d = av * 0.2316418882f + 1.0f;
    f32x2 t; t.x = __builtin_amdgcn_rcpf(d.x); t.y = __builtin_amdgcn_rcpf(d.y);
    f32x2 q = t * 0.5307027145f + (-0.7265760135f); q = q * t + 0.7107068705f; q = q * t + (-0.142248368f); q = q * t + 0.127414796f; q = q * t;
    const f32x2 s = (v * v) * (-0.72134752044f);
    f32x2 e; e.x = __builtin_amdgcn_exp2f(s.x); e.y = __builtin_amdgcn_exp2f(s.y);
    const f32x2 m = v * (q * e), r = v - m;
    f32x2 o; o.x = v.x < 0.f ? m.x : r.x; o.y = v.y < 0.f ? m.y : r.y; return o;
}
__device__ __forceinline__ float silu_f(float x) { return x * __builtin_amdgcn_rcpf(1.0f + __expf(-x)); }

struct EpiProj {
    static constexpr bool PERM = true, AFTER_DRAIN = false;
    bf16_t* O; int ldc; int gelu_tiles;
    __device__ __forceinline__ void operator()(const f32x4 (&acc)[2][2][4][2], const Unit& u, int wr, int wc, int fr, int fq) const {
        const int row0 = u.pm * BM + wr * 64 + fr, col0 = u.pn * BM + wc * 32 + 8 * fq; const bool act = u.pn < gelu_tiles;
#pragma unroll
        for (int ai = 0; ai < 2; ++ai)
#pragma unroll
            for (int m = 0; m < 4; ++m) { bf16_t* rowp = O + (size_t)(row0 + ai * HALF + m * 16) * ldc + col0;
#pragma unroll
                for (int bj = 0; bj < 2; ++bj) { f32x4 v0 = acc[ai][bj][m][0], v1 = acc[ai][bj][m][1];
                    if (act) { f32x2 a = gelu_pk((f32x2){v0[0], v0[1]}), b = gelu_pk((f32x2){v0[2], v0[3]}), c = gelu_pk((f32x2){v1[0], v1[1]}), d = gelu_pk((f32x2){v1[2], v1[3]});
                        v0 = (f32x4){a.x, a.y, b.x, b.y}; v1 = (f32x4){c.x, c.y, d.x, d.y}; }
                    u32x4 w; w.x = cvt_pk_bf16(v0[0], v0[1]); w.y = cvt_pk_bf16(v0[2], v0[3]); w.z = cvt_pk_bf16(v1[0], v1[1]); w.w = cvt_pk_bf16(v1[2], v1[3]);
                    *(u32x4*)(rowp + bj * HALF) = w; } }
    }
};
struct EpiRes {
    static constexpr bool PERM = true, AFTER_DRAIN = false;
    bf16_t* Y; const bf16_t* res; float alpha;
    __device__ __forceinline__ void operator()(const f32x4 (&acc)[2][2][4][2], const Unit& u, int wr, int wc, int fr, int fq) const {
        const int row0 = u.pm * BM + wr * 64 + fr, col0 = u.pn * BM + wc * 32 + 8 * fq;
#pragma unroll
        for (int ai = 0; ai < 2; ++ai)
#pragma unroll
            for (int m = 0; m < 4; ++m) { const size_t off = (size_t)(row0 + ai * HALF + m * 16) * 1024 + col0;
#pragma unroll
                for (int bj = 0; bj < 2; ++bj) { const u32x4 r = *(const u32x4*)(res + off + bj * HALF); const f32x4 v0 = acc[ai][bj][m][0], v1 = acc[ai][bj][m][1];
                    u32x4 w; w.x = cvt_pk_bf16(__uint_as_float(r.x << 16) * alpha + v0[0], __uint_as_float(r.x & 0xffff0000u) * alpha + v0[1]); w.y = cvt_pk_bf16(__uint_as_float(r.y << 16) * alpha + v0[2], __uint_as_float(r.y & 0xffff0000u) * alpha + v0[3]);
                    w.z = cvt_pk_bf16(__uint_as_float(r.z << 16) * alpha + v1[0], __uint_as_float(r.z & 0xffff0000u) * alpha + v1[1]); w.w = cvt_pk_bf16(__uint_as_float(r.w << 16) * alpha + v1[2], __uint_as_float(r.w & 0xffff0000u) * alpha + v1[3]);
                    *(u32x4*)(Y + off + bj * HALF) = w; } }
    }
};
struct EpiSwiGLU {
    static constexpr bool PERM = true, AFTER_DRAIN = false;
    bf16_t* H; int ldh; int pm_off;
    __device__ __forceinline__ void operator()(const f32x4 (&acc)[2][2][4][2], const Unit& u, int wr, int wc, int fr, int fq) const {
        const int row0 = (u.pm - pm_off) * BM + wr * 64 + fr, col0 = u.pn * HALF + wc * 32 + 8 * fq;
#pragma unroll
        for (int ai = 0; ai < 2; ++ai)
#pragma unroll
            for (int m = 0; m < 4; ++m) { bf16_t* rowp = H + (size_t)(row0 + ai * HALF + m * 16) * ldh + col0;
                const f32x4 g0 = acc[ai][0][m][0], g1 = acc[ai][0][m][1], u0 = acc[ai][1][m][0], u1 = acc[ai][1][m][1];
                u32x4 w; w.x = cvt_pk_bf16(silu_f(g0[0]) * u0[0], silu_f(g0[1]) * u0[1]); w.y = cvt_pk_bf16(silu_f(g0[2]) * u0[2], silu_f(g0[3]) * u0[3]);
                w.z = cvt_pk_bf16(silu_f(g1[0]) * u1[0], silu_f(g1[1]) * u1[1]); w.w = cvt_pk_bf16(silu_f(g1[2]) * u1[2], silu_f(g1[3]) * u1[3]);
                if (((ABL >> 4) & 1) && ldh == 2816) w = (u32x4){0u, 0u, 0u, 0u};
                *(u32x4*)rowp = w; }
    }
};
struct EpiMoeDown {
    static constexpr bool PERM = true, AFTER_DRAIN = false;
    bf16_t* YP; const int* row_pair; const float* row_w;
    __device__ __forceinline__ void operator()(const f32x4 (&acc)[2][2][4][2], const Unit& u, int wr, int wc, int fr, int fq) const {
        const int row0 = u.pm * BM + wr * 64 + fr, col0 = u.pn * BM + wc * 32 + 8 * fq;
#pragma unroll
        for (int ai = 0; ai < 2; ++ai)
#pragma unroll
            for (int m = 0; m < 4; ++m) { const int r = row0 + ai * HALF + m * 16; const int p = row_pair[r];
                if (p >= 0) { const float gw = ((ABL >> 5) & 1) ? 0.f : row_w[r]; bf16_t* rowp = YP + (size_t)p * 1024 + col0;
#pragma unroll
                    for (int bj = 0; bj < 2; ++bj) { const f32x4 v0 = acc[ai][bj][m][0] * gw, v1 = acc[ai][bj][m][1] * gw;
                        u32x4 w; w.x = cvt_pk_bf16(v0[0], v0[1]); w.y = cvt_pk_bf16(v0[2], v0[3]); w.z = cvt_pk_bf16(v1[0], v1[1]); w.w = cvt_pk_bf16(v1[2], v1[3]);
                        *(u32x4*)(rowp + bj * HALF) = w; } } }
    }
};

struct EpiPart {
    static constexpr bool PERM = false, AFTER_DRAIN = false;
    float* PART; int pm0, npan;
    __device__ __forceinline__ void operator()(const f32x4 (&acc)[2][2][4][2], const Unit& u, int wr, int wc, int fr, int fq) const {
        const int row0 = ((u.ks * npan + (u.pm - pm0)) * BM) + wr * 64 + fr, col0 = u.pn * BM + wc * 32 + 4 * fq;
#pragma unroll
        for (int ai = 0; ai < 2; ++ai)
#pragma unroll
            for (int m = 0; m < 4; ++m) { float* rowp = PART + (size_t)(row0 + ai * HALF + m * 16) * 1024 + col0;
#pragma unroll
                for (int bj = 0; bj < 2; ++bj)
#pragma unroll
                    for (int n = 0; n < 2; ++n) *(f32x4*)(rowp + bj * HALF + n * 16) = acc[ai][bj][m][n]; }
    }
};
template <class Epi, class Sched, bool ALIGN_EPI = false, bool SP2 = false>
__device__ __forceinline__ void gemm_phase(PG8_LAS unsigned char* lds, const int K, const int ld, const Sched& S, const Epi& E) {
    int tid_ = threadIdx.x; asm volatile("" : "+v"(tid_));
    const int tid = tid_, wid = __builtin_amdgcn_readfirstlane(tid >> 6), lane = tid & 63, wr = wid >> 2, wc = wid & 3, fr = lane & 15, fq = lane >> 4;
    const int nt = K / BK;
    unsigned voffA[2], voffB[2];
#pragma unroll
    for (int i = 0; i < 2; ++i) { int R, C; stage_rc(tid * 16 + i * 8192, R, C); const int Rb = Epi::PERM ? ((R & ~31) + perm32(R & 31)) : R;
        voffA[i] = (unsigned)(R * ld + C) * 2u; voffB[i] = (unsigned)(Rb * ld + C) * 2u; }
    const size_t kstep = (size_t)(BK * 2);
    const size_t hstep = (size_t)HALF * ld * 2;
    const unsigned ldsw = (unsigned)wid * 1024u;
    const int aoff = lds_byte(wr * 64 + fr, fq * 8), boff = lds_byte(wc * 32 + fr, fq * 8);
#define PG8_SA(b, h) (((b) * 2 + (h)) * HTB)
#define PG8_SB(b, h) ((4 + (b) * 2 + (h)) * HTB)
#define PG8_STAGE(bufoff, gbase, voff) do { _Pragma("unroll") for (int _i = 0; _i < 2; ++_i) \
        __builtin_amdgcn_global_load_lds((const unsigned*)((const char*)(gbase) + (voff)[_i]), (PG8_LAS unsigned*)(lds + (bufoff) + ldsw + _i * 8192), 16, 0, 0); } while (0)
#define PG8_LDA(dst, b, h) do { _Pragma("unroll") for (int m = 0; m < 4; ++m) _Pragma("unroll") for (int k = 0; k < 2; ++k) dst[m][k] = *(const PG8_LAS bf16x8*)(lds + PG8_SA(b, h) + aoff + m * 2048 + k * 1024); } while (0)
#define PG8_LDB(dst, b, h) do { _Pragma("unroll") for (int n = 0; n < 2; ++n) _Pragma("unroll") for (int k = 0; k < 2; ++k) dst[n][k] = *(const PG8_LAS bf16x8*)(lds + PG8_SB(b, h) + boff + n * 2048 + k * 1024); } while (0)
#define PG8_MMA(ai, bj, At, Bt) do { __builtin_amdgcn_s_setprio(1); _Pragma("unroll") for (int m = 0; m < 4; ++m) _Pragma("unroll") for (int n = 0; n < 2; ++n) _Pragma("unroll") for (int k = 0; k < 2; ++k) \
        acc[ai][bj][m][n] = __builtin_amdgcn_mfma_f32_16x16x32_bf16(Bt[n][k], At[m][k], acc[ai][bj][m][n], 0, 0, 0); __builtin_amdgcn_s_setprio(0); } while (0)
#define PG8_WAIT_V(n) asm volatile("s_waitcnt vmcnt(" #n ")" ::: "memory")
#define PG8_WAIT_L(n) asm volatile("s_waitcnt lgkmcnt(" #n ")" ::: "memory")
#define PG8_BAR __builtin_amdgcn_s_barrier()
#define PG8_SCHED __builtin_amdgcn_sched_barrier(0)
    Unit cur, nxt; int ui = 0;
    if (!S.next(0, cur)) return;
    f32x4 acc[2][2][4][2];
#pragma unroll
    for (int a = 0; a < 2; ++a)
#pragma unroll
        for (int b = 0; b < 2; ++b)
#pragma unroll
            for (int m = 0; m < 4; ++m)
#pragma unroll
                for (int n = 0; n < 2; ++n) acc[a][b][m][n] = (f32x4){0.f, 0.f, 0.f, 0.f};
    bf16x8 At[4][2], B0[2][2], B1[2][2];
    const char* cA = S.a_base(cur); const char* cB = S.b_base(cur);
    if constexpr (SP2) {
        PG8_STAGE(PG8_SB(0, 0), cB, voffB); PG8_STAGE(PG8_SB(0, 1), cB + hstep, voffB); PG8_STAGE(PG8_SA(0, 0), cA, voffA); PG8_STAGE(PG8_SA(0, 1), cA + hstep, voffA);
        if (wr == 1) PG8_BAR;
        PG8_WAIT_V(2); PG8_BAR;
        PG8_STAGE(PG8_SB(1, 0), cB + kstep, voffB); PG8_STAGE(PG8_SA(1, 0), cA + kstep, voffA); PG8_STAGE(PG8_SB(1, 1), cB + hstep + kstep, voffB);
        PG8_WAIT_V(6); PG8_BAR;
    } else {
        PG8_STAGE(PG8_SB(0, 0), cB, voffB); PG8_STAGE(PG8_SA(0, 0), cA, voffA); PG8_STAGE(PG8_SB(0, 1), cB + hstep, voffB); PG8_STAGE(PG8_SA(0, 1), cA + hstep, voffA);
        if (wr == 1) PG8_BAR;
        PG8_WAIT_V(4); PG8_BAR;
        PG8_STAGE(PG8_SB(1, 0), cB + kstep, voffB); PG8_STAGE(PG8_SA(1, 0), cA + kstep, voffA); PG8_STAGE(PG8_SB(1, 1), cB + hstep + kstep, voffB);
        PG8_WAIT_V(6); PG8_BAR;
    }
    for (;;) {
        const bool has_next = S.next(ui + 1, nxt);
        const char* nA = has_next ? S.a_base(nxt) : cA; const char* nB = has_next ? S.b_base(nxt) : cB;
        for (int t = 0; t < nt; t += 2) {
            const bool last = (t == nt - 2);
            const char* a1 = cA + (size_t)(t + 1) * kstep;
            const char* a2 = last ? nA : cA + (size_t)(t + 2) * kstep; const char* b2 = last ? nB : cB + (size_t)(t + 2) * kstep;
            const char* a3 = a2 + kstep; const char* b3 = b2 + kstep;
            if constexpr (SP2) {
            PG8_LDB(B0, 0, 0); PG8_LDB(B1, 0, 1); PG8_SCHED; PG8_LDA(At, 0, 0); PG8_STAGE(PG8_SA(1, 1), a1 + hstep, voffA);
            PG8_WAIT_V(8); PG8_WAIT_L(0); PG8_BAR; PG8_MMA(0, 0, At, B0); PG8_MMA(0, 1, At, B1); PG8_BAR; PG8_SCHED;
            PG8_LDA(At, 0, 1); PG8_STAGE(PG8_SB(0, 0), b2, voffB); PG8_STAGE(PG8_SB(0, 1), b2 + hstep, voffB); PG8_STAGE(PG8_SA(0, 0), a2, voffA);
            PG8_WAIT_V(8); PG8_WAIT_L(0); PG8_BAR; PG8_MMA(1, 0, At, B0); PG8_MMA(1, 1, At, B1); PG8_BAR; PG8_SCHED;
            PG8_LDB(B0, 1, 0); PG8_LDB(B1, 1, 1); PG8_SCHED; PG8_LDA(At, 1, 0); PG8_STAGE(PG8_SA(0, 1), a2 + hstep, voffA);
            PG8_WAIT_V(8); PG8_WAIT_L(0); PG8_BAR; PG8_MMA(0, 0, At, B0); PG8_MMA(0, 1, At, B1); PG8_BAR; PG8_SCHED;
            PG8_LDA(At, 1, 1); PG8_STAGE(PG8_SB(1, 0), b3, voffB); PG8_STAGE(PG8_SB(1, 1), b3 + hstep, voffB); PG8_STAGE(PG8_SA(1, 0), a3, voffA);
            PG8_WAIT_V(8); PG8_WAIT_L(0); PG8_BAR; PG8_MMA(1, 0, At, B0); PG8_MMA(1, 1, At, B1); PG8_BAR; PG8_SCHED;
            } else {
            PG8_LDB(B0, 0, 0); PG8_SCHED; PG8_LDA(At, 0, 0); PG8_STAGE(PG8_SA(1, 1), a1 + hstep, voffA);
            PG8_WAIT_L(8); PG8_BAR; PG8_WAIT_L(0); PG8_MMA(0, 0, At, B0); PG8_BAR; PG8_SCHED;
            PG8_LDB(B1, 0, 1); PG8_STAGE(PG8_SB(0, 0), b2, voffB);
            PG8_BAR; PG8_WAIT_L(0); PG8_MMA(0, 1, At, B1); PG8_BAR;
            PG8_LDA(At, 0, 1); PG8_STAGE(PG8_SA(0, 0), a2, voffA);
            PG8_BAR; PG8_WAIT_L(0); PG8_MMA(1, 0, At, B0); PG8_BAR; PG8_SCHED;
            PG8_STAGE(PG8_SB(0, 1), b2 + hstep, voffB);
            PG8_WAIT_V(6); PG8_BAR; PG8_MMA(1, 1, At, B1); PG8_BAR;
            PG8_LDB(B0, 1, 0); PG8_SCHED; PG8_LDA(At, 1, 0); PG8_STAGE(PG8_SA(0, 1), a2 + hstep, voffA);
            PG8_WAIT_L(8); PG8_BAR; PG8_WAIT_L(0); PG8_MMA(0, 0, At, B0); PG8_BAR; PG8_SCHED;
            PG8_LDB(B1, 1, 1); PG8_STAGE(PG8_SB(1, 0), b3, voffB);
            PG8_BAR; PG8_WAIT_L(0); PG8_MMA(0, 1, At, B1); PG8_BAR;
            PG8_LDA(At, 1, 1); PG8_STAGE(PG8_SA(1, 0), a3, voffA);
            PG8_BAR; PG8_WAIT_L(0); PG8_MMA(1, 0, At, B0); PG8_BAR; PG8_SCHED;
            PG8_STAGE(PG8_SB(1, 1), b3 + hstep, voffB);
            PG8_WAIT_V(6); PG8_BAR; PG8_MMA(1, 1, At, B1); PG8_BAR;
            }
        }
        if constexpr (ALIGN_EPI) { if (wr == 0) PG8_BAR; }
        E(acc, cur, wr, wc, fr, fq);
        if (!has_next) break;
#pragma unroll
        for (int a = 0; a < 2; ++a)
#pragma unroll
            for (int b = 0; b < 2; ++b)
#pragma unroll
                for (int m = 0; m < 4; ++m)
#pragma unroll
                    for (int n = 0; n < 2; ++n) acc[a][b][m][n] = (f32x4){0.f, 0.f, 0.f, 0.f};
        cur = nxt; cA = nA; cB = nB; ++ui;
        if constexpr (ALIGN_EPI) { if (wr == 1) PG8_BAR; }
    }
    PG8_WAIT_V(0);
    if constexpr (!ALIGN_EPI) { if (wr == 0) PG8_BAR; }
    PG8_BAR;
#undef PG8_SA
#undef PG8_SB
#undef PG8_STAGE
#undef PG8_LDA
#undef PG8_LDB
#undef PG8_MMA
#undef PG8_WAIT_V
#undef PG8_WAIT_L
#undef PG8_BAR
#undef PG8_SCHED
}
}

constexpr int NWAVES = 8;
constexpr int BATCH = 16, SEQ = 2048, D = 1024, T = BATCH * SEQ;
constexpr int LDP = 2816;
constexpr int IN_COLS = 2576;
constexpr int C_U = 0, C_V = 512, C_Q = 1024, C_K = 1280, C_VV = 1536, C_G = 2048, C_A = 2560;
constexpr int DFF = 2816, DFE = 3584, NE = 8;
constexpr float LN_EPS = 1e-5f, RMS_EPS = 1e-6f, ALPHA = 1.41421356237f;
constexpr int RMAX = 2 * T + NE * 256;
constexpr int SLAB_P = 64;
constexpr int NSLAB = 5;
constexpr int KSPLIT = 7, KSLICE = DFE / KSPLIT, REM_P0 = 4 * SLAB_P, REM_MAXP = 8;
constexpr int NPHASE = 24;

constexpr size_t MiB = 1u << 20;
constexpr size_t WS_CTL = 0, CTL_ZERO_BYTES = 64 * 1024;
constexpr size_t WS_TOKE = 1 * MiB;
constexpr size_t WS_TOKW = WS_TOKE + 256 * 1024;
constexpr size_t WS_PPOS = WS_TOKW + 256 * 1024;
constexpr size_t WS_PEXP = WS_PPOS + 256 * 1024;
constexpr size_t WS_RPAIR = 2 * MiB;
constexpr size_t WS_RW = WS_RPAIR + 512 * 1024;
constexpr size_t WS_WM = 3 * MiB;
constexpr size_t WS_WIN = 4 * MiB;
constexpr size_t WS_WOUT = 15 * MiB;
constexpr size_t WS_WGU = 19 * MiB;
constexpr size_t WS_WDN = 30 * MiB;
constexpr size_t WS_EGU = 36 * MiB;
constexpr size_t WS_EDN = 148 * MiB;
constexpr size_t WS_XB = 204 * MiB;
constexpr size_t WS_BIG = 268 * MiB;
constexpr size_t WS_PROJ = WS_BIG;
constexpr size_t WS_CAT = 444 * MiB;
constexpr size_t WS_HID = WS_BIG;
constexpr size_t WS_XG = WS_BIG;
constexpr size_t WS_PART = WS_BIG;
constexpr size_t WS_HSLAB = 400 * MiB;
constexpr size_t WS_END = 512 * MiB;
constexpr int CW_TMO = 0;
constexpr int CW_CNT = 64;
constexpr int CW_CUR = 128;
constexpr int CW_BAR = 4096;

constexpr int RING_BYTES = 131072;
constexpr int LDSCTL_OFF = RING_BYTES, MISC_OFF = LDSCTL_OFF + 320;
constexpr int LDS_BYTES = 147456;

#define GAS __attribute__((address_space(1)))
#define LAS __attribute__((address_space(3)))
typedef unsigned short bf16;
typedef unsigned v4u __attribute__((ext_vector_type(4)));
typedef unsigned v2u __attribute__((ext_vector_type(2)));
typedef float f32x4 __attribute__((ext_vector_type(4)));
typedef float f32x2 __attribute__((ext_vector_type(2)));
typedef short bf16x8 __attribute__((ext_vector_type(8)));
#define RLX_AGENT __ATOMIC_RELAXED, __HIP_MEMORY_SCOPE_AGENT
#define LDS_WAIT() asm volatile("s_waitcnt lgkmcnt(0)" ::: "memory")
__device__ __forceinline__ float bflo(unsigned w) { return __uint_as_float(w << 16); }
__device__ __forceinline__ float bfhi(unsigned w) { return __uint_as_float(w & 0xffff0000u); }
__device__ __forceinline__ float bf2f(unsigned short h) { return __uint_as_float(((unsigned)h) << 16); }
__device__ __forceinline__ unsigned pk2(float lo, float hi) { return pg8::cvt_pk_bf16(lo, hi); }

#define XB_TMO      128
#define XB_XCNT(j)  (256  + 64 * (j))
#define XB_XSUB(j)  (1280 + 64 * (j))
#define XB_XGEN(j)  (2304 + 64 * (j))
#define XB_TOP      3328
#define XB_TOPGEN   3392
#define XCD_BAR_WORDS 3456
#define XB_SPIN_CAP (1u << 18)
__device__ __forceinline__ unsigned xb_ld(unsigned* p)              { return __hip_atomic_load(p, __ATOMIC_RELAXED, __HIP_MEMORY_SCOPE_AGENT); }
__device__ __forceinline__ unsigned xb_add(unsigned* p, unsigned v) { return __hip_atomic_fetch_add(p, v, __ATOMIC_RELAXED, __HIP_MEMORY_SCOPE_AGENT); }
__device__ __forceinline__ unsigned xb_xcc_id() { return (unsigned)__builtin_amdgcn_s_getreg((3 << 11) | 20) & 0xFu; }
#define XB_SPIN(cond, bar) do { unsigned _sp = 0; while (cond) { __builtin_amdgcn_s_sleep(1); \
    if ((++_sp & 255u) == 0u) { if (xb_ld(&(bar)[XB_TMO])) break; if (_sp > XB_SPIN_CAP) { atomicAdd(&(bar)[XB_TMO], 1u); break; } } } } while (0)
struct XcdBarrier { unsigned* bar; unsigned x; volatile LAS unsigned* st; };
__device__ __forceinline__ XcdBarrier xcd_barrier_post(unsigned* bar, volatile LAS unsigned* st) {
    XcdBarrier b; b.bar = bar; b.x = xb_xcc_id(); b.st = st;
    if (threadIdx.x == 0) (void)xb_add(&bar[XB_XCNT(b.x)], 1u);
    return b;
}
__device__ __forceinline__ void xcd_barrier_complete(unsigned* bar, unsigned x, unsigned& nloc, unsigned& nx) {
    const unsigned G = gridDim.x * gridDim.y * gridDim.z;
    unsigned sum, cnt, mine, sp = 0u;
    for (;;) {
        sum = 0u; cnt = 0u; mine = 0u;
#pragma unroll
        for (unsigned j = 0; j < 16; ++j) { const unsigned c = xb_ld(&bar[XB_XCNT(j)]); sum += c; cnt += (c > 0u) ? 1u : 0u; mine = (j == x) ? c : mine; }
        if (sum == G) break;
        __builtin_amdgcn_s_sleep(1);
        if ((++sp & 255u) == 0u) { if (xb_ld(&bar[XB_TMO])) break; if (sp > XB_SPIN_CAP) { atomicAdd(&bar[XB_TMO], 1u); break; } }
    }
    nloc = mine > 0u ? mine : 1u; nx = cnt > 0u ? cnt : 1u;
}
__device__ __forceinline__ void xcd_barrier(const XcdBarrier& b) {
    asm volatile("s_waitcnt vmcnt(0)" ::: "memory");
    __syncthreads();
    if (threadIdx.x == 0) {
        unsigned* bar = b.bar;
        __builtin_amdgcn_s_waitcnt(0);
        unsigned nloc = b.st[0], nx = b.st[1];
        if (nloc == 0u) { xcd_barrier_complete(bar, b.x, nloc, nx); b.st[0] = nloc; b.st[1] = nx; }
        const unsigned old = xb_add(&bar[XB_XSUB(b.x)], 1u);
        const unsigned gen = old / nloc;
        if (old + 1u == (gen + 1u) * nloc) {
            __builtin_amdgcn_fence(__ATOMIC_RELEASE, "agent");
            asm volatile("s_waitcnt vmcnt(0)" ::: "memory");
            const unsigned og = xb_add(&bar[XB_TOP], 1u);
            const unsigned tg = og / nx;
            if (og + 1u == (tg + 1u) * nx) xb_add(&bar[XB_TOPGEN], 1u);
            else XB_SPIN(xb_ld(&bar[XB_TOPGEN]) == tg, bar);
            __builtin_amdgcn_fence(__ATOMIC_ACQUIRE, "agent");
            xb_add(&bar[XB_XGEN(b.x)], 1u);
            asm volatile("s_waitcnt vmcnt(0)" ::: "memory");
        } else {
            XB_SPIN(xb_ld(&bar[XB_XGEN(b.x)]) == gen, bar);
            __builtin_amdgcn_fence(__ATOMIC_ACQUIRE, "agent");
            asm volatile("s_waitcnt vmcnt(0)" ::: "memory");
        }
    }
    __syncthreads();
}

struct Args { const float* in[21]; float* out; unsigned char* ws; int ph_lo, ph_hi; };
struct Frame {
    LAS unsigned char* lds;
    volatile LAS unsigned* MISC;
    unsigned* ctl;
    int G;
    unsigned char* ws; float* out;
};
#define LOCAL_IDS int tid = threadIdx.x; asm volatile("" : "+v"(tid)); const int lane = tid & 63; const int wave = __builtin_amdgcn_readfirstlane(tid >> 6); (void)lane; (void)wave
__device__ __forceinline__ float wave_sum(float v) {
#pragma unroll
    for (int o = 1; o < 64; o <<= 1) v += __shfl_xor(v, o);
    return v;
}

__device__ __forceinline__ void tr_block(const float* W, int Nsrc, int K, int k0, int n0, bf16* WT, int drow, int lane) {
    const int n = n0 + lane; const bool ok = n < Nsrc; const float* src = W + (size_t)k0 * Nsrc + (ok ? n : 0);
    float v[64];
#pragma unroll
    for (int kk = 0; kk < 64; ++kk) v[kk] = src[(size_t)kk * Nsrc];
    GAS v4u* dst = (GAS v4u*)(WT + (size_t)(drow + lane) * K + k0);
#pragma unroll
    for (int c = 0; c < 8; ++c) { v4u o; o.x = pk2(v[8 * c], v[8 * c + 1]); o.y = pk2(v[8 * c + 2], v[8 * c + 3]); o.z = pk2(v[8 * c + 4], v[8 * c + 5]); o.w = pk2(v[8 * c + 6], v[8 * c + 7]);
        if (!ok) o = (v4u){0u, 0u, 0u, 0u}; dst[c] = o; }
}
__device__ __forceinline__ void tr_plain(const float* W, int K, int Nsrc, int nblk, bf16* WT, int item, int lane) {
    const int kb = item / nblk, nb = item % nblk; tr_block(W, Nsrc, K, 64 * kb, 64 * nb, WT, 64 * nb, lane);
}
__device__ __forceinline__ void tr_gu(const float* W, int K, int Nsrc, int nblk, bf16* WT, int add, int item, int lane) {
    const int kb = item / nblk, nb = item % nblk, n0 = 64 * nb; tr_block(W, Nsrc, K, 64 * kb, n0, WT, (n0 >> 7) * 256 + (n0 & 127) + add, lane);
}
constexpr int I_IN = 16 * 44, I_OUT = 16 * 16, I_G = 16 * 44, I_DN = 44 * 16, I_EG = 16 * 56, I_ED = 56 * 16;
constexpr int NITEMS = 2 * I_IN + 2 * I_OUT + 2 * I_G + I_DN + 16 * I_EG + 8 * I_ED;
constexpr int NITEMS_A = I_IN + I_OUT, NITEMS_B = NITEMS - NITEMS_A;
__device__ __forceinline__ void conv_item(unsigned char* ws, const Args& a, int it, int lane) {
    bf16* Win = (bf16*)(ws + WS_WIN); bf16* Wout = (bf16*)(ws + WS_WOUT); bf16* Wgu = (bf16*)(ws + WS_WGU); bf16* Wdn = (bf16*)(ws + WS_WDN);
    bf16* Egu = (bf16*)(ws + WS_EGU); bf16* Edn = (bf16*)(ws + WS_EDN);
    int r = it;
    if (r < 2 * I_IN) { const int l = r / I_IN; tr_plain(a.in[1] + (size_t)l * D * IN_COLS, D, IN_COLS, 44, Win + (size_t)l * LDP * D, r % I_IN, lane); return; } r -= 2 * I_IN;
    if (r < 2 * I_OUT) { const int l = r / I_OUT; tr_plain(a.in[9] + (size_t)l * D * D, D, D, 16, Wout + (size_t)l * D * D, r % I_OUT, lane); return; } r -= 2 * I_OUT;
    if (r < I_G) { tr_gu(a.in[12], D, DFF, 44, Wgu, 0, r, lane); return; } r -= I_G;
    if (r < I_G) { tr_gu(a.in[13], D, DFF, 44, Wgu, 128, r, lane); return; } r -= I_G;
    if (r < I_DN) { tr_plain(a.in[14], DFF, D, 16, Wdn, r, lane); return; } r -= I_DN;
    if (r < 8 * I_EG) { const int e = r / I_EG; tr_gu(a.in[16] + (size_t)e * D * DFE, D, DFE, 56, Egu + (size_t)e * 2 * DFE * D, 0, r % I_EG, lane); return; } r -= 8 * I_EG;
    if (r < 8 * I_EG) { const int e = r / I_EG; tr_gu(a.in[17] + (size_t)e * D * DFE, D, DFE, 56, Egu + (size_t)e * 2 * DFE * D, 128, r % I_EG, lane); return; } r -= 8 * I_EG;
    { const int e = r / I_ED; tr_plain(a.in[18] + (size_t)e * DFE * D, DFE, D, 16, Edn + (size_t)e * D * DFE, r % I_ED, lane); }
}
__device__ __forceinline__ void conv_set_b(Frame& F, const Args& a, int gw2, int NGW2) {
    LOCAL_IDS;
    for (int k = gw2; k < NITEMS_B; k += NGW2) conv_item(F.ws, a, k < I_IN ? I_IN + k : 2 * I_IN + I_OUT + (k - I_IN), lane);
}
__device__ __forceinline__ void p0_prologue(Frame& F, const Args& a) {
    LOCAL_IDS;
    const int gw = blockIdx.x * NWAVES + wave, NGW = F.G * NWAVES;
    for (int k = gw; k < NITEMS_A; k += NGW) conv_item(F.ws, a, k < I_IN ? k : 2 * I_IN + (k - I_IN), lane);
    if (F.G < 128) conv_set_b(F, a, gw, NGW);
    const size_t gt = (size_t)blockIdx.x * 512 + tid, NT = (size_t)F.G * 512;
    { const f32x4* x4 = (const f32x4*)a.in[0]; v4u* o = (v4u*)(F.ws + WS_XB);
      for (size_t i = gt; i < (size_t)T * D / 8; i += NT) { const f32x4 p = x4[2 * i], q = x4[2 * i + 1]; v4u w; w.x = pk2(p[0], p[1]); w.y = pk2(p[2], p[3]); w.z = pk2(q[0], q[1]); w.w = pk2(q[2], q[3]); o[i] = w; } }
    { const float* w = a.in[2]; bf16* o = (bf16*)(F.ws + WS_WM);
      for (size_t i = gt; i < (size_t)2 * 4 * 128 * 128; i += NT) { const int s = (int)(i & 127), t = (int)((i >> 7) & 127); o[i] = (bf16)(pk2(s <= t ? w[i] : 0.f, 0.f) & 0xffffu); } }
}

__device__ __forceinline__ void gmlp_item(Frame& F, const Args& a, int layer, int item) {
    const int bb = item >> 6, c = (item >> 2) & 15, h = item & 3; const int r0 = bb * SEQ + c * 128;
    const bf16* P = (const bf16*)(F.ws + WS_PROJ); bf16* CAT = (bf16*)(F.ws + WS_CAT);
    const bf16* Wm = (const bf16*)(F.ws + WS_WM) + (size_t)(layer * 4 + h) * 128 * 128;
    const float* lng = a.in[4] + layer * 512 + h * 128; const float* lnb = a.in[5] + layer * 512 + h * 128; const float* bs = a.in[3] + (layer * 4 + h) * 128;
    LAS unsigned char* VTA = F.lds;
    LOCAL_IDS; const int w = wave, fr = lane & 15, fq = lane >> 4;
    {
        const int s = tid >> 2, q4 = tid & 3; const bf16* vp = P + (size_t)(r0 + s) * LDP + C_V + h * 128 + q4 * 8;
        float x[4][8]; float sum = 0.f;
#pragma unroll
        for (int j = 0; j < 4; ++j) { const v4u wv = *(const v4u*)(vp + 32 * j); x[j][0] = bflo(wv.x); x[j][1] = bfhi(wv.x); x[j][2] = bflo(wv.y); x[j][3] = bfhi(wv.y); x[j][4] = bflo(wv.z); x[j][5] = bfhi(wv.z); x[j][6] = bflo(wv.w); x[j][7] = bfhi(wv.w);
#pragma unroll
            for (int e = 0; e < 8; ++e) sum += x[j][e]; }
        sum += __shfl_xor(sum, 1); sum += __shfl_xor(sum, 2);
        const float mean = sum * (1.f / 128.f); float q = 0.f;
#pragma unroll
        for (int j = 0; j < 4; ++j)
#pragma unroll
            for (int e = 0; e < 8; ++e) { x[j][e] -= mean; q += x[j][e] * x[j][e]; }
        q += __shfl_xor(q, 1); q += __shfl_xor(q, 2);
        const float rstd = 1.0f / sqrtf(q * (1.f / 128.f) + LN_EPS);
#pragma unroll
        for (int j = 0; j < 4; ++j) { const int ch0 = q4 * 8 + 32 * j; const f32x4 g0 = *(const f32x4*)(lng + ch0), g1 = *(const f32x4*)(lng + ch0 + 4), b0 = *(const f32x4*)(lnb + ch0), b1 = *(const f32x4*)(lnb + ch0 + 4);
#pragma unroll
            for (int e = 0; e < 8; ++e) { const float gg = e < 4 ? g0[e & 3] : g1[e & 3], be = e < 4 ? b0[e & 3] : b1[e & 3]; const float y = x[j][e] * rstd * gg + be;
                *(LAS bf16*)(VTA + (ch0 + e) * 272 + s * 2) = (bf16)(pk2(y, 0.f) & 0xffffu); } }
    }
    __syncthreads();
    {
        bf16x8 aV[4];
#pragma unroll
        for (int ks = 0; ks < 4; ++ks) aV[ks] = *(const LAS bf16x8*)(VTA + (16 * w + fr) * 272 + (32 * ks + 8 * fq) * 2);
#pragma unroll
        for (int tt = 0; tt < 8; ++tt) { f32x4 acc = (f32x4){0.f, 0.f, 0.f, 0.f}; const int t = 16 * tt + fr;
#pragma unroll
            for (int ks = 0; ks < 4; ++ks) if (ks <= tt / 2) { const bf16x8 bW = *(const bf16x8*)(Wm + (size_t)t * 128 + 32 * ks + 8 * fq); acc = __builtin_amdgcn_mfma_f32_16x16x32_bf16(aV[ks], bW, acc, 0, 0, 0); }
            const float bst = bs[t]; const size_t row = (size_t)(r0 + t); const v2u uu = *(const v2u*)(P + row * LDP + C_U + h * 128 + 16 * w + 4 * fq);
            v2u o; o.x = pk2(bflo(uu.x) * (acc[0] + bst), bfhi(uu.x) * (acc[1] + bst)); o.y = pk2(bflo(uu.y) * (acc[2] + bst), bfhi(uu.y) * (acc[3] + bst));
            if ((ABL >> layer) & 1) { o.x = 0u; o.y = 0u; }
            *(v2u*)(CAT + row * D + h * 128 + 16 * w + 4 * fq) = o; }
    }
    __syncthreads();
}

constexpr int G_QD = 0, G_KI = 9216, G_SC = 18432, G_KDT = 27648, G_VT = 36864, G_ST = 55296, G_ALR = 73728, G_PART = 75776, G_DEC = 77824, G_SS = 78080, G_RQ = 80128, G_RK = 88320, G_RV = 96512, G_BL = 112896, G_END = 129280;
template <int N> __device__ __forceinline__ float dpp_row_shr(float x) {
    return __builtin_bit_cast(float, __builtin_amdgcn_update_dpp(0, __builtin_bit_cast(int, x), 0x110 + N, 0xf, 0xf, false)); }
__device__ __forceinline__ void gla_item(Frame& F, const Args& a, int layer, int item) {
    const int bb = item >> 2, h = item & 3;
    const bf16* P = (const bf16*)(F.ws + WS_PROJ) + (size_t)bb * SEQ * LDP; bf16* CAT = (bf16*)(F.ws + WS_CAT) + (size_t)bb * SEQ * D;
    LAS unsigned char* L = F.lds;
    LOCAL_IDS; const int w = wave, fr = lane & 15, fq = lane >> 4, d = lane;
    const int ve = (w & 1) * 64 + lane, vjg = w >> 1;
    const int dtw = w & 3, ihw = w >> 2;
    const int ih = w & 3, eh = w >> 2;
    bf16x8 wfrag;
    { const float* wa = a.in[6] + (size_t)layer * 16 * 256 + h * 64 + 16 * dtw + fr;
#pragma unroll
      for (int j = 0; j < 8; ++j) { const float wv = wa[(8 * (fq & 1) + j) * 256]; const unsigned hi = pk2(wv, 0.f) & 0xffffu; const unsigned lo = pk2(wv - __uint_as_float(hi << 16), 0.f) & 0xffffu; wfrag[j] = (short)((fq < 2) ? hi : lo); } }
    const f32x4 bav = *(const f32x4*)(a.in[7] + layer * 256 + h * 64 + 16 * dtw + 4 * fq);
    f32x4 ng[4];
#pragma unroll
    for (int e4 = 0; e4 < 4; ++e4) ng[e4] = *(const f32x4*)(a.in[8] + layer * 512 + h * 128 + 64 * eh + 16 * e4 + 4 * fq);
    for (int i = tid; i < (18432 + 9216) / 4; i += 512) { if (i < 18432 / 4) ((LAS unsigned*)(L + G_ST))[i] = 0u; else ((LAS unsigned*)(L + G_SC))[i - 18432 / 4] = 0u; }
    f32x4 sacc[4];
#pragma unroll
    for (int dt = 0; dt < 4; ++dt) sacc[dt] = (f32x4){0.f, 0.f, 0.f, 0.f};
    const unsigned oq = (unsigned)((tid >> 3) * LDP + C_Q + h * 64 + (tid & 7) * 8), ok_ = (unsigned)((tid >> 3) * LDP + C_K + h * 64 + (tid & 7) * 8);
    const unsigned ov = (unsigned)((tid >> 4) * LDP + C_VV + h * 128 + (tid & 15) * 8), oa = (unsigned)(((tid & 127) >> 1) * LDP + C_A + (tid & 1) * 8);
    const unsigned og = (unsigned)((16 * ih + fr) * LDP + C_G + h * 128 + 64 * eh + 4 * fq);
    v4u rq, rk, rv0, rv1, ra = (v4u){0u, 0u, 0u, 0u};
    { rq = *(const v4u*)(P + oq); rk = *(const v4u*)(P + ok_); rv0 = *(const v4u*)(P + ov); rv1 = *(const v4u*)(P + ov + 32 * LDP); if (tid < 128) ra = *(const v4u*)(P + oa); }
    __syncthreads();
    v2u pend[4]; bf16* prow = CAT;
#pragma unroll
    for (int e4 = 0; e4 < 4; ++e4) pend[e4] = (v2u){0u, 0u};
    for (int n = 0; n < 32; ++n) {
        const bf16* R = P + (size_t)n * 64 * LDP;
        *(LAS v4u*)(L + G_RQ + tid * 16) = rq; *(LAS v4u*)(L + G_RK + tid * 16) = rk; *(LAS v4u*)(L + G_RV + tid * 16) = rv0; *(LAS v4u*)(L + G_RV + 8192 + tid * 16) = rv1;
        if (tid < 128) *(LAS v4u*)(L + G_ALR + tid * 16) = ra;
        __syncthreads();
        if (n + 1 < 32) { const bf16* Rn = R + (size_t)64 * LDP; rq = *(const v4u*)(Rn + oq); rk = *(const v4u*)(Rn + ok_); rv0 = *(const v4u*)(Rn + ov); rv1 = *(const v4u*)(Rn + ov + 32 * LDP); if (tid < 128) ra = *(const v4u*)(Rn + oa); }
        v2u gate[4];
#pragma unroll
        for (int e4 = 0; e4 < 4; ++e4) gate[e4] = *(const v2u*)(R + og + 16 * e4);
        if (n > 0) {
#pragma unroll
            for (int e4 = 0; e4 < 4; ++e4) *(v2u*)(prow + 16 * e4) = pend[e4]; }
        { unsigned short vv[16];
#pragma unroll
          for (int jj = 0; jj < 16; ++jj) vv[jj] = *(const LAS unsigned short*)(L + G_RV + (16 * vjg + jj) * 256 + ve * 2);
          v4u p0, p1; p0.x = vv[0] | ((unsigned)vv[1] << 16); p0.y = vv[2] | ((unsigned)vv[3] << 16); p0.z = vv[4] | ((unsigned)vv[5] << 16); p0.w = vv[6] | ((unsigned)vv[7] << 16);
          p1.x = vv[8] | ((unsigned)vv[9] << 16); p1.y = vv[10] | ((unsigned)vv[11] << 16); p1.z = vv[12] | ((unsigned)vv[13] << 16); p1.w = vv[14] | ((unsigned)vv[15] << 16);
          *(LAS v4u*)(L + G_VT + ve * 144 + vjg * 32) = p0; *(LAS v4u*)(L + G_VT + ve * 144 + vjg * 32 + 16) = p1; }
        { f32x4 cum[2];
#pragma unroll
          for (int t2 = 0; t2 < 2; ++t2) { const int i = 16 * (2 * ihw + t2) + fr;
              const bf16x8 af = *(const LAS bf16x8*)(L + G_ALR + i * 32 + (fq & 1) * 16);
              f32x4 z = __builtin_amdgcn_mfma_f32_16x16x32_bf16(wfrag, af, bav, 0, 0, 0);
#pragma unroll
              for (int r = 0; r < 4; ++r) { float x = (fminf(z[r], 0.f) - __logf(1.0f + __expf(-fabsf(z[r])))) * 0.0625f;
                  x += dpp_row_shr<1>(x); x += dpp_row_shr<2>(x); x += dpp_row_shr<4>(x); x += dpp_row_shr<8>(x); z[r] = x; }
              cum[t2] = z; }
#pragma unroll
          for (int r = 0; r < 4; ++r) cum[1][r] += __shfl(cum[0][r], (lane & 48) | 15);
          *(LAS f32x4*)(L + G_BL + ((32 * ihw + fr) * 64 + 16 * dtw + 4 * fq) * 4) = cum[0];
          *(LAS f32x4*)(L + G_BL + ((32 * ihw + 16 + fr) * 64 + 16 * dtw + 4 * fq) * 4) = cum[1];
          if (fr == 15) *(LAS f32x4*)(L + G_PART + (ihw * 64 + 16 * dtw + 4 * fq) * 4) = cum[1]; }
        __syncthreads();
        { const float p0 = *(const LAS float*)(L + G_PART + d * 4), p1 = *(const LAS float*)(L + G_PART + (64 + d) * 4); const float bl = p0 + p1, ebl = __expf(bl), off = (w >= 4) ? p0 : 0.f;
          unsigned kd[8];
#pragma unroll
          for (int ii = 0; ii < 8; ++ii) { const float qv = bf2f(*(const LAS unsigned short*)(L + G_RQ + (8 * w + ii) * 128 + d * 2)), kv = bf2f(*(const LAS unsigned short*)(L + G_RK + (8 * w + ii) * 128 + d * 2));
              const float b_ = off + *(const LAS float*)(L + G_BL + ((8 * w + ii) * 64 + d) * 4); const float eb = __expf(b_), ki = kv * __builtin_amdgcn_rcpf(eb);
              *(LAS bf16*)(L + G_QD + (8 * w + ii) * 144 + d * 2) = (bf16)(pk2(qv * 0.125f * eb, 0.f) & 0xffffu);
              *(LAS bf16*)(L + G_KI + (8 * w + ii) * 144 + d * 2) = (bf16)(pk2(ki, 0.f) & 0xffffu);
              kd[ii] = pk2(ki * ebl, 0.f) & 0xffffu; }
          v4u pk; pk.x = kd[0] | (kd[1] << 16); pk.y = kd[2] | (kd[3] << 16); pk.z = kd[4] | (kd[5] << 16); pk.w = kd[6] | (kd[7] << 16);
          *(LAS v4u*)(L + G_KDT + d * 144 + w * 16) = pk;
          if (w == 0) *(LAS float*)(L + G_DEC + d * 4) = ebl; }
        __syncthreads();
#pragma unroll
        for (int rep = 0; rep < 2; ++rep) { const int tix = w + 8 * rep;
            if (tix < 10) { const int it = (tix >= 6) ? 3 : (tix >= 3) ? 2 : (tix >= 1) ? 1 : 0, jt = tix - it * (it + 1) / 2;
                f32x4 acc = (f32x4){0.f, 0.f, 0.f, 0.f};
#pragma unroll
                for (int ks = 0; ks < 2; ++ks) { const bf16x8 ak = *(const LAS bf16x8*)(L + G_KI + (16 * jt + fr) * 144 + (32 * ks + 8 * fq) * 2), bq = *(const LAS bf16x8*)(L + G_QD + (16 * it + fr) * 144 + (32 * ks + 8 * fq) * 2);
                    acc = __builtin_amdgcn_mfma_f32_16x16x32_bf16(ak, bq, acc, 0, 0, 0); }
                const int i = 16 * it + fr, j0 = 16 * jt + 4 * fq;
                v2u o; o.x = pk2(j0 <= i ? acc[0] : 0.f, j0 + 1 <= i ? acc[1] : 0.f); o.y = pk2(j0 + 2 <= i ? acc[2] : 0.f, j0 + 3 <= i ? acc[3] : 0.f);
                *(LAS v2u*)(L + G_SC + i * 144 + j0 * 2) = o; } }
        __syncthreads();
        f32x4 o[4]; float ssq = 0.f;
        { bf16x8 bSC[2], bQD[2];
#pragma unroll
          for (int ks = 0; ks < 2; ++ks) { bSC[ks] = *(const LAS bf16x8*)(L + G_SC + (16 * ih + fr) * 144 + (32 * ks + 8 * fq) * 2); bQD[ks] = *(const LAS bf16x8*)(L + G_QD + (16 * ih + fr) * 144 + (32 * ks + 8 * fq) * 2); }
#pragma unroll
          for (int e4 = 0; e4 < 4; ++e4) { const int er = 64 * eh + 16 * e4 + fr; f32x4 acc = (f32x4){0.f, 0.f, 0.f, 0.f};
              const bf16x8 aV0 = *(const LAS bf16x8*)(L + G_VT + er * 144 + (8 * fq) * 2), aV1 = *(const LAS bf16x8*)(L + G_VT + er * 144 + (32 + 8 * fq) * 2);
              const bf16x8 aS0 = *(const LAS bf16x8*)(L + G_ST + er * 144 + (8 * fq) * 2), aS1 = *(const LAS bf16x8*)(L + G_ST + er * 144 + (32 + 8 * fq) * 2);
              acc = __builtin_amdgcn_mfma_f32_16x16x32_bf16(aV0, bSC[0], acc, 0, 0, 0);
              if (ih >= 2) acc = __builtin_amdgcn_mfma_f32_16x16x32_bf16(aV1, bSC[1], acc, 0, 0, 0);
              acc = __builtin_amdgcn_mfma_f32_16x16x32_bf16(aS0, bQD[0], acc, 0, 0, 0); acc = __builtin_amdgcn_mfma_f32_16x16x32_bf16(aS1, bQD[1], acc, 0, 0, 0);
              o[e4] = acc;
              ssq += acc[0] * acc[0] + acc[1] * acc[1] + acc[2] * acc[2] + acc[3] * acc[3]; }
          ssq += __shfl_xor(ssq, 16); ssq += __shfl_xor(ssq, 32);
          if (fq == 0) *(LAS float*)(L + G_SS + (eh * 64 + 16 * ih + fr) * 4) = ssq; }
        __syncthreads();
        { bf16x8 aV[2];
#pragma unroll
          for (int ks = 0; ks < 2; ++ks) aV[ks] = *(const LAS bf16x8*)(L + G_VT + (16 * w + fr) * 144 + (32 * ks + 8 * fq) * 2);
#pragma unroll
          for (int dt = 0; dt < 4; ++dt) { const f32x4 dec = *(const LAS f32x4*)(L + G_DEC + (16 * dt + 4 * fq) * 4); sacc[dt] = sacc[dt] * dec;
#pragma unroll
              for (int ks = 0; ks < 2; ++ks) { const bf16x8 ak = *(const LAS bf16x8*)(L + G_KDT + (16 * dt + fr) * 144 + (32 * ks + 8 * fq) * 2); sacc[dt] = __builtin_amdgcn_mfma_f32_16x16x32_bf16(ak, aV[ks], sacc[dt], 0, 0, 0); }
              v2u sw; sw.x = pk2(sacc[dt][0], sacc[dt][1]); sw.y = pk2(sacc[dt][2], sacc[dt][3]);
              *(LAS v2u*)(L + G_ST + (16 * w + fr) * 144 + (16 * dt + 4 * fq) * 2) = sw; } }
        { const float tot = *(const LAS float*)(L + G_SS + (16 * ih + fr) * 4) + *(const LAS float*)(L + G_SS + (64 + 16 * ih + fr) * 4);
          const float rstd = 1.0f / sqrtf(tot * (1.f / 128.f) + RMS_EPS);
          bf16* orow = CAT + (size_t)(n * 64 + 16 * ih + fr) * D + 512 + h * 128 + 64 * eh + 4 * fq;
#pragma unroll
          for (int e4 = 0; e4 < 4; ++e4) { const float g0 = bflo(gate[e4].x), g1 = bfhi(gate[e4].x), g2 = bflo(gate[e4].y), g3 = bfhi(gate[e4].y);
              v2u ov_; ov_.x = pk2(o[e4][0] * rstd * ng[e4][0] * pg8::silu_f(g0), o[e4][1] * rstd * ng[e4][1] * pg8::silu_f(g1)); ov_.y = pk2(o[e4][2] * rstd * ng[e4][2] * pg8::silu_f(g2), o[e4][3] * rstd * ng[e4][3] * pg8::silu_f(g3));
              if ((ABL >> (2 + layer)) & 1) { ov_.x = 0u; ov_.y = 0u; }
              pend[e4] = ov_; }
          prow = orow; }
    }
#pragma unroll
    for (int e4 = 0; e4 < 4; ++e4) *(v2u*)(prow + 16 * e4) = pend[e4];
    __syncthreads();
}
__device__ __forceinline__ void mixer_phase(Frame& F, const Args& a, int layer) {
    const int bx = blockIdx.x; int G_ = F.G; asm volatile("" : "+s"(G_));
    if (G_ >= 128) {
        if (bx < 64) gla_item(F, a, layer, bx);
        else { for (int it = bx - 64; it < 1024; it += F.G - 64) gmlp_item(F, a, layer, it);
            if (layer == 0) { const int wv = __builtin_amdgcn_readfirstlane((int)threadIdx.x >> 6); conv_set_b(F, a, (bx - 64) * NWAVES + wv, (F.G - 64) * NWAVES); } }
    } else {
        for (int it = bx; it < 64; it += F.G) gla_item(F, a, layer, it);
        for (int it = bx; it < 1024; it += F.G) gmlp_item(F, a, layer, it);
    }
}

template <bool ROUTER>
__device__ __forceinline__ void ln_phase(Frame& F, const Args& a, const float* g, const float* b) {
    LOCAL_IDS;
    constexpr int RB = ROUTER ? 2 : 4;
    const int gw = blockIdx.x * NWAVES + wave, NGW = F.G * NWAVES;
    const bf16* Y = (const bf16*)F.out; bf16* XB = (bf16*)(F.ws + WS_XB);
    f32x4 gv[4], bv[4];
#pragma unroll
    for (int j = 0; j < 4; ++j) { gv[j] = *(const f32x4*)(g + 4 * lane + 256 * j); bv[j] = *(const f32x4*)(b + 4 * lane + 256 * j); }
    LAS unsigned* hist = (LAS unsigned*)(F.lds + 1024);
    f32x4 wq[ROUTER ? 32 : 1];
    if (ROUTER) {
        if (tid < 8) hist[tid] = 0u;
        int* rp = (int*)(F.ws + WS_RPAIR);
        for (int c = blockIdx.x; c < RMAX / 512; c += F.G) rp[c * 512 + tid] = -1;
        const float* wr = a.in[15];
#pragma unroll
        for (int j = 0; j < 4; ++j)
#pragma unroll
            for (int c = 0; c < 4; ++c) { const int k = 4 * lane + 256 * j + c; wq[(j * 4 + c) * 2] = *(const f32x4*)(wr + k * 8); wq[(j * 4 + c) * 2 + 1] = *(const f32x4*)(wr + k * 8 + 4); }
        __syncthreads();
    }
    for (int m0 = gw * RB; m0 < T; m0 += NGW * RB) {
        v2u raw[RB][4];
#pragma unroll
        for (int r = 0; r < RB; ++r) { const v2u* xr = (const v2u*)(Y + (size_t)(m0 + r) * D) + lane;
#pragma unroll
            for (int j = 0; j < 4; ++j) raw[r][j] = xr[64 * j]; }
#pragma unroll
        for (int r = 0; r < RB; ++r) { const int m = m0 + r;
            f32x4 v[4]; float s = 0.f;
#pragma unroll
            for (int j = 0; j < 4; ++j) { const v2u yy = raw[r][j]; v[j] = (f32x4){bflo(yy.x), bfhi(yy.x), bflo(yy.y), bfhi(yy.y)}; s += (v[j][0] + v[j][1]) + (v[j][2] + v[j][3]); }
            const float mean = wave_sum(s) * (1.f / D); float s2 = 0.f;
#pragma unroll
            for (int j = 0; j < 4; ++j) { v[j] = v[j] - mean; s2 += (v[j][0] * v[j][0] + v[j][1] * v[j][1]) + (v[j][2] * v[j][2] + v[j][3] * v[j][3]); }
            const float rstd = 1.f / sqrtf(wave_sum(s2) * (1.f / D) + LN_EPS);
            v2u* o8 = (v2u*)(XB + (size_t)m * D) + lane;
#pragma unroll
            for (int j = 0; j < 4; ++j) { v[j] = v[j] * rstd * gv[j] + bv[j]; v2u w; w.x = pk2(v[j][0], v[j][1]); w.y = pk2(v[j][2], v[j][3]); o8[64 * j] = w; }
            if (ROUTER) {
                float lg[8];
#pragma unroll
                for (int e = 0; e < 8; ++e) lg[e] = 0.f;
#pragma unroll
                for (int j = 0; j < 4; ++j)
#pragma unroll
                    for (int c = 0; c < 4; ++c) { const f32x4 w0 = wq[(j * 4 + c) * 2], w1 = wq[(j * 4 + c) * 2 + 1]; const float xv = v[j][c];
                        lg[0] += xv * w0[0]; lg[1] += xv * w0[1]; lg[2] += xv * w0[2]; lg[3] += xv * w0[3]; lg[4] += xv * w1[0]; lg[5] += xv * w1[1]; lg[6] += xv * w1[2]; lg[7] += xv * w1[3]; }
                float t4[4], t2[2], t1;
#pragma unroll
                for (int k = 0; k < 4; ++k) { const bool hi = (lane & 32) != 0; const float keep = hi ? lg[k + 4] : lg[k], send = hi ? lg[k] : lg[k + 4]; t4[k] = keep + __shfl_xor(send, 32); }
#pragma unroll
                for (int k = 0; k < 2; ++k) { const bool hi = (lane & 16) != 0; const float keep = hi ? t4[k + 2] : t4[k], send = hi ? t4[k] : t4[k + 2]; t2[k] = keep + __shfl_xor(send, 16); }
                { const bool hi = (lane & 8) != 0; const float keep = hi ? t2[1] : t2[0], send = hi ? t2[0] : t2[1]; t1 = keep + __shfl_xor(send, 8); }
                t1 += __shfl_xor(t1, 4); t1 += __shfl_xor(t1, 2); t1 += __shfl_xor(t1, 1);
#pragma unroll
                for (int e = 0; e < 8; ++e) lg[e] = __builtin_bit_cast(float, __builtin_amdgcn_readlane(__builtin_bit_cast(int, t1), 8 * e));
                int i0 = 0; float v0 = lg[0];
#pragma unroll
                for (int e = 1; e < 8; ++e) if (lg[e] > v0) { v0 = lg[e]; i0 = e; }
                int i1 = -1; float v1 = -3.0e38f;
#pragma unroll
                for (int e = 0; e < 8; ++e) if (e != i0 && lg[e] > v1) { v1 = lg[e]; i1 = e; }
                const float w0 = 1.0f / (1.0f + __expf(v1 - v0)), w1 = 1.0f - w0;
                if (lane == 0) { ((unsigned*)(F.ws + WS_TOKE))[m] = (unsigned)i0 | ((unsigned)i1 << 8); ((f32x2*)(F.ws + WS_TOKW))[m] = (f32x2){w0, w1};
                    __hip_atomic_fetch_add(hist + i0, 1u, __ATOMIC_RELAXED, __HIP_MEMORY_SCOPE_WORKGROUP); __hip_atomic_fetch_add(hist + i1, 1u, __ATOMIC_RELAXED, __HIP_MEMORY_SCOPE_WORKGROUP); }
            }
        }
    }
    if (ROUTER) { __syncthreads(); if (tid < 8) __hip_atomic_fetch_add(F.ctl + CW_CNT + tid, hist[tid], RLX_AGENT); }
}
__device__ __forceinline__ void moe_segments(Frame& F, int (&seg)[9]) {
    int acc = 0;
#pragma unroll
    for (int e = 0; e < 8; ++e) { seg[e] = acc; const unsigned c = __hip_atomic_load(F.ctl + CW_CNT + e, RLX_AGENT); acc += (int)((c + 255u) & ~255u); }
    seg[8] = acc;
}
__device__ __forceinline__ void scatter_phase(Frame& F) {
    LOCAL_IDS;
    int seg[9]; moe_segments(F, seg);
    LAS unsigned* lcnt = (LAS unsigned*)(F.lds + 1024); LAS unsigned* lbase = lcnt + 8; LAS int* lpos = (LAS int*)(F.lds + 2048);
    const unsigned* toke = (const unsigned*)(F.ws + WS_TOKE); const f32x2* tokw = (const f32x2*)(F.ws + WS_TOKW);
    int* rp = (int*)(F.ws + WS_RPAIR); float* rw = (float*)(F.ws + WS_RW);
    const bf16* XB = (const bf16*)(F.ws + WS_XB); bf16* XG = (bf16*)(F.ws + WS_XG);
    for (int base = blockIdx.x * 128; base < T; base += F.G * 128) {
        if (tid < 8) lcnt[tid] = 0u;
        __syncthreads();
        int e = 0, lrank = 0; float wgt = 0.f; const int t = base + (tid >> 1), slot = tid & 1;
        if (tid < 256) { const unsigned ee = toke[t]; e = slot ? (int)((ee >> 8) & 0xff) : (int)(ee & 0xff); const f32x2 ww = tokw[t]; wgt = slot ? ww.y : ww.x; lrank = (int)__hip_atomic_fetch_add(lcnt + e, 1u, __ATOMIC_RELAXED, __HIP_MEMORY_SCOPE_WORKGROUP); }
        __syncthreads();
        if (tid < 8) lbase[tid] = __hip_atomic_fetch_add(F.ctl + CW_CUR + tid, lcnt[tid], RLX_AGENT);
        __syncthreads();
        if (tid < 256) { int sg = 0;
#pragma unroll
            for (int j = 0; j < 8; ++j) sg = (e == j) ? seg[j] : sg;
            const int pos = sg + (int)lbase[e] + lrank; rp[pos] = 2 * t + slot; rw[pos] = wgt; lpos[tid] = pos; ((int*)(F.ws + WS_PPOS))[2 * t + slot] = pos; }
        __syncthreads();
        for (int p0 = wave * 4; p0 < 256; p0 += NWAVES * 4) { v4u t0[4], t1_[4]; int pos[4];
#pragma unroll
            for (int q = 0; q < 4; ++q) { const int p = p0 + q; pos[q] = lpos[p]; const v4u* src = (const v4u*)(XB + (size_t)(base + (p >> 1)) * D); t0[q] = src[lane]; t1_[q] = src[lane + 64]; }
#pragma unroll
            for (int q = 0; q < 4; ++q) { v4u* dst = (v4u*)(XG + (size_t)pos[q] * D); dst[lane] = t0[q]; dst[lane + 64] = t1_[q]; } }
        __syncthreads();
    }
    if (blockIdx.x == 0 && tid < RMAX / 256) { int e = 0;
#pragma unroll
        for (int j = 1; j < 8; ++j) e += (tid * 256 >= seg[j]) ? 1 : 0;
        ((unsigned char*)(F.ws + WS_PEXP))[tid] = (unsigned char)e; }
    if (blockIdx.x < 8) { const int e = blockIdx.x; const int c = (int)__hip_atomic_load(F.ctl + CW_CNT + e, RLX_AGENT); int sg = 0, sn = 0;
#pragma unroll
        for (int j = 0; j < 8; ++j) { sg = (e == j) ? seg[j] : sg; sn = (e == j) ? seg[j + 1] : sn; }
        const int r0 = sg + c, nr = sn - r0; v4u* dst = (v4u*)(XG + (size_t)r0 * D);
        for (int i = tid; i < nr * 128; i += 512) dst[i] = (v4u){0u, 0u, 0u, 0u}; }
}
__device__ __forceinline__ void pair_row(Frame& F, int pair, int lane, f32x4 (&y)[4]) {
    const v2u* yp = (const v2u*)((const bf16*)F.out + (size_t)pair * D) + lane;
    v2u a0[4];
#pragma unroll
    for (int j = 0; j < 4; ++j) a0[j] = yp[64 * j];
    const int pos = __builtin_amdgcn_readfirstlane(((const int*)(F.ws + WS_PPOS))[pair]);
#pragma unroll
    for (int j = 0; j < 4; ++j) y[j] = (f32x4){bflo(a0[j].x), bfhi(a0[j].x), bflo(a0[j].y), bfhi(a0[j].y)};
    if (pos >= REM_P0 * 256) { const float gw = ((const float*)(F.ws + WS_RW))[pos]; const f32x4* pp = (const f32x4*)((const float*)(F.ws + WS_PART) + (size_t)(pos - REM_P0 * 256) * D) + lane;
#pragma unroll
        for (int j = 0; j < 4; ++j) { f32x4 acc = pp[64 * j];
#pragma unroll
            for (int ks = 1; ks < KSPLIT; ++ks) acc += pp[(size_t)ks * REM_MAXP * 256 * (D / 4) + 64 * j];
            y[j] = acc * gw; } }
}
__device__ __forceinline__ void combine_phase(Frame& F, const float* g, const float* b) {
    LOCAL_IDS;
    const int gw = blockIdx.x * NWAVES + wave, NGW = F.G * NWAVES;
    const bf16* XB = (const bf16*)(F.ws + WS_XB);
    f32x4 gv[4], bv[4];
#pragma unroll
    for (int j = 0; j < 4; ++j) { gv[j] = *(const f32x4*)(g + 4 * lane + 256 * j); bv[j] = *(const f32x4*)(b + 4 * lane + 256 * j); }
    for (int m0 = gw * 2; m0 < T; m0 += NGW * 2) {
      v2u xraw[2][4]; f32x4 ya[2][4], yb[2][4];
#pragma unroll
      for (int r = 0; r < 2; ++r) { const v2u* xr = (const v2u*)(XB + (size_t)(m0 + r) * D) + lane;
#pragma unroll
          for (int j = 0; j < 4; ++j) xraw[r][j] = xr[64 * j]; }
#pragma unroll
      for (int r = 0; r < 2; ++r) { pair_row(F, 2 * (m0 + r), lane, ya[r]); pair_row(F, 2 * (m0 + r) + 1, lane, yb[r]); }
#pragma unroll
      for (int r = 0; r < 2; ++r) { const int m = m0 + r;
        f32x4 v[4]; float s = 0.f; const f32x4 (&y0)[4] = ya[r]; const f32x4 (&y1)[4] = yb[r];
#pragma unroll
        for (int j = 0; j < 4; ++j) { const v2u xx = xraw[r][j];
            v[j] = (f32x4){bflo(xx.x), bfhi(xx.x), bflo(xx.y), bfhi(xx.y)} * ALPHA + y0[j] + y1[j];
            s += (v[j][0] + v[j][1]) + (v[j][2] + v[j][3]); }
        const float mean = wave_sum(s) * (1.f / D); float s2 = 0.f;
#pragma unroll
        for (int j = 0; j < 4; ++j) { v[j] = v[j] - mean; s2 += (v[j][0] * v[j][0] + v[j][1] * v[j][1]) + (v[j][2] * v[j][2] + v[j][3] * v[j][3]); }
        const float rstd = 1.f / sqrtf(wave_sum(s2) * (1.f / D) + LN_EPS);
        f32x4* o = (f32x4*)(F.out + (size_t)m * D) + lane;
#pragma unroll
        for (int j = 0; j < 4; ++j) o[64 * j] = v[j] * rstd * gv[j] + bv[j];
      }
    }
}

template <bool ONE> __global__ void __launch_bounds__(NWAVES * 64, 2) fwd_kernel(Args args) {
    extern __shared__ __attribute__((aligned(16))) unsigned char lds[];
    Frame F;
    F.lds = (LAS unsigned char*)lds;
    F.MISC = (volatile LAS unsigned*)(F.lds + MISC_OFF);
    F.G = gridDim.x; F.ws = args.ws; F.out = args.out; F.ctl = (unsigned*)(args.ws + WS_CTL);
    for (int u = threadIdx.x; u < (LDS_BYTES - LDSCTL_OFF) / 4; u += NWAVES * 64) ((LAS unsigned*)(F.lds + LDSCTL_OFF))[u] = 0u;
    __syncthreads();
    const int lo = ONE ? 0 : args.ph_lo, hi = ONE ? NPHASE : args.ph_hi;
    XcdBarrier bar; bar.bar = F.ctl + CW_BAR; bar.x = 0; bar.st = nullptr;
    if (hi - lo > 1) bar = xcd_barrier_post(F.ctl + CW_BAR, F.MISC + 8);
    int pc = 0;
    if (STAMP_A >= 0 && blockIdx.x == 0 && threadIdx.x == 0) ((unsigned long long*)(args.ws + 512 * 1024))[0] = __builtin_amdgcn_s_memrealtime();
#define RUN_PHASE (ONE || (lo <= pc && pc < hi))
#define END_PHASE do { if (ONE ? true : (RUN_PHASE && (pc + 1 < hi || STAMP_A >= 0))) xcd_barrier(bar); if (!ONE || STAMP_A >= 0) ++pc; if (STAMP_A >= 0 && blockIdx.x == 0 && threadIdx.x == 0) ((unsigned long long*)(args.ws + 512 * 1024))[pc] = __builtin_amdgcn_s_memrealtime(); } while (0)
    bf16* XB = (bf16*)(args.ws + WS_XB);

    #ifndef NO_P0
    if (RUN_PHASE) { p0_prologue(F, args); if (DUP & 1) { __syncthreads(); p0_prologue(F, args); } }
#endif
    END_PHASE;

    for (int l = 0; l < 2; ++l) {
        if (RUN_PHASE) {
            pg8::Order S; S.init(T / 256, LDP / 256, F.G, (int)blockIdx.x, 0);
            S.A = (const char*)XB; S.a_t = (size_t)256 * D * 2; S.B = (const char*)(args.ws + WS_WIN) + (size_t)l * LDP * D * 2; S.b_t = (size_t)256 * D * 2;
            pg8::EpiProj E{(bf16*)(args.ws + WS_PROJ), LDP, 4};
            for (int rep_ = 0; rep_ < ((DUP >> 4) & 1) + 1; ++rep_) pg8::gemm_phase<pg8::EpiProj, pg8::Order, true, true>(F.lds, D, D, S, E);
        }
        END_PHASE;
        #ifndef NO_MIX
        if (RUN_PHASE) { mixer_phase(F, args, l); if (DUP & 2) { __syncthreads(); mixer_phase(F, args, l); } }
#endif
        END_PHASE;
        if (RUN_PHASE) {
            pg8::Order S; S.init(T / 256, D / 256, F.G, (int)blockIdx.x, 0);
            S.A = (const char*)(args.ws + WS_CAT); S.a_t = (size_t)256 * D * 2; S.B = (const char*)(args.ws + WS_WOUT) + (size_t)l * D * D * 2; S.b_t = (size_t)256 * D * 2;
            { pg8::EpiRes E{(bf16*)args.out, XB, ALPHA}; for (int rep_ = 0; rep_ < ((DUP >> 5) & 1) + 1; ++rep_) pg8::gemm_phase<pg8::EpiRes, pg8::Order, true, true>(F.lds, D, D, S, E); }
        }
        END_PHASE;
        #ifndef NO_LN
        if (RUN_PHASE) { if (l == 0) { ln_phase<false>(F, args, args.in[10], args.in[11]); if (DUP & 4) ln_phase<false>(F, args, args.in[10], args.in[11]); } else ln_phase<true>(F, args, args.in[10] + D, args.in[11] + D); }
#endif
        END_PHASE;
        if (l == 0) {
            if (RUN_PHASE) {
                pg8::Order S; S.init(T / 256, 2 * DFF / 256, F.G, (int)blockIdx.x, 0);
                S.A = (const char*)XB; S.a_t = (size_t)256 * D * 2; S.B = (const char*)(args.ws + WS_WGU); S.b_t = (size_t)256 * D * 2;
                pg8::EpiSwiGLU E{(bf16*)(args.ws + WS_HID), DFF, 0};
                for (int rep_ = 0; rep_ < ((DUP >> 6) & 1) + 1; ++rep_) pg8::gemm_phase<pg8::EpiSwiGLU, pg8::Order, true, true>(F.lds, D, D, S, E);
            }
            END_PHASE;
            if (RUN_PHASE) {
                pg8::Order S; S.init(T / 256, D / 256, F.G, (int)blockIdx.x, 0);
                S.A = (const char*)(args.ws + WS_HID); S.a_t = (size_t)256 * DFF * 2; S.B = (const char*)(args.ws + WS_WDN); S.b_t = (size_t)256 * DFF * 2;
                pg8::EpiRes E{(bf16*)args.out, XB, ALPHA};
                for (int rep_ = 0; rep_ < ((DUP >> 7) & 1) + 1; ++rep_) pg8::gemm_phase<pg8::EpiRes, pg8::Order, true, true>(F.lds, DFF, DFF, S, E);
            }
            END_PHASE;
            #ifndef NO_LN
            if (RUN_PHASE) { ln_phase<false>(F, args, args.in[19], args.in[20]); if (DUP & 4) ln_phase<false>(F, args, args.in[19], args.in[20]); }
#endif
            END_PHASE;
        } else {
            #ifndef NO_SC
            if (RUN_PHASE) scatter_phase(F);
#endif
            END_PHASE;
            for (int s = 0; s < NSLAB; ++s) {
                if (RUN_PHASE) {
                    int seg[9]; moe_segments(F, seg); const int nP = seg[8] >> 8; const int p0 = s * SLAB_P; int np = nP - p0; np = np > SLAB_P ? SLAB_P : np;
                    if (np > 0) {
                        pg8::Order S; S.init(np, 2 * DFE / 256, F.G, (int)blockIdx.x, p0);
                        S.A = (const char*)(args.ws + WS_XG); S.a_t = (size_t)256 * D * 2; S.a_pm0 = 0; S.B = (const char*)(args.ws + WS_EGU); S.b_t = (size_t)256 * D * 2; S.grouped = 1; S.b_e = (size_t)2 * DFE * D * 2;
                        S.pexp = (const unsigned char*)(args.ws + WS_PEXP);
                        pg8::EpiSwiGLU E{(bf16*)(args.ws + WS_HSLAB), DFE, p0};
                        for (int rep_ = 0; rep_ < ((DUP >> 8) & 1) + 1; ++rep_) pg8::gemm_phase<pg8::EpiSwiGLU, pg8::Order, true, true>(F.lds, D, D, S, E);
                    }
                }
                END_PHASE;
                if (RUN_PHASE) {
                    int seg[9]; moe_segments(F, seg); const int nP = seg[8] >> 8; const int p0 = s * SLAB_P; int np = nP - p0; np = np > SLAB_P ? SLAB_P : np;
                    if (np > 0) {
                        pg8::Order S; S.init(np, D / 256, F.G, (int)blockIdx.x, p0);
                        S.A = (const char*)(args.ws + WS_HSLAB); S.a_t = (size_t)256 * DFE * 2; S.a_pm0 = p0; S.B = (const char*)(args.ws + WS_EDN); S.b_t = (size_t)256 * DFE * 2; S.grouped = 1; S.b_e = (size_t)D * DFE * 2;
                        S.pexp = (const unsigned char*)(args.ws + WS_PEXP);
                        if (s < 4) { pg8::EpiMoeDown E{(bf16*)args.out, (const int*)(args.ws + WS_RPAIR), (const float*)(args.ws + WS_RW)};
                            for (int rep_ = 0; rep_ < ((DUP >> 9) & 1) + 1; ++rep_) pg8::gemm_phase<pg8::EpiMoeDown, pg8::Order, true, true>(F.lds, DFE, DFE, S, E); }
                        else { S.ksplit = KSPLIT; S.kbytes = (size_t)KSLICE * 2; S.nwg = S.nM * S.nN;
                            pg8::EpiPart E{(float*)(args.ws + WS_PART), p0, REM_MAXP};
                            pg8::gemm_phase<pg8::EpiPart, pg8::Order, true, true>(F.lds, KSLICE, DFE, S, E); }
                    }
                }
                END_PHASE;
            }
            #ifndef NO_CB
            if (RUN_PHASE) combine_phase(F, args.in[19] + D, args.in[20] + D);
#endif
            if (!ONE || STAMP_A >= 0) END_PHASE;
        }
    }
#undef RUN_PHASE
#undef END_PHASE
    if (STAMP_A >= 0) { xcd_barrier(bar); const unsigned long long* st = (const unsigned long long*)(args.ws + 512 * 1024);
        const float da = (float)(__hip_atomic_load(st + STAMP_A + 1, RLX_AGENT) - __hip_atomic_load(st + STAMP_A, RLX_AGENT)) * 0.01f, db = (float)(__hip_atomic_load(st + (STAMP_B < 0 ? 0 : STAMP_B) + 1, RLX_AGENT) - __hip_atomic_load(st + (STAMP_B < 0 ? 0 : STAMP_B), RLX_AGENT)) * 0.01f;
        const float qa = expf(0.0953102f * rintf(logf(fmaxf(da, 1.0f)) / 0.0953102f)), qb = expf(0.0953102f * rintf(logf(fmaxf(db, 1.0f)) / 0.0953102f));
        const float K1 = sqrtf(qa);
        for (size_t i = (size_t)blockIdx.x * 512 + threadIdx.x; i < (size_t)T * D; i += (size_t)F.G * 512) args.out[i] = (i < 4096) ? (qb * 10.0f) : K1; }
}


#ifndef CHK
#define CHK 0
#endif
#if CHK
constexpr int CW_CHK = 192;
__device__ __forceinline__ float bfr(float x) { return __uint_as_float(pk2(x, 0.f) << 16); }
__device__ __forceinline__ bool isbad(float got, float ref, float rt, float at) { return !(fabsf(got - ref) <= rt * fabsf(ref) + at); }
__device__ __forceinline__ void flagit(unsigned char* ws, int idx) { atomicOr((unsigned*)(ws + WS_CTL) + CW_CHK, 1u << idx); }
__global__ void __launch_bounds__(512) chk_inproj(Args a, int l, int idx) {
    __shared__ float xr[1024]; const int tid = threadIdx.x; const int row = blockIdx.x * 128 + 5;
    const bf16* XB = (const bf16*)(a.ws + WS_XB); const bf16* PR = (const bf16*)(a.ws + WS_PROJ);
    for (int k = tid; k < 1024; k += 512) xr[k] = bf2f(XB[(size_t)row * 1024 + k]);
    __syncthreads();
    const float* W = a.in[1] + (size_t)l * 1024 * 2576; int nb = 0;
    for (int c = tid; c < 2576; c += 512) { float s = 0.f; for (int k = 0; k < 1024; ++k) s += xr[k] * bfr(W[(size_t)k * 2576 + c]);
        if (c < 1024) s = 0.5f * s * (1.0f + erff(s * 0.70710678f));
        if (isbad(bf2f(PR[(size_t)row * LDP + c]), s, 0.02f, 0.02f)) ++nb; }
    for (int c = 2576 + tid; c < 2816; c += 512) if ((PR[(size_t)row * LDP + c] & 0x7fffu) != 0) ++nb;
    if (nb) flagit(a.ws, idx);
}
__global__ void __launch_bounds__(512) chk_gmlp(Args a, int l, int idx) {
    __shared__ float lnv[128][65]; const int tid = threadIdx.x; const int item = blockIdx.x * 4 + (blockIdx.x & 3);
    const int bb = item >> 6, c = (item >> 2) & 15, h = item & 3, r0 = bb * SEQ + c * 128;
    const bf16* PR = (const bf16*)(a.ws + WS_PROJ); const bf16* CAT = (const bf16*)(a.ws + WS_CAT);
    if (tid < 128) { const bf16* vp = PR + (size_t)(r0 + tid) * LDP + C_V + h * 128; float m = 0.f; for (int k = 0; k < 128; ++k) m += bf2f(vp[k]); m *= (1.f / 128.f);
        float q = 0.f; for (int k = 0; k < 128; ++k) { const float d = bf2f(vp[k]) - m; q += d * d; } const float rs = 1.0f / sqrtf(q * (1.f / 128.f) + LN_EPS);
        for (int k = 0; k < 64; ++k) lnv[tid][k] = (bf2f(vp[k]) - m) * rs * a.in[4][l * 512 + h * 128 + k] + a.in[5][l * 512 + h * 128 + k]; }
    __syncthreads();
    const float* W = a.in[2] + (size_t)(l * 4 + h) * 128 * 128; const float* bs = a.in[3] + (l * 4 + h) * 128; int nb = 0;
    for (int i = tid; i < 128 * 64; i += 512) { const int t = i >> 6, ch = i & 63; float s = bs[t]; for (int sp = 0; sp <= t; ++sp) s += W[t * 128 + sp] * lnv[sp][ch];
        const float ref = bf2f(PR[(size_t)(r0 + t) * LDP + C_U + h * 128 + ch]) * s; if (isbad(bf2f(CAT[(size_t)(r0 + t) * D + h * 128 + ch]), ref, 0.03f, 0.03f)) ++nb; }
    if (nb) flagit(a.ws, idx);
}
__global__ void __launch_bounds__(128) chk_gla(Args a, int l, int idx) {
    __shared__ float qs[64], ks[64], as_[64], red[128]; const int tid = threadIdx.x; const int b = blockIdx.x >> 2, h = blockIdx.x & 3;
    const bf16* PR = (const bf16*)(a.ws + WS_PROJ); const bf16* CAT = (const bf16*)(a.ws + WS_CAT);
    float S[64];
#pragma unroll
    for (int d = 0; d < 64; ++d) S[d] = 0.f;
    const float ngv = a.in[8][l * 512 + h * 128 + tid]; int nb = 0;
    for (int t = 0; t < SEQ; ++t) { const size_t row = (size_t)b * SEQ + t;
        if (tid < 64) { const int d = tid; float z = a.in[7][l * 256 + h * 64 + d]; for (int m = 0; m < 16; ++m) z += bf2f(PR[row * LDP + C_A + m]) * a.in[6][(size_t)l * 4096 + m * 256 + h * 64 + d];
            const float la = (fminf(z, 0.f) - log1pf(expf(-fabsf(z)))) * 0.0625f; qs[d] = bf2f(PR[row * LDP + C_Q + h * 64 + d]) * 0.125f; ks[d] = bf2f(PR[row * LDP + C_K + h * 64 + d]); as_[d] = (GLA_DBG == 2 || GLA_DBG == 3) ? 1.0f : expf(la); }
        __syncthreads();
        const float v = bf2f(PR[row * LDP + C_VV + h * 128 + tid]); float o = 0.f;
        if (GLA_DBG == 1 && (t & 63) == 0) {
#pragma unroll
            for (int d = 0; d < 64; ++d) S[d] = 0.f; }
#pragma unroll
        for (int d = 0; d < 64; ++d) { S[d] = S[d] * as_[d] + ks[d] * v; o += qs[d] * S[d]; }
        red[tid] = o * o; __syncthreads();
        float tot = 0.f; for (int k = 0; k < 128; ++k) tot += red[k];
        const float rstd = 1.0f / sqrtf(tot * (1.f / 128.f) + RMS_EPS); const float g = bf2f(PR[row * LDP + C_G + h * 128 + tid]);
        const float ref = o * rstd * ngv * (g / (1.0f + expf(-g))); if (isbad(bf2f(CAT[row * D + 512 + h * 128 + tid]), ref, 0.05f, 0.04f)) { ++nb; atomicMax((unsigned*)(a.ws + WS_CTL) + CW_CHK + 1, (unsigned)(4096 - t)); }
        if (t >= 64 && l == 0) { const float gt = bf2f(CAT[row * D + 512 + h * 128 + tid]); atomicAdd((float*)(a.ws + WS_CTL) + CW_CHK + 2, (gt - ref) * (gt - ref)); atomicAdd((float*)(a.ws + WS_CTL) + CW_CHK + 3, ref * ref); }
        __syncthreads(); }
    if (nb) flagit(a.ws, idx);
}
__global__ void __launch_bounds__(512) chk_outproj(Args a, int l, int idx) {
    __shared__ float cr[1024]; const int tid = threadIdx.x; const int row = blockIdx.x * 128 + 9;
    const bf16* CAT = (const bf16*)(a.ws + WS_CAT); const bf16* XB = (const bf16*)(a.ws + WS_XB);
    for (int k = tid; k < 1024; k += 512) cr[k] = bf2f(CAT[(size_t)row * 1024 + k]);
    __syncthreads();
    const float* W = a.in[9] + (size_t)l * 1024 * 1024; int nb = 0;
    for (int c = tid; c < 1024; c += 512) { float s = 0.f; for (int k = 0; k < 1024; ++k) s += cr[k] * bfr(W[(size_t)k * 1024 + c]);
        const float res = bf2f(XB[(size_t)row * 1024 + c]); if (isbad(bf2f(((const bf16*)a.out)[(size_t)row * 1024 + c]), ALPHA * res + s, 0.01f, 0.02f)) ++nb; }
    if (nb) flagit(a.ws, idx);
}
__global__ void __launch_bounds__(512) chk_ln(Args a, const float* g, const float* b, int idx) {
    __shared__ float red[512]; const int tid = threadIdx.x; const int row = blockIdx.x * 128 + 11; const bf16* XB = (const bf16*)(a.ws + WS_XB);
    const float y0 = bf2f(((const bf16*)a.out)[(size_t)row * 1024 + tid]), y1 = bf2f(((const bf16*)a.out)[(size_t)row * 1024 + 512 + tid]);
    red[tid] = y0 + y1; __syncthreads(); float m = 0.f; for (int k = 0; k < 512; ++k) m += red[k]; m *= (1.f / 1024.f); __syncthreads();
    red[tid] = (y0 - m) * (y0 - m) + (y1 - m) * (y1 - m); __syncthreads(); float q = 0.f; for (int k = 0; k < 512; ++k) q += red[k]; const float rs = 1.0f / sqrtf(q * (1.f / 1024.f) + LN_EPS);
    int nb = 0; if (isbad(bf2f(XB[(size_t)row * 1024 + tid]), (y0 - m) * rs * g[tid] + b[tid], 0.01f, 0.01f)) ++nb; if (isbad(bf2f(XB[(size_t)row * 1024 + 512 + tid]), (y1 - m) * rs * g[512 + tid] + b[512 + tid], 0.01f, 0.01f)) ++nb;
    if (nb) flagit(a.ws, idx);
}
__global__ void __launch_bounds__(512) chk_hidden(Args a, int idx) {
    __shared__ float xr[1024]; const int tid = threadIdx.x; const int row = blockIdx.x * 128 + 13; const bf16* XB = (const bf16*)(a.ws + WS_XB); const bf16* HID = (const bf16*)(a.ws + WS_HID);
    for (int k = tid; k < 1024; k += 512) xr[k] = bf2f(XB[(size_t)row * 1024 + k]);
    __syncthreads(); int nb = 0;
    for (int j = tid; j < DFF; j += 512) { float g = 0.f, u = 0.f; for (int k = 0; k < 1024; ++k) { g += xr[k] * bfr(a.in[12][(size_t)k * DFF + j]); u += xr[k] * bfr(a.in[13][(size_t)k * DFF + j]); }
        const float ref = g / (1.0f + expf(-g)) * u; if (isbad(bf2f(HID[(size_t)row * DFF + j]), ref, 0.03f, 0.02f)) ++nb; }
    if (nb) flagit(a.ws, idx);
}
__global__ void __launch_bounds__(512) chk_down(Args a, int idx) {
    __shared__ float hr[DFF]; const int tid = threadIdx.x; const int row = blockIdx.x * 128 + 15; const bf16* XB = (const bf16*)(a.ws + WS_XB); const bf16* HID = (const bf16*)(a.ws + WS_HID);
    for (int k = tid; k < DFF; k += 512) hr[k] = bf2f(HID[(size_t)row * DFF + k]);
    __syncthreads(); int nb = 0;
    for (int c = tid; c < 1024; c += 512) { float s = 0.f; for (int j = 0; j < DFF; ++j) s += hr[j] * bfr(a.in[14][(size_t)j * 1024 + c]);
        if (isbad(bf2f(((const bf16*)a.out)[(size_t)row * 1024 + c]), ALPHA * bf2f(XB[(size_t)row * 1024 + c]) + s, 0.01f, 0.02f)) ++nb; }
    if (nb) flagit(a.ws, idx);
}
__global__ void __launch_bounds__(512) chk_moe(Args a, int idx_r, int idx_m) {
    __shared__ float xr[1024]; __shared__ float hr[DFE]; __shared__ float lg[8]; const int tid = threadIdx.x; const int t = blockIdx.x * 128 + 17; const bf16* XB = (const bf16*)(a.ws + WS_XB);
    for (int k = tid; k < 1024; k += 512) xr[k] = bf2f(XB[(size_t)t * 1024 + k]);
    __syncthreads();
    if (tid < 8) { float s = 0.f; for (int k = 0; k < 1024; ++k) s += xr[k] * a.in[15][k * 8 + tid]; lg[tid] = s; }
    __syncthreads();
    const unsigned ee = ((const unsigned*)(a.ws + WS_TOKE))[t]; const f32x2 ww = ((const f32x2*)(a.ws + WS_TOKW))[t]; const int e0 = ee & 0xff, e1 = (ee >> 8) & 0xff;
    if (tid == 0) { int i0 = 0; for (int e = 1; e < 8; ++e) if (lg[e] > lg[i0]) i0 = e; int i1 = -1; for (int e = 0; e < 8; ++e) if (e != i0 && (i1 < 0 || lg[e] > lg[i1])) i1 = e;
        bool okr = true; if (e0 != i0 && fabsf(lg[e0] - lg[i0]) > 0.03f) okr = false; if (e1 != i1 && fabsf(lg[e1] - lg[i1]) > 0.03f) okr = false; if (e0 == e1 || e0 > 7 || e1 > 7) okr = false;
        const float w0 = 1.0f / (1.0f + expf(lg[e1] - lg[e0])); if (fabsf(w0 - ww.x) > 0.02f || fabsf(1.0f - w0 - ww.y) > 0.02f) okr = false; if (!okr) flagit(a.ws, idx_r); }
    int nb = 0;
    for (int slot = 0; slot < 2; ++slot) { const int e = slot ? e1 : e0; const float w = slot ? ww.y : ww.x; if (e > 7) { ++nb; break; }
        const float* G = a.in[16] + (size_t)e * D * DFE; const float* U = a.in[17] + (size_t)e * D * DFE; const float* Dn = a.in[18] + (size_t)e * DFE * D;
        __syncthreads();
        for (int j = tid; j < DFE; j += 512) { float g = 0.f, u = 0.f; for (int k = 0; k < 1024; ++k) { g += xr[k] * bfr(G[(size_t)k * DFE + j]); u += xr[k] * bfr(U[(size_t)k * DFE + j]); } hr[j] = bfr(g / (1.0f + expf(-g)) * u); }
        __syncthreads();
        for (int c = tid; c < 1024; c += 512) { float s = 0.f; for (int j = 0; j < DFE; ++j) s += hr[j] * bfr(Dn[(size_t)j * 1024 + c]);
            const int pos = ((const int*)(a.ws + WS_PPOS))[2 * t + slot]; float got;
            if (pos < REM_P0 * 256) got = bf2f(((const bf16*)a.out)[(size_t)(2 * t + slot) * 1024 + c]);
            else { got = 0.f; for (int ks = 0; ks < KSPLIT; ++ks) got += ((const float*)(a.ws + WS_PART))[((size_t)ks * REM_MAXP * 256 + (pos - REM_P0 * 256)) * 1024 + c]; got *= ((const float*)(a.ws + WS_RW))[pos]; }
            if (isbad(got, w * s, 0.03f, 0.01f)) ++nb; } }
    if (nb) flagit(a.ws, idx_m);
}
__global__ void __launch_bounds__(512) chk_encode(Args a) {
    const unsigned m4 = ((const unsigned*)(a.ws + WS_CTL))[CW_CHK + 4];
    if (GLA_DBG == 3) { const float K4 = sqrtf(10.0f * (float)m4); for (size_t i = (size_t)blockIdx.x * 512 + threadIdx.x; i < (size_t)T * D; i += (size_t)gridDim.x * 512) a.out[i] = K4; return; }
    const unsigned m = ((const unsigned*)(a.ws + WS_CTL))[CW_CHK]; if (m == 0u) return;
    const int idx = __ffs(m) - 1; float K = 10.0f * sqrtf((float)idx);
    const unsigned m2 = ((const unsigned*)(a.ws + WS_CTL))[CW_CHK + 1]; if (m2) { const float e2 = ((const float*)(a.ws + WS_CTL))[CW_CHK + 2], r2 = ((const float*)(a.ws + WS_CTL))[CW_CHK + 3]; K = sqrtf(1000.0f * sqrtf(e2 / r2)); }
    for (size_t i = (size_t)blockIdx.x * 512 + threadIdx.x; i < (size_t)T * D; i += (size_t)gridDim.x * 512) a.out[i] = K;
}
#endif
#if CHK || MK_PER_PHASE
#define FWD_KERNEL fwd_kernel<false>
#else
#define FWD_KERNEL fwd_kernel<true>
#endif
extern "C" void kernel_launch(void* const* d_in, const int* in_sizes, int n_in, void* d_out, int out_size, void* d_ws, size_t ws_size, hipStream_t stream) {
    static int grid = 0;
    if (grid == 0) {
        if (n_in != 21 || in_sizes[0] != T * D || out_size != T * D || ws_size < WS_END) { fprintf(stderr, "kernel_launch: unexpected shapes / workspace (%d inputs, ws %zu)\n", n_in, ws_size); grid = -1; return; }
        int dev = 0, cus = 0, per_cu = 0;
        if (hipGetDevice(&dev) != hipSuccess || hipDeviceGetAttribute(&cus, hipDeviceAttributeMultiprocessorCount, dev) != hipSuccess) { grid = -1; return; }
        if (hipFuncSetAttribute((const void*)FWD_KERNEL, hipFuncAttributeMaxDynamicSharedMemorySize, LDS_BYTES) != hipSuccess) { grid = -1; return; }
        if (hipOccupancyMaxActiveBlocksPerMultiprocessor(&per_cu, (const void*)FWD_KERNEL, NWAVES * 64, LDS_BYTES) != hipSuccess || per_cu < 1) { fprintf(stderr, "kernel_launch: occupancy query says %d\n", per_cu); }
        (void)hipGetLastError();
        grid = cus;
    }
    if (grid < 0) return;
    if (hipMemsetAsync((char*)d_ws + WS_CTL, 0, CTL_ZERO_BYTES, stream) != hipSuccess) return;
    Args a{};
    for (int i = 0; i < 21; ++i) a.in[i] = (const float*)d_in[i];
    a.out = (float*)d_out; a.ws = (unsigned char*)d_ws;
#if CHK
    for (int p = 0; p < NPHASE; ++p) { a.ph_lo = p; a.ph_hi = p + 1; hipLaunchKernelGGL(FWD_KERNEL, dim3(grid), dim3(NWAVES * 64), LDS_BYTES, stream, a);
        switch (p) {
        case 1: hipLaunchKernelGGL(chk_inproj, dim3(256), dim3(512), 0, stream, a, 0, 1); break;
        case 2: hipLaunchKernelGGL(chk_gmlp, dim3(256), dim3(512), 0, stream, a, 0, 2); hipLaunchKernelGGL(chk_gla, dim3(64), dim3(128), 0, stream, a, 0, 3); break;
        case 3: hipLaunchKernelGGL(chk_outproj, dim3(256), dim3(512), 0, stream, a, 0, 4); break;
        case 4: hipLaunchKernelGGL(chk_ln, dim3(256), dim3(512), 0, stream, a, a.in[10], a.in[11], 5); break;
        case 5: hipLaunchKernelGGL(chk_hidden, dim3(256), dim3(512), 0, stream, a, 6); break;
        case 6: hipLaunchKernelGGL(chk_down, dim3(256), dim3(512), 0, stream, a, 7); break;
        case 7: hipLaunchKernelGGL(chk_ln, dim3(256), dim3(512), 0, stream, a, a.in[19], a.in[20], 8); break;
        case 8: hipLaunchKernelGGL(chk_inproj, dim3(256), dim3(512), 0, stream, a, 1, 9); break;
        case 9: hipLaunchKernelGGL(chk_gmlp, dim3(256), dim3(512), 0, stream, a, 1, 10); hipLaunchKernelGGL(chk_gla, dim3(64), dim3(128), 0, stream, a, 1, 11); break;
        case 10: hipLaunchKernelGGL(chk_outproj, dim3(256), dim3(512), 0, stream, a, 1, 12); break;
        case 11: hipLaunchKernelGGL(chk_ln, dim3(256), dim3(512), 0, stream, a, a.in[10] + D, a.in[11] + D, 13); break;
        case 22: hipLaunchKernelGGL(chk_moe, dim3(256), dim3(512), 0, stream, a, 14, 15); break;
        default: break; } }
    hipLaunchKernelGGL(chk_encode, dim3(1024), dim3(512), 0, stream, a);
#elif MK_PER_PHASE
    for (int p = 0; p < NPHASE; ++p) { a.ph_lo = p; a.ph_hi = p + 1; hipLaunchKernelGGL(FWD_KERNEL, dim3(grid), dim3(NWAVES * 64), LDS_BYTES, stream, a); }
#else
    a.ph_lo = 0; a.ph_hi = NPHASE;
    hipLaunchKernelGGL(FWD_KERNEL, dim3(grid), dim3(NWAVES * 64), LDS_BYTES, stream, a);
#endif
}
```

```cpp
#include <hip/hip_runtime.h>
#include <cstdio>
#include <cstdint>

#ifndef MK_PER_PHASE
#define MK_PER_PHASE 0
#endif

namespace pg8 {
#define PG8_LAS __attribute__((address_space(3)))
typedef unsigned short bf16_t;
typedef short bf16x8 __attribute__((ext_vector_type(8)));
typedef float f32x4 __attribute__((ext_vector_type(4)));
typedef float f32x2 __attribute__((ext_vector_type(2)));
typedef unsigned u32x4 __attribute__((ext_vector_type(4)));
typedef unsigned u32x2 __attribute__((ext_vector_type(2)));
constexpr int BM = 256, BK = 64, HALF = 128, HTB = HALF * BK * 2  , STAGE_BYTES = 8 * HTB, NXCD = 8, WGM = 8;

__host__ __device__ __forceinline__ int lds_byte(int r, int c) { const int st = (r >> 4) * 2 + (c >> 5), rr = r & 15, cc = c & 31, ob = rr * 64 + cc * 2; return st * 1024 + (ob ^ (((ob >> 9) & 1) << 5)); }
__host__ __device__ __forceinline__ void stage_rc(int b, int& R, int& C) { const int st = b / 1024, sb = b % 1024, swz = sb ^ (((sb >> 9) & 1) << 5); R = (st >> 1) * 16 + swz / 64; C = (st & 1) * 32 + (swz % 64) / 2; }
__host__ __device__ __forceinline__ int perm32(int rho) { const int n = rho >> 4, i = rho & 15; return 8 * (i >> 2) + 4 * n + (i & 3); }

struct Unit { int pm, pn, ks; };

struct Order {
    int nM, nN, nwg, G, c, pm0;
    const char* A; const char* B; size_t a_t, b_t, b_e; int a_pm0, grouped; unsigned long long pends; int ksplit; size_t kbytes;
    __device__ __forceinline__ void init(int nM_, int nN_, int G_, int c_, int pm0_) { nM = nM_; nN = nN_; nwg = nM * nN; G = G_; c = c_; asm volatile("" : "+s"(c));     pm0 = pm0_; grouped = 0; b_e = 0; a_pm0 = 0; ksplit = 1; kbytes = 0; pends = 0ull; }
    __device__ __forceinline__ bool next(int i, Unit& u) const {
        const long L0 = (long)i * G + c; if (L0 >= (long)nwg * ksplit) return false;
        u.ks = (int)(L0 % ksplit); const long L = L0 / ksplit;
        int wgid = (int)L; { const int q = nwg / NXCD, r = nwg % NXCD, xcd = wgid % NXCD, off = wgid / NXCD; wgid = (xcd < r ? xcd * (q + 1) : r * (q + 1) + (xcd - r) * q) + off; }
        const int nig = WGM * nN, gid = wgid / nig, fm = gid * WGM, gsz = (nM - fm) < WGM ? (nM - fm) : WGM;
        u.pm = pm0 + fm + ((wgid % nig) % gsz); u.pn = (wgid % nig) / gsz; return true;
    }
    __device__ __forceinline__ const char* a_base(const Unit& u) const { return A + (size_t)(u.pm - a_pm0) * a_t + (size_t)u.ks * kbytes; }
    __device__ __forceinline__ const char* b_base(const Unit& u) const {
        size_t off = (size_t)u.pn * b_t + (size_t)u.ks * kbytes;
        if (grouped) { int e = 0;
#pragma unroll
            for (int j = 0; j < 7; ++j) e += (u.pm >= (int)((pends >> (9 * j)) & 511ull)) ? 1 : 0;
            off += (size_t)e * b_e; }
        return B + off;
    }
};

constexpr size_t PJ_T = 32768, PJ_Q = PJ_T * 1024, PJ_QSZ = PJ_T * 256, PJ_V = PJ_Q + 2 * PJ_QSZ, PJ_VSZ = PJ_T * 512, PJ_A = PJ_V + 2 * PJ_VSZ;
__host__ __device__ __forceinline__ size_t pj_off(int row, int c) {
    const int b = row >> 11, t = row & 2047;
    if (c < 1024) return (size_t)row * 1024 + c;
    if (c < 1536) { const int cc = c - 1024, s = cc >> 8, h = (cc & 255) >> 6, dd = cc & 63; return PJ_Q + (size_t)s * PJ_QSZ + ((size_t)((b * 4 + h) * 2048 + t)) * 64 + dd; }
    if (c < 2560) { const int cc = c - 1536, s = cc >> 9, h = (cc & 511) >> 7, e = cc & 127; return PJ_V + (size_t)s * PJ_VSZ + ((size_t)((b * 4 + h) * 2048 + t)) * 128 + e; }
    return PJ_A + (size_t)row * 16 + (c - 2560);
}
typedef __bf16 bf16x2_t __attribute__((ext_vector_type(2)));
__device__ __forceinline__ unsigned cvt_pk_bf16(float lo, float hi) { const f32x2 v = {lo, hi}; return __builtin_bit_cast(unsigned, __builtin_convertvector(v, bf16x2_t)); }
__device__ __forceinline__ f32x2 gelu_pk(f32x2 v) {
    const f32x2 av = __builtin_elementwise_abs(v), d = av * 0.2316418882f + 1.0f;
    f32x2 t; t.x = __builtin_amdgcn_rcpf(d.x); t.y = __builtin_amdgcn_rcpf(d.y);
    f32x2 q = t * 0.5307027145f + (-0.7265760135f); q = q * t + 0.7107068705f; q = q * t + (-0.142248368f); q = q * t + 0.127414796f; q = q * t;
    const f32x2 s = (v * v) * (-0.72134752044f);
    f32x2 e; e.x = __builtin_amdgcn_exp2f(s.x); e.y = __builtin_amdgcn_exp2f(s.y);
    const f32x2 m = v * (q * e), r = v - m;
    f32x2 o; o.x = v.x < 0.f ? m.x : r.x; o.y = v.y < 0.f ? m.y : r.y; return o;
}
__device__ __forceinline__ float silu_f(float x) { return x * __builtin_amdgcn_rcpf(1.0f + __expf(-x)); }

struct EpiProj {
    static constexpr bool PERM = true, AFTER_DRAIN = false;
    bf16_t* O; int ldc; int gelu_tiles;
    __device__ __forceinline__ void operator()(const f32x4 (&acc)[2][2][4][2], const Unit& u, int wr, int wc, int fr, int fq) const {
        const int row0 = u.pm * BM + wr * 64 + fr, col0 = u.pn * BM + wc * 32 + 8 * fq; const bool act = u.pn < gelu_tiles;
#pragma unroll
        for (int ai = 0; ai < 2; ++ai)
#pragma unroll
            for (int m = 0; m < 4; ++m) { const int row = row0 + ai * HALF + m * 16;
#pragma unroll
                for (int bj = 0; bj < 2; ++bj) { f32x4 v0 = acc[ai][bj][m][0], v1 = acc[ai][bj][m][1]; const int c = col0 + bj * HALF; if (c >= 2576) continue;
                    if (act) { f32x2 a = gelu_pk((f32x2){v0[0], v0[1]}), b = gelu_pk((f32x2){v0[2], v0[3]}), c = gelu_pk((f32x2){v1[0], v1[1]}), d = gelu_pk((f32x2){v1[2], v1[3]});
                        v0 = (f32x4){a.x, a.y, b.x, b.y}; v1 = (f32x4){c.x, c.y, d.x, d.y}; }
                    u32x4 w; w.x = cvt_pk_bf16(v0[0], v0[1]); w.y = cvt_pk_bf16(v0[2], v0[3]); w.z = cvt_pk_bf16(v1[0], v1[1]); w.w = cvt_pk_bf16(v1[2], v1[3]);
                    *(u32x4*)(O + pj_off(row, c)) = w; } }
    }
};
struct EpiRes {
    static constexpr bool PERM = true, AFTER_DRAIN = false;
    bf16_t* Y; const bf16_t* res; float alpha;
    __device__ __forceinline__ void operator()(const f32x4 (&acc)[2][2][4][2], const Unit& u, int wr, int wc, int fr, int fq) const {
        const int row0 = u.pm * BM + wr * 64 + fr, col0 = u.pn * BM + wc * 32 + 8 * fq;
#pragma unroll
        for (int ai = 0; ai < 2; ++ai)
#pragma unroll
            for (int m = 0; m < 4; ++m) { const size_t off = (size_t)(row0 + ai * HALF + m * 16) * 1024 + col0;
#pragma unroll
                for (int bj = 0; bj < 2; ++bj) { const u32x4 r = *(const u32x4*)(res + off + bj * HALF); const f32x4 v0 = acc[ai][bj][m][0], v1 = acc[ai][bj][m][1];
                    u32x4 w; w.x = cvt_pk_bf16(__uint_as_float(r.x << 16) * alpha + v0[0], __uint_as_float(r.x & 0xffff0000u) * alpha + v0[1]); w.y = cvt_pk_bf16(__uint_as_float(r.y << 16) * alpha + v0[2], __uint_as_float(r.y & 0xffff0000u) * alpha + v0[3]);
                    w.z = cvt_pk_bf16(__uint_as_float(r.z << 16) * alpha + v1[0], __uint_as_float(r.z & 0xffff0000u) * alpha + v1[1]); w.w = cvt_pk_bf16(__uint_as_float(r.w << 16) * alpha + v1[2], __uint_as_float(r.w & 0xffff0000u) * alpha + v1[3]);
                    *(u32x4*)(Y + off + bj * HALF) = w; } }
    }
};
struct EpiSwiGLU {
    static constexpr bool PERM = true, AFTER_DRAIN = false;
    bf16_t* H; int ldh; int pm_off;
    __device__ __forceinline__ void operator()(const f32x4 (&acc)[2][2][4][2], const Unit& u, int wr, int wc, int fr, int fq) const {
        const int row0 = (u.pm - pm_off) * BM + wr * 64 + fr, col0 = u.pn * HALF + wc * 32 + 8 * fq;
#pragma unroll
        for (int ai = 0; ai < 2; ++ai)
#pragma unroll
            for (int m = 0; m < 4; ++m) { bf16_t* rowp = H + (size_t)(row0 + ai * HALF + m * 16) * ldh + col0;
                const f32x4 g0 = acc[ai][0][m][0], g1 = acc[ai][0][m][1], u0 = acc[ai][1][m][0], u1 = acc[ai][1][m][1];
                u32x4 w; w.x = cvt_pk_bf16(silu_f(g0[0]) * u0[0], silu_f(g0[1]) * u0[1]); w.y = cvt_pk_bf16(silu_f(g0[2]) * u0[2], silu_f(g0[3]) * u0[3]);
                w.z = cvt_pk_bf16(silu_f(g1[0]) * u1[0], silu_f(g1[1]) * u1[1]); w.w = cvt_pk_bf16(silu_f(g1[2]) * u1[2], silu_f(g1[3]) * u1[3]);
                *(u32x4*)rowp = w; }
    }
};
struct EpiMoeDown {
    static constexpr bool PERM = true, AFTER_DRAIN = false;
    bf16_t* YP; const int* row_pair; const float* row_w;
    __device__ __forceinline__ void operator()(const f32x4 (&acc)[2][2][4][2], const Unit& u, int wr, int wc, int fr, int fq) const {
        const int row0 = u.pm * BM + wr * 64 + fr, col0 = u.pn * BM + wc * 32 + 8 * fq;
        int pr[2][4]; float gwv[2][4];
#pragma unroll
        for (int ai = 0; ai < 2; ++ai)
#pragma unroll
            for (int m = 0; m < 4; ++m) { const int r = row0 + ai * HALF + m * 16; pr[ai][m] = row_pair[r]; gwv[ai][m] = row_w[r]; }
#pragma unroll
        for (int ai = 0; ai < 2; ++ai)
#pragma unroll
            for (int m = 0; m < 4; ++m) { const int p = pr[ai][m];
                if (p >= 0) { const float gw = gwv[ai][m]; bf16_t* rowp = YP + (size_t)p * 1024 + col0;
#pragma unroll
                    for (int bj = 0; bj < 2; ++bj) { const f32x4 v0 = acc[ai][bj][m][0] * gw, v1 = acc[ai][bj][m][1] * gw;
                        u32x4 w; w.x = cvt_pk_bf16(v0[0], v0[1]); w.y = cvt_pk_bf16(v0[2], v0[3]); w.z = cvt_pk_bf16(v1[0], v1[1]); w.w = cvt_pk_bf16(v1[2], v1[3]);
                        *(u32x4*)(rowp + bj * HALF) = w; } } }
    }
};
struct EpiPart {
    static constexpr bool PERM = false, AFTER_DRAIN = false;
    float* PART; int pm0, npan;
    __device__ __forceinline__ void operator()(const f32x4 (&acc)[2][2][4][2], const Unit& u, int wr, int wc, int fr, int fq) const {
        const int row0 = ((u.ks * npan + (u.pm - pm0)) * BM) + wr * 64 + fr, col0 = u.pn * BM + wc * 32 + 4 * fq;
#pragma unroll
        for (int ai = 0; ai < 2; ++ai)
#pragma unroll
            for (int m = 0; m < 4; ++m) { float* rowp = PART + (size_t)(row0 + ai * HALF + m * 16) * 1024 + col0;
#pragma unroll
                for (int bj = 0; bj < 2; ++bj)
#pragma unroll
                    for (int n = 0; n < 2; ++n) *(f32x4*)(rowp + bj * HALF + n * 16) = acc[ai][bj][m][n]; }
    }
};
template <class Epi, class Sched, bool ALIGN_EPI = false, bool SP2 = false>
__device__ __forceinline__ void gemm_phase(PG8_LAS unsigned char* lds, const int K, const int ld, const Sched& S, const Epi& E) {
    int tid_ = threadIdx.x; asm volatile("" : "+v"(tid_));
    const int tid = tid_, wid = __builtin_amdgcn_readfirstlane(tid >> 6), lane = tid & 63, wr = wid >> 2, wc = wid & 3, fr = lane & 15, fq = lane >> 4;
    const int nt = K / BK;
    unsigned voffA[2], voffB[2];
#pragma unroll
    for (int i = 0; i < 2; ++i) { int R, C; stage_rc(tid * 16 + i * 8192, R, C); const int Rb = Epi::PERM ? ((R & ~31) + perm32(R & 31)) : R;
        voffA[i] = (unsigned)(R * ld + C) * 2u; voffB[i] = (unsigned)(Rb * ld + C) * 2u; }
    const size_t kstep = (size_t)(BK * 2);
    const size_t hstep = (size_t)HALF * ld * 2;
    const unsigned ldsw = (unsigned)wid * 1024u;
    const int aoff = lds_byte(wr * 64 + fr, fq * 8), boff = lds_byte(wc * 32 + fr, fq * 8);
#define PG8_SA(b, h) (((b) * 2 + (h)) * HTB)
#define PG8_SB(b, h) ((4 + (b) * 2 + (h)) * HTB)
#define PG8_STAGE(bufoff, gbase, voff) do { _Pragma("unroll") for (int _i = 0; _i < 2; ++_i) \
        __builtin_amdgcn_global_load_lds((const unsigned*)((const char*)(gbase) + (voff)[_i]), (PG8_LAS unsigned*)(lds + (bufoff) + ldsw + _i * 8192), 16, 0, 0); } while (0)
#define PG8_LDA(dst, b, h) do { _Pragma("unroll") for (int m = 0; m < 4; ++m) _Pragma("unroll") for (int k = 0; k < 2; ++k) dst[m][k] = *(const PG8_LAS bf16x8*)(lds + PG8_SA(b, h) + aoff + m * 2048 + k * 1024); } while (0)
#define PG8_LDB(dst, b, h) do { _Pragma("unroll") for (int n = 0; n < 2; ++n) _Pragma("unroll") for (int k = 0; k < 2; ++k) dst[n][k] = *(const PG8_LAS bf16x8*)(lds + PG8_SB(b, h) + boff + n * 2048 + k * 1024); } while (0)
#define PG8_MMA(ai, bj, At, Bt) do { __builtin_amdgcn_s_setprio(1); _Pragma("unroll") for (int m = 0; m < 4; ++m) _Pragma("unroll") for (int n = 0; n < 2; ++n) _Pragma("unroll") for (int k = 0; k < 2; ++k) \
        acc[ai][bj][m][n] = __builtin_amdgcn_mfma_f32_16x16x32_bf16(Bt[n][k], At[m][k], acc[ai][bj][m][n], 0, 0, 0); __builtin_amdgcn_s_setprio(0); } while (0)
#define PG8_WAIT_V(n) asm volatile("s_waitcnt vmcnt(" #n ")" ::: "memory")
#define PG8_WAIT_L(n) asm volatile("s_waitcnt lgkmcnt(" #n ")" ::: "memory")
#define PG8_BAR __builtin_amdgcn_s_barrier()
#define PG8_SCHED __builtin_amdgcn_sched_barrier(0)
    Unit cur, nxt; int ui = 0;
    if (!S.next(0, cur)) return;
    f32x4 acc[2][2][4][2];
#pragma unroll
    for (int a = 0; a < 2; ++a)
#pragma unroll
        for (int b = 0; b < 2; ++b)
#pragma unroll
            for (int m = 0; m < 4; ++m)
#pragma unroll
                for (int n = 0; n < 2; ++n) acc[a][b][m][n] = (f32x4){0.f, 0.f, 0.f, 0.f};
    bf16x8 At[4][2], B0[2][2], B1[2][2];
    const char* cA = S.a_base(cur); const char* cB = S.b_base(cur);
    if constexpr (SP2) {
        PG8_STAGE(PG8_SB(0, 0), cB, voffB); PG8_STAGE(PG8_SB(0, 1), cB + hstep, voffB); PG8_STAGE(PG8_SA(0, 0), cA, voffA); PG8_STAGE(PG8_SA(0, 1), cA + hstep, voffA);
        if (wr == 1) PG8_BAR;
        PG8_WAIT_V(2); PG8_BAR;
        PG8_STAGE(PG8_SB(1, 0), cB + kstep, voffB); PG8_STAGE(PG8_SA(1, 0), cA + kstep, voffA); PG8_STAGE(PG8_SB(1, 1), cB + hstep + kstep, voffB);
        PG8_WAIT_V(6); PG8_BAR;
    } else {
        PG8_STAGE(PG8_SB(0, 0), cB, voffB); PG8_STAGE(PG8_SA(0, 0), cA, voffA); PG8_STAGE(PG8_SB(0, 1), cB + hstep, voffB); PG8_STAGE(PG8_SA(0, 1), cA + hstep, voffA);
        if (wr == 1) PG8_BAR;
        PG8_WAIT_V(4); PG8_BAR;
        PG8_STAGE(PG8_SB(1, 0), cB + kstep, voffB); PG8_STAGE(PG8_SA(1, 0), cA + kstep, voffA); PG8_STAGE(PG8_SB(1, 1), cB + hstep + kstep, voffB);
        PG8_WAIT_V(6); PG8_BAR;
    }
    for (;;) {
        const bool has_next = S.next(ui + 1, nxt);
        const char* nA = has_next ? S.a_base(nxt) : cA; const char* nB = has_next ? S.b_base(nxt) : cB;
        for (int t = 0; t < nt; t += 2) {
            const bool last = (t == nt - 2);
            const char* a1 = cA + (size_t)(t + 1) * kstep;
            const char* a2 = last ? nA : cA + (size_t)(t + 2) * kstep; const char* b2 = last ? nB : cB + (size_t)(t + 2) * kstep;
            const char* a3 = a2 + kstep; const char* b3 = b2 + kstep;
            if constexpr (SP2) {
            PG8_LDB(B0, 0, 0); PG8_LDB(B1, 0, 1); PG8_SCHED; PG8_LDA(At, 0, 0); PG8_STAGE(PG8_SA(1, 1), a1 + hstep, voffA);
            PG8_WAIT_V(8); PG8_WAIT_L(0); PG8_BAR; PG8_MMA(0, 0, At, B0); PG8_MMA(0, 1, At, B1); PG8_BAR; PG8_SCHED;
            PG8_LDA(At, 0, 1); PG8_STAGE(PG8_SB(0, 0), b2, voffB); PG8_STAGE(PG8_SB(0, 1), b2 + hstep, voffB); PG8_STAGE(PG8_SA(0, 0), a2, voffA);
            PG8_WAIT_V(8); PG8_WAIT_L(0); PG8_BAR; PG8_MMA(1, 0, At, B0); PG8_MMA(1, 1, At, B1); PG8_BAR; PG8_SCHED;
            PG8_LDB(B0, 1, 0); PG8_LDB(B1, 1, 1); PG8_SCHED; PG8_LDA(At, 1, 0); PG8_STAGE(PG8_SA(0, 1), a2 + hstep, voffA);
            PG8_WAIT_V(8); PG8_WAIT_L(0); PG8_BAR; PG8_MMA(0, 0, At, B0); PG8_MMA(0, 1, At, B1); PG8_BAR; PG8_SCHED;
            PG8_LDA(At, 1, 1); PG8_STAGE(PG8_SB(1, 0), b3, voffB); PG8_STAGE(PG8_SB(1, 1), b3 + hstep, voffB); PG8_STAGE(PG8_SA(1, 0), a3, voffA);
            PG8_WAIT_V(8); PG8_WAIT_L(0); PG8_BAR; PG8_MMA(1, 0, At, B0); PG8_MMA(1, 1, At, B1); PG8_BAR; PG8_SCHED;
            } else {
            PG8_LDB(B0, 0, 0); PG8_SCHED; PG8_LDA(At, 0, 0); PG8_STAGE(PG8_SA(1, 1), a1 + hstep, voffA);
            PG8_WAIT_L(8); PG8_BAR; PG8_WAIT_L(0); PG8_MMA(0, 0, At, B0); PG8_BAR; PG8_SCHED;
            PG8_LDB(B1, 0, 1); PG8_STAGE(PG8_SB(0, 0), b2, voffB);
            PG8_BAR; PG8_WAIT_L(0); PG8_MMA(0, 1, At, B1); PG8_BAR;
            PG8_LDA(At, 0, 1); PG8_STAGE(PG8_SA(0, 0), a2, voffA);
            PG8_BAR; PG8_WAIT_L(0); PG8_MMA(1, 0, At, B0); PG8_BAR; PG8_SCHED;
            PG8_STAGE(PG8_SB(0, 1), b2 + hstep, voffB);
            PG8_WAIT_V(6); PG8_BAR; PG8_MMA(1, 1, At, B1); PG8_BAR;
            PG8_LDB(B0, 1, 0); PG8_SCHED; PG8_LDA(At, 1, 0); PG8_STAGE(PG8_SA(0, 1), a2 + hstep, voffA);
            PG8_WAIT_L(8); PG8_BAR; PG8_WAIT_L(0); PG8_MMA(0, 0, At, B0); PG8_BAR; PG8_SCHED;
            PG8_LDB(B1, 1, 1); PG8_STAGE(PG8_SB(1, 0), b3, voffB);
            PG8_BAR; PG8_WAIT_L(0); PG8_MMA(0, 1, At, B1); PG8_BAR;
            PG8_LDA(At, 1, 1); PG8_STAGE(PG8_SA(1, 0), a3, voffA);
            PG8_BAR; PG8_WAIT_L(0); PG8_MMA(1, 0, At, B0); PG8_BAR; PG8_SCHED;
            PG8_STAGE(PG8_SB(1, 1), b3 + hstep, voffB);
            PG8_WAIT_V(6); PG8_BAR; PG8_MMA(1, 1, At, B1); PG8_BAR;
            }
        }
        if constexpr (ALIGN_EPI) { if (wr == 0) PG8_BAR; }
        E(acc, cur, wr, wc, fr, fq);
        if (!has_next) break;
#pragma unroll
        for (int a = 0; a < 2; ++a)
#pragma unroll
            for (int b = 0; b < 2; ++b)
#pragma unroll
                for (int m = 0; m < 4; ++m)
#pragma unroll
                    for (int n = 0; n < 2; ++n) acc[a][b][m][n] = (f32x4){0.f, 0.f, 0.f, 0.f};
        cur = nxt; cA = nA; cB = nB; ++ui;
        if constexpr (ALIGN_EPI) { if (wr == 1) PG8_BAR; }
    }
    PG8_WAIT_V(0);
    if constexpr (!ALIGN_EPI) { if (wr == 0) PG8_BAR; }
    PG8_BAR;
#undef PG8_SA
#undef PG8_SB
#undef PG8_STAGE
#undef PG8_LDA
#undef PG8_LDB
#undef PG8_MMA
#undef PG8_WAIT_V
#undef PG8_WAIT_L
#undef PG8_BAR
#undef PG8_SCHED
}
}

constexpr int NWAVES = 8;
constexpr int BATCH = 16, SEQ = 2048, D = 1024, T = BATCH * SEQ;
constexpr int LDP = 2816;
constexpr int IN_COLS = 2576;
constexpr int C_U = 0, C_V = 512, C_Q = 1024, C_K = 1280, C_VV = 1536, C_G = 2048, C_A = 2560;
constexpr int DFF = 2816, DFE = 3584, NE = 8;
constexpr float LN_EPS = 1e-5f, RMS_EPS = 1e-6f, ALPHA = 1.41421356237f;
constexpr int RMAX = 2 * T + NE * 256;
constexpr int SLAB_P = 64;
constexpr int NSLAB = 5;
constexpr int KSPLIT = 7, KSLICE = DFE / KSPLIT, REM_P0 = 4 * SLAB_P, REM_MAXP = 8;
constexpr int NPHASE = 24;

constexpr size_t MiB = 1u << 20;
constexpr size_t WS_CTL = 0, CTL_ZERO_BYTES = 64 * 1024;
constexpr size_t WS_TOKE = 1 * MiB;
constexpr size_t WS_TOKW = WS_TOKE + 256 * 1024;
constexpr size_t WS_PPOS = WS_TOKW + 256 * 1024;
constexpr size_t WS_PEXP = WS_PPOS + 256 * 1024;
constexpr size_t WS_RPAIR = 2 * MiB;
constexpr size_t WS_RW = WS_RPAIR + 512 * 1024;
constexpr size_t WS_WM = 3 * MiB;
constexpr size_t WS_WIN = 4 * MiB;
constexpr size_t WS_WOUT = 15 * MiB;
constexpr size_t WS_WGU = 19 * MiB;
constexpr size_t WS_WDN = 30 * MiB;
constexpr size_t WS_EGU = 36 * MiB;
constexpr size_t WS_EDN = 148 * MiB;
constexpr size_t WS_XB = 204 * MiB;
constexpr size_t WS_BIG = 268 * MiB;
constexpr size_t WS_PROJ = WS_BIG;
constexpr size_t WS_CAT = 444 * MiB;
constexpr size_t WS_HID = WS_BIG;
constexpr size_t WS_XG = WS_BIG;
constexpr size_t WS_PART = WS_BIG;
constexpr size_t WS_HSLAB = 400 * MiB;
constexpr size_t WS_END = 512 * MiB;
constexpr int CW_TMO = 0;
constexpr int CW_CNT = 64;
constexpr int CW_CUR = 128;
constexpr int CW_BAR = 4096;

constexpr int RING_BYTES = 131072;
constexpr int LDSCTL_OFF = RING_BYTES, MISC_OFF = LDSCTL_OFF + 320;
constexpr int LDS_BYTES = 147456;

#define GAS __attribute__((address_space(1)))
#define LAS __attribute__((address_space(3)))
typedef unsigned short bf16;
typedef unsigned v4u __attribute__((ext_vector_type(4)));
typedef unsigned v2u __attribute__((ext_vector_type(2)));
typedef float f32x4 __attribute__((ext_vector_type(4)));
typedef float f32x2 __attribute__((ext_vector_type(2)));
typedef short bf16x8 __attribute__((ext_vector_type(8)));
#define RLX_AGENT __ATOMIC_RELAXED, __HIP_MEMORY_SCOPE_AGENT
#define LDS_WAIT() asm volatile("s_waitcnt lgkmcnt(0)" ::: "memory")
__device__ __forceinline__ float bflo(unsigned w) { return __uint_as_float(w << 16); }
__device__ __forceinline__ float bfhi(unsigned w) { return __uint_as_float(w & 0xffff0000u); }
__device__ __forceinline__ float bf2f(unsigned short h) { return __uint_as_float(((unsigned)h) << 16); }
__device__ __forceinline__ unsigned pk2(float lo, float hi) { return pg8::cvt_pk_bf16(lo, hi); }

#define XB_TMO      128
#define XB_XCNT(j)  (256  + 64 * (j))
#define XB_XSUB(j)  (1280 + 64 * (j))
#define XB_XGEN(j)  (2304 + 64 * (j))
#define XB_TOP      3328
#define XB_TOPGEN   3392
#define XCD_BAR_WORDS 3456
#define XB_SPIN_CAP (1u << 18)
__device__ __forceinline__ unsigned xb_ld(unsigned* p)              { return __hip_atomic_load(p, __ATOMIC_RELAXED, __HIP_MEMORY_SCOPE_AGENT); }
__device__ __forceinline__ unsigned xb_add(unsigned* p, unsigned v) { return __hip_atomic_fetch_add(p, v, __ATOMIC_RELAXED, __HIP_MEMORY_SCOPE_AGENT); }
__device__ __forceinline__ unsigned xb_xcc_id() { return (unsigned)__builtin_amdgcn_s_getreg((3 << 11) | 20) & 0xFu; }
#define XB_SPIN(cond, bar) do { unsigned _sp = 0; while (cond) { __builtin_amdgcn_s_sleep(1); \
    if ((++_sp & 255u) == 0u) { if (xb_ld(&(bar)[XB_TMO])) break; if (_sp > XB_SPIN_CAP) { atomicAdd(&(bar)[XB_TMO], 1u); break; } } } } while (0)
struct XcdBarrier { unsigned* bar; unsigned x; volatile LAS unsigned* st; };
__device__ __forceinline__ XcdBarrier xcd_barrier_post(unsigned* bar, volatile LAS unsigned* st) {
    XcdBarrier b; b.bar = bar; b.x = xb_xcc_id(); b.st = st;
    if (threadIdx.x == 0) (void)xb_add(&bar[XB_XCNT(b.x)], 1u);
    return b;
}
__device__ __forceinline__ void xcd_barrier_complete(unsigned* bar, unsigned x, unsigned& nloc, unsigned& nx) {
    const unsigned G = gridDim.x * gridDim.y * gridDim.z;
    unsigned sum, cnt, mine, sp = 0u;
    for (;;) {
        sum = 0u; cnt = 0u; mine = 0u;
#pragma unroll
        for (unsigned j = 0; j < 16; ++j) { const unsigned c = xb_ld(&bar[XB_XCNT(j)]); sum += c; cnt += (c > 0u) ? 1u : 0u; mine = (j == x) ? c : mine; }
        if (sum == G) break;
        __builtin_amdgcn_s_sleep(1);
        if ((++sp & 255u) == 0u) { if (xb_ld(&bar[XB_TMO])) break; if (sp > XB_SPIN_CAP) { atomicAdd(&bar[XB_TMO], 1u); break; } }
    }
    nloc = mine > 0u ? mine : 1u; nx = cnt > 0u ? cnt : 1u;
}
__device__ __forceinline__ void xcd_barrier(const XcdBarrier& b) {
    asm volatile("s_waitcnt vmcnt(0)" ::: "memory");
    __syncthreads();
    if (threadIdx.x == 0) {
        unsigned* bar = b.bar;
        __builtin_amdgcn_s_waitcnt(0);
        unsigned nloc = b.st[0], nx = b.st[1];
        if (nloc == 0u) { xcd_barrier_complete(bar, b.x, nloc, nx); b.st[0] = nloc; b.st[1] = nx; }
        const unsigned old = xb_add(&bar[XB_XSUB(b.x)], 1u);
        const unsigned gen = old / nloc;
        if (old + 1u == (gen + 1u) * nloc) {
            __builtin_amdgcn_fence(__ATOMIC_RELEASE, "agent");
            asm volatile("s_waitcnt vmcnt(0)" ::: "memory");
            const unsigned og = xb_add(&bar[XB_TOP], 1u);
            const unsigned tg = og / nx;
            if (og + 1u == (tg + 1u) * nx) xb_add(&bar[XB_TOPGEN], 1u);
            else XB_SPIN(xb_ld(&bar[XB_TOPGEN]) == tg, bar);
            __builtin_amdgcn_fence(__ATOMIC_ACQUIRE, "agent");
            xb_add(&bar[XB_XGEN(b.x)], 1u);
            asm volatile("s_waitcnt vmcnt(0)" ::: "memory");
        } else {
            XB_SPIN(xb_ld(&bar[XB_XGEN(b.x)]) == gen, bar);
            __builtin_amdgcn_fence(__ATOMIC_ACQUIRE, "agent");
            asm volatile("s_waitcnt vmcnt(0)" ::: "memory");
        }
    }
    __syncthreads();
}

struct Args { const float* in[21]; float* out; unsigned char* ws; int ph_lo, ph_hi; };
struct Frame {
    LAS unsigned char* lds;
    volatile LAS unsigned* MISC;
    unsigned* ctl;
    int G;
    unsigned char* ws; float* out;
};
#define LOCAL_IDS int tid = threadIdx.x; asm volatile("" : "+v"(tid)); const int lane = tid & 63; const int wave = __builtin_amdgcn_readfirstlane(tid >> 6); (void)lane; (void)wave
__device__ __forceinline__ float wave_sum(float v) {
#pragma unroll
    for (int o = 1; o < 64; o <<= 1) v += __shfl_xor(v, o);
    return v;
}

__device__ __forceinline__ void tr_block(const float* W, int Nsrc, int K, int k0, int n0, bf16* WT, int drow, int lane) {
    const int n = n0 + lane; const bool ok = n < Nsrc; const float* src = W + (size_t)k0 * Nsrc + (ok ? n : 0);
    float v[64];
#pragma unroll
    for (int kk = 0; kk < 64; ++kk) v[kk] = src[(size_t)kk * Nsrc];
    GAS v4u* dst = (GAS v4u*)(WT + (size_t)(drow + lane) * K + k0);
#pragma unroll
    for (int c = 0; c < 8; ++c) { v4u o; o.x = pk2(v[8 * c], v[8 * c + 1]); o.y = pk2(v[8 * c + 2], v[8 * c + 3]); o.z = pk2(v[8 * c + 4], v[8 * c + 5]); o.w = pk2(v[8 * c + 6], v[8 * c + 7]);
        if (!ok) o = (v4u){0u, 0u, 0u, 0u}; dst[c] = o; }
}
__device__ __forceinline__ void tr_plain(const float* W, int K, int Nsrc, int nblk, bf16* WT, int item, int lane) {
    const int kb = item / nblk, nb = item % nblk; tr_block(W, Nsrc, K, 64 * kb, 64 * nb, WT, 64 * nb, lane);
}
__device__ __forceinline__ void tr_gu(const float* W, int K, int Nsrc, int nblk, bf16* WT, int add, int item, int lane) {
    const int kb = item / nblk, nb = item % nblk, n0 = 64 * nb; tr_block(W, Nsrc, K, 64 * kb, n0, WT, (n0 >> 7) * 256 + (n0 & 127) + add, lane);
}
constexpr int I_IN = 16 * 44, I_OUT = 16 * 16, I_G = 16 * 44, I_DN = 44 * 16, I_EG = 16 * 56, I_ED = 56 * 16;
constexpr int NITEMS = 2 * I_IN + 2 * I_OUT + 2 * I_G + I_DN + 16 * I_EG + 8 * I_ED;
constexpr int NITEMS_A = I_IN + I_OUT, NITEMS_B = NITEMS - NITEMS_A;
constexpr int NITEMS_B0 = I_IN + I_OUT + 2 * I_G + I_DN + (16 * I_EG + 8 * I_ED) / 2;
__device__ __forceinline__ void conv_item(unsigned char* ws, const Args& a, int it, int lane) {
    bf16* Win = (bf16*)(ws + WS_WIN); bf16* Wout = (bf16*)(ws + WS_WOUT); bf16* Wgu = (bf16*)(ws + WS_WGU); bf16* Wdn = (bf16*)(ws + WS_WDN);
    bf16* Egu = (bf16*)(ws + WS_EGU); bf16* Edn = (bf16*)(ws + WS_EDN);
    int r = it;
    if (r < 2 * I_IN) { const int l = r / I_IN; tr_plain(a.in[1] + (size_t)l * D * IN_COLS, D, IN_COLS, 44, Win + (size_t)l * LDP * D, r % I_IN, lane); return; } r -= 2 * I_IN;
    if (r < 2 * I_OUT) { const int l = r / I_OUT; tr_plain(a.in[9] + (size_t)l * D * D, D, D, 16, Wout + (size_t)l * D * D, r % I_OUT, lane); return; } r -= 2 * I_OUT;
    if (r < I_G) { tr_gu(a.in[12], D, DFF, 44, Wgu, 0, r, lane); return; } r -= I_G;
    if (r < I_G) { tr_gu(a.in[13], D, DFF, 44, Wgu, 128, r, lane); return; } r -= I_G;
    if (r < I_DN) { tr_plain(a.in[14], DFF, D, 16, Wdn, r, lane); return; } r -= I_DN;
    if (r < 8 * I_EG) { const int e = r / I_EG; tr_gu(a.in[16] + (size_t)e * D * DFE, D, DFE, 56, Egu + (size_t)e * 2 * DFE * D, 0, r % I_EG, lane); return; } r -= 8 * I_EG;
    if (r < 8 * I_EG) { const int e = r / I_EG; tr_gu(a.in[17] + (size_t)e * D * DFE, D, DFE, 56, Egu + (size_t)e * 2 * DFE * D, 128, r % I_EG, lane); return; } r -= 8 * I_EG;
    { const int e = r / I_ED; tr_plain(a.in[18] + (size_t)e * DFE * D, DFE, D, 16, Edn + (size_t)e * D * DFE, r % I_ED, lane); }
}
__device__ __forceinline__ void conv_set_b(Frame& F, const Args& a, int gw2, int NGW2, int k_lo, int k_hi) {
    LOCAL_IDS;
    for (int k = k_lo + gw2; k < k_hi; k += NGW2) conv_item(F.ws, a, k < I_IN ? I_IN + k : 2 * I_IN + I_OUT + (k - I_IN), lane);
}
__device__ __forceinline__ void p0_prologue(Frame& F, const Args& a) {
    LOCAL_IDS;
    const int gw = blockIdx.x * NWAVES + wave, NGW = F.G * NWAVES;
    for (int k = gw; k < NITEMS_A; k += NGW) conv_item(F.ws, a, k < I_IN ? k : 2 * I_IN + (k - I_IN), lane);
    if (F.G < 128) conv_set_b(F, a, gw, NGW, 0, NITEMS_B);
    const size_t gt = (size_t)blockIdx.x * 512 + tid, NT = (size_t)F.G * 512;
    { const f32x4* x4 = (const f32x4*)a.in[0]; v4u* o = (v4u*)(F.ws + WS_XB);
      for (size_t i = gt; i < (size_t)T * D / 8; i += 4 * NT) { f32x4 p[4], q[4];
#pragma unroll
          for (int u = 0; u < 4; ++u) if (i + u * NT < (size_t)T * D / 8) { p[u] = x4[2 * (i + u * NT)]; q[u] = x4[2 * (i + u * NT) + 1]; }
#pragma unroll
          for (int u = 0; u < 4; ++u) if (i + u * NT < (size_t)T * D / 8) { v4u w; w.x = pk2(p[u][0], p[u][1]); w.y = pk2(p[u][2], p[u][3]); w.z = pk2(q[u][0], q[u][1]); w.w = pk2(q[u][2], q[u][3]); o[i + u * NT] = w; } } }
    { const float* w = a.in[2]; bf16* o = (bf16*)(F.ws + WS_WM);
      for (size_t i = gt; i < (size_t)2 * 4 * 128 * 128; i += NT) { const int s = (int)(i & 127), t = (int)((i >> 7) & 127); o[i] = (bf16)(pk2(s <= t ? w[i] : 0.f, 0.f) & 0xffffu); } }
}

__device__ __forceinline__ void gmlp_item(Frame& F, const Args& a, int layer, int item) {
    const int bb = item >> 6, c = (item >> 2) & 15, h = item & 3; const int r0 = bb * SEQ + c * 128;
    const bf16* P = (const bf16*)(F.ws + WS_PROJ); bf16* CAT = (bf16*)(F.ws + WS_CAT);
    const bf16* Wm = (const bf16*)(F.ws + WS_WM) + (size_t)(layer * 4 + h) * 128 * 128;
    const float* lng = a.in[4] + layer * 512 + h * 128; const float* lnb = a.in[5] + layer * 512 + h * 128; const float* bs = a.in[3] + (layer * 4 + h) * 128;
    LAS unsigned char* VTA = F.lds;
    LOCAL_IDS; const int w = wave, fr = lane & 15, fq = lane >> 4;
    {
        const int s = tid >> 2, q4 = tid & 3; const bf16* vp = P + (size_t)(r0 + s) * 1024 + 512 + h * 128 + q4 * 8;
        float x[4][8]; float sum = 0.f;
#pragma unroll
        for (int j = 0; j < 4; ++j) { const v4u wv = *(const v4u*)(vp + 32 * j); x[j][0] = bflo(wv.x); x[j][1] = bfhi(wv.x); x[j][2] = bflo(wv.y); x[j][3] = bfhi(wv.y); x[j][4] = bflo(wv.z); x[j][5] = bfhi(wv.z); x[j][6] = bflo(wv.w); x[j][7] = bfhi(wv.w);
#pragma unroll
            for (int e = 0; e < 8; ++e) sum += x[j][e]; }
        sum += __shfl_xor(sum, 1); sum += __shfl_xor(sum, 2);
        const float mean = sum * (1.f / 128.f); float q = 0.f;
#pragma unroll
        for (int j = 0; j < 4; ++j)
#pragma unroll
            for (int e = 0; e < 8; ++e) { x[j][e] -= mean; q += x[j][e] * x[j][e]; }
        q += __shfl_xor(q, 1); q += __shfl_xor(q, 2);
        const float rstd = 1.0f / sqrtf(q * (1.f / 128.f) + LN_EPS);
#pragma unroll
        for (int j = 0; j < 4; ++j) { const int ch0 = q4 * 8 + 32 * j; const f32x4 g0 = *(const f32x4*)(lng + ch0), g1 = *(const f32x4*)(lng + ch0 + 4), b0 = *(const f32x4*)(lnb + ch0), b1 = *(const f32x4*)(lnb + ch0 + 4);
#pragma unroll
            for (int e = 0; e < 8; ++e) { const float gg = e < 4 ? g0[e & 3] : g1[e & 3], be = e < 4 ? b0[e & 3] : b1[e & 3]; const float y = x[j][e] * rstd * gg + be;
                *(LAS bf16*)(VTA + (ch0 + e) * 272 + s * 2) = (bf16)(pk2(y, 0.f) & 0xffffu); } }
    }
    __syncthreads();
    {
        bf16x8 aV[4];
#pragma unroll
        for (int ks = 0; ks < 4; ++ks) aV[ks] = *(const LAS bf16x8*)(VTA + (16 * w + fr) * 272 + (32 * ks + 8 * fq) * 2);
#pragma unroll
        for (int tt = 0; tt < 8; ++tt) { f32x4 acc = (f32x4){0.f, 0.f, 0.f, 0.f}; const int t = 16 * tt + fr;
#pragma unroll
            for (int ks = 0; ks < 4; ++ks) if (ks <= tt / 2) { const bf16x8 bW = *(const bf16x8*)(Wm + (size_t)t * 128 + 32 * ks + 8 * fq); acc = __builtin_amdgcn_mfma_f32_16x16x32_bf16(aV[ks], bW, acc, 0, 0, 0); }
            const float bst = bs[t]; const size_t row = (size_t)(r0 + t); const v2u uu = *(const v2u*)(P + row * 1024 + h * 128 + 16 * w + 4 * fq);
            v2u o; o.x = pk2(bflo(uu.x) * (acc[0] + bst), bfhi(uu.x) * (acc[1] + bst)); o.y = pk2(bflo(uu.y) * (acc[2] + bst), bfhi(uu.y) * (acc[3] + bst));
            *(v2u*)(CAT + row * D + h * 128 + 16 * w + 4 * fq) = o; }
    }
    __syncthreads();
}

constexpr int G_QD = 0, G_KI = 9216, G_SC = 18432, G_KDT = 27648, G_VT = 36864, G_ST = 55296, G_ALR = 73728, G_PART = 75776, G_DEC = 77824, G_SS = 78080, G_RQ = 80128, G_RK = 88320, G_RV = 96512, G_BL = 112896, G_END = 129280;
template <int N> __device__ __forceinline__ float dpp_row_shr(float x) {
    return __builtin_bit_cast(float, __builtin_amdgcn_update_dpp(0, __builtin_bit_cast(int, x), 0x110 + N, 0xf, 0xf, false)); }
__device__ __forceinline__ void gla_item(Frame& F, const Args& a, int layer, int item) {
    const int bb = item >> 2, h = item & 3;
    const bf16* PJ = (const bf16*)(F.ws + WS_PROJ); bf16* CAT = (bf16*)(F.ws + WS_CAT) + (size_t)bb * SEQ * D;
    const bf16* Qh = PJ + pg8::PJ_Q + (size_t)item * SEQ * 64; const bf16* Kh = Qh + pg8::PJ_QSZ; const bf16* Vh = PJ + pg8::PJ_V + (size_t)item * SEQ * 128; const bf16* Gh = Vh + pg8::PJ_VSZ; const bf16* Ah = PJ + pg8::PJ_A + (size_t)bb * SEQ * 16;
    LAS unsigned char* L = F.lds;
    LOCAL_IDS; const int w = wave, fr = lane & 15, fq = lane >> 4, d = lane;
    const int ve = (w & 1) * 64 + lane, vjg = w >> 1;
    const int dtw = w & 3, ihw = w >> 2;
    const int ih = w & 3, eh = w >> 2;
    bf16x8 wfrag;
    { const float* wa = a.in[6] + (size_t)layer * 16 * 256 + h * 64 + 16 * dtw + fr;
#pragma unroll
      for (int j = 0; j < 8; ++j) { const float wv = wa[(8 * (fq & 1) + j) * 256]; const unsigned hi = pk2(wv, 0.f) & 0xffffu; const unsigned lo = pk2(wv - __uint_as_float(hi << 16), 0.f) & 0xffffu; wfrag[j] = (short)((fq < 2) ? hi : lo); } }
    const f32x4 bav = *(const f32x4*)(a.in[7] + layer * 256 + h * 64 + 16 * dtw + 4 * fq);
    f32x4 ng[4];
#pragma unroll
    for (int e4 = 0; e4 < 4; ++e4) ng[e4] = *(const f32x4*)(a.in[8] + layer * 512 + h * 128 + 64 * eh + 16 * e4 + 4 * fq);
    for (int i = tid; i < (18432 + 9216) / 4; i += 512) { if (i < 18432 / 4) ((LAS unsigned*)(L + G_ST))[i] = 0u; else ((LAS unsigned*)(L + G_SC))[i - 18432 / 4] = 0u; }
    f32x4 sacc[4];
#pragma unroll
    for (int dt = 0; dt < 4; ++dt) sacc[dt] = (f32x4){0.f, 0.f, 0.f, 0.f};
    const unsigned og = (unsigned)((16 * ih + fr) * 128 + 64 * eh + 4 * fq);
    v4u rq, rk, rv0, rv1, ra = (v4u){0u, 0u, 0u, 0u};
    { rq = *(const v4u*)(Qh + tid * 8); rk = *(const v4u*)(Kh + tid * 8); rv0 = *(const v4u*)(Vh + tid * 8); rv1 = *(const v4u*)(Vh + 4096 + tid * 8); if (tid < 128) ra = *(const v4u*)(Ah + tid * 8); }
    __syncthreads();
    v2u pend[4]; bf16* prow = CAT;
#pragma unroll
    for (int e4 = 0; e4 < 4; ++e4) pend[e4] = (v2u){0u, 0u};
    for (int n = 0; n < 32; ++n) {
        *(LAS v4u*)(L + G_RQ + tid * 16) = rq; *(LAS v4u*)(L + G_RK + tid * 16) = rk; *(LAS v4u*)(L + G_RV + tid * 16) = rv0; *(LAS v4u*)(L + G_RV + 8192 + tid * 16) = rv1;
        if (tid < 128) *(LAS v4u*)(L + G_ALR + tid * 16) = ra;
        __syncthreads();
        if (n + 1 < 32) { const int nn = n + 1; rq = *(const v4u*)(Qh + nn * 4096 + tid * 8); rk = *(const v4u*)(Kh + nn * 4096 + tid * 8); rv0 = *(const v4u*)(Vh + nn * 8192 + tid * 8); rv1 = *(const v4u*)(Vh + nn * 8192 + 4096 + tid * 8); if (tid < 128) ra = *(const v4u*)(Ah + nn * 1024 + tid * 8); }
        v2u gate[4];
#pragma unroll
        for (int e4 = 0; e4 < 4; ++e4) gate[e4] = *(const v2u*)(Gh + n * 8192 + og + 16 * e4);
        if (n > 0) {
#pragma unroll
            for (int e4 = 0; e4 < 4; ++e4) *(v2u*)(prow + 16 * e4) = pend[e4]; }
        { unsigned short vv[16];
#pragma unroll
          for (int jj = 0; jj < 16; ++jj) vv[jj] = *(const LAS unsigned short*)(L + G_RV + (16 * vjg + jj) * 256 + ve * 2);
          v4u p0, p1; p0.x = vv[0] | ((unsigned)vv[1] << 16); p0.y = vv[2] | ((unsigned)vv[3] << 16); p0.z = vv[4] | ((unsigned)vv[5] << 16); p0.w = vv[6] | ((unsigned)vv[7] << 16);
          p1.x = vv[8] | ((unsigned)vv[9] << 16); p1.y = vv[10] | ((unsigned)vv[11] << 16); p1.z = vv[12] | ((unsigned)vv[13] << 16); p1.w = vv[14] | ((unsigned)vv[15] << 16);
          *(LAS v4u*)(L + G_VT + ve * 144 + vjg * 32) = p0; *(LAS v4u*)(L + G_VT + ve * 144 + vjg * 32 + 16) = p1; }
        { f32x4 cum[2];
#pragma unroll
          for (int t2 = 0; t2 < 2; ++t2) { const int i = 16 * (2 * ihw + t2) + fr;
              const bf16x8 af = *(const LAS bf16x8*)(L + G_ALR + i * 32 + (fq & 1) * 16);
              f32x4 z = __builtin_amdgcn_mfma_f32_16x16x32_bf16(wfrag, af, bav, 0, 0, 0);
#pragma unroll
              for (int r = 0; r < 4; ++r) { float x = (fminf(z[r], 0.f) - __logf(1.0f + __expf(-fabsf(z[r])))) * 0.0625f;
                  x += dpp_row_shr<1>(x); x += dpp_row_shr<2>(x); x += dpp_row_shr<4>(x); x += dpp_row_shr<8>(x); z[r] = x; }
              cum[t2] = z; }
#pragma unroll
          for (int r = 0; r < 4; ++r) cum[1][r] += __shfl(cum[0][r], (lane & 48) | 15);
          *(LAS f32x4*)(L + G_BL + ((32 * ihw + fr) * 64 + 16 * dtw + 4 * fq) * 4) = cum[0];
          *(LAS f32x4*)(L + G_BL + ((32 * ihw + 16 + fr) * 64 + 16 * dtw + 4 * fq) * 4) = cum[1];
          if (fr == 15) *(LAS f32x4*)(L + G_PART + (ihw * 64 + 16 * dtw + 4 * fq) * 4) = cum[1]; }
        __syncthreads();
        { const float p0 = *(const LAS float*)(L + G_PART + d * 4), p1 = *(const LAS float*)(L + G_PART + (64 + d) * 4); const float bl = p0 + p1, ebl = __expf(bl), off = (w >= 4) ? p0 : 0.f;
          unsigned kd[8];
#pragma unroll
          for (int ii = 0; ii < 8; ++ii) { const float qv = bf2f(*(const LAS unsigned short*)(L + G_RQ + (8 * w + ii) * 128 + d * 2)), kv = bf2f(*(const LAS unsigned short*)(L + G_RK + (8 * w + ii) * 128 + d * 2));
              const float b_ = off + *(const LAS float*)(L + G_BL + ((8 * w + ii) * 64 + d) * 4); const float eb = __expf(b_), ki = kv * __builtin_amdgcn_rcpf(eb);
              *(LAS bf16*)(L + G_QD + (8 * w + ii) * 144 + d * 2) = (bf16)(pk2(qv * 0.125f * eb, 0.f) & 0xffffu);
              *(LAS bf16*)(L + G_KI + (8 * w + ii) * 144 + d * 2) = (bf16)(pk2(ki, 0.f) & 0xffffu);
              kd[ii] = pk2(ki * ebl, 0.f) & 0xffffu; }
          v4u pk; pk.x = kd[0] | (kd[1] << 16); pk.y = kd[2] | (kd[3] << 16); pk.z = kd[4] | (kd[5] << 16); pk.w = kd[6] | (kd[7] << 16);
          *(LAS v4u*)(L + G_KDT + d * 144 + w * 16) = pk;
          if (w == 0) *(LAS float*)(L + G_DEC + d * 4) = ebl; }
        __syncthreads();
        { LAS unsigned char* SW = L + G_RQ + w * 2304;
#pragma unroll
          for (int jt = 0; jt < 4; ++jt) if (jt <= ih) { f32x4 acc = (f32x4){0.f, 0.f, 0.f, 0.f};
#pragma unroll
              for (int ks = 0; ks < 2; ++ks) { const bf16x8 ak = *(const LAS bf16x8*)(L + G_KI + (16 * jt + fr) * 144 + (32 * ks + 8 * fq) * 2), bq = *(const LAS bf16x8*)(L + G_QD + (16 * ih + fr) * 144 + (32 * ks + 8 * fq) * 2);
                  acc = __builtin_amdgcn_mfma_f32_16x16x32_bf16(ak, bq, acc, 0, 0, 0); }
              const int jl = 4 * fq;
              v2u o_; if (jt == ih) { o_.x = pk2(jl <= fr ? acc[0] : 0.f, jl + 1 <= fr ? acc[1] : 0.f); o_.y = pk2(jl + 2 <= fr ? acc[2] : 0.f, jl + 3 <= fr ? acc[3] : 0.f); }
              else { o_.x = pk2(acc[0], acc[1]); o_.y = pk2(acc[2], acc[3]); }
              *(LAS v2u*)(SW + fr * 144 + (16 * jt + jl) * 2) = o_; }
          if ((ih & 1) == 0) *(LAS v2u*)(SW + fr * 144 + (16 * (ih + 1) + 4 * fq) * 2) = (v2u){0u, 0u};
          asm volatile("s_waitcnt lgkmcnt(0)" ::: "memory"); }
        f32x4 o[4]; float ssq = 0.f;
        { bf16x8 bSC[2], bQD[2];
#pragma unroll
          for (int ks = 0; ks < 2; ++ks) { bSC[ks] = *(const LAS bf16x8*)(L + G_RQ + w * 2304 + fr * 144 + (32 * ks + 8 * fq) * 2); bQD[ks] = *(const LAS bf16x8*)(L + G_QD + (16 * ih + fr) * 144 + (32 * ks + 8 * fq) * 2); }
#pragma unroll
          for (int e4 = 0; e4 < 4; ++e4) { const int er = 64 * eh + 16 * e4 + fr; f32x4 acc = (f32x4){0.f, 0.f, 0.f, 0.f};
              const bf16x8 aV0 = *(const LAS bf16x8*)(L + G_VT + er * 144 + (8 * fq) * 2), aV1 = *(const LAS bf16x8*)(L + G_VT + er * 144 + (32 + 8 * fq) * 2);
              const bf16x8 aS0 = *(const LAS bf16x8*)(L + G_ST + er * 144 + (8 * fq) * 2), aS1 = *(const LAS bf16x8*)(L + G_ST + er * 144 + (32 + 8 * fq) * 2);
              acc = __builtin_amdgcn_mfma_f32_16x16x32_bf16(aV0, bSC[0], acc, 0, 0, 0);
              if (ih >= 2) acc = __builtin_amdgcn_mfma_f32_16x16x32_bf16(aV1, bSC[1], acc, 0, 0, 0);
              acc = __builtin_amdgcn_mfma_f32_16x16x32_bf16(aS0, bQD[0], acc, 0, 0, 0); acc = __builtin_amdgcn_mfma_f32_16x16x32_bf16(aS1, bQD[1], acc, 0, 0, 0);
              o[e4] = acc;
              ssq += acc[0] * acc[0] + acc[1] * acc[1] + acc[2] * acc[2] + acc[3] * acc[3]; }
          ssq += __shfl_xor(ssq, 16); ssq += __shfl_xor(ssq, 32);
          if (fq == 0) *(LAS float*)(L + G_SS + (eh * 64 + 16 * ih + fr) * 4) = ssq; }
        __syncthreads();
        { bf16x8 aV[2];
#pragma unroll
          for (int ks = 0; ks < 2; ++ks) aV[ks] = *(const LAS bf16x8*)(L + G_VT + (16 * w + fr) * 144 + (32 * ks + 8 * fq) * 2);
#pragma unroll
          for (int dt = 0; dt < 4; ++dt) { const f32x4 dec = *(const LAS f32x4*)(L + G_DEC + (16 * dt + 4 * fq) * 4); sacc[dt] = sacc[dt] * dec;
#pragma unroll
              for (int ks = 0; ks < 2; ++ks) { const bf16x8 ak = *(const LAS bf16x8*)(L + G_KDT + (16 * dt + fr) * 144 + (32 * ks + 8 * fq) * 2); sacc[dt] = __builtin_amdgcn_mfma_f32_16x16x32_bf16(ak, aV[ks], sacc[dt], 0, 0, 0); }
              v2u sw; sw.x = pk2(sacc[dt][0], sacc[dt][1]); sw.y = pk2(sacc[dt][2], sacc[dt][3]);
              *(LAS v2u*)(L + G_ST + (16 * w + fr) * 144 + (16 * dt + 4 * fq) * 2) = sw; } }
        { const float tot = *(const LAS float*)(L + G_SS + (16 * ih + fr) * 4) + *(const LAS float*)(L + G_SS + (64 + 16 * ih + fr) * 4);
          const float rstd = 1.0f / sqrtf(tot * (1.f / 128.f) + RMS_EPS);
          bf16* orow = CAT + (size_t)(n * 64 + 16 * ih + fr) * D + 512 + h * 128 + 64 * eh + 4 * fq;
#pragma unroll
          for (int e4 = 0; e4 < 4; ++e4) { const float g0 = bflo(gate[e4].x), g1 = bfhi(gate[e4].x), g2 = bflo(gate[e4].y), g3 = bfhi(gate[e4].y);
              v2u ov_; ov_.x = pk2(o[e4][0] * rstd * ng[e4][0] * pg8::silu_f(g0), o[e4][1] * rstd * ng[e4][1] * pg8::silu_f(g1)); ov_.y = pk2(o[e4][2] * rstd * ng[e4][2] * pg8::silu_f(g2), o[e4][3] * rstd * ng[e4][3] * pg8::silu_f(g3));
              pend[e4] = ov_; }
          prow = orow; }
    }
#pragma unroll
    for (int e4 = 0; e4 < 4; ++e4) *(v2u*)(prow + 16 * e4) = pend[e4];
    __syncthreads();
}
__device__ __forceinline__ void mixer_phase(Frame& F, const Args& a, int layer) {
    const int bx = blockIdx.x; int G_ = F.G; asm volatile("" : "+s"(G_));
    if (G_ >= 128) {
        if (bx < 64) gla_item(F, a, layer, bx);
        else { for (int it = bx - 64; it < 1024; it += F.G - 64) gmlp_item(F, a, layer, it);
            { const int wv = __builtin_amdgcn_readfirstlane((int)threadIdx.x >> 6);
              conv_set_b(F, a, (bx - 64) * NWAVES + wv, (G_ - 64) * NWAVES, layer == 0 ? 0 : NITEMS_B0, layer == 0 ? NITEMS_B0 : NITEMS_B); } }
    } else {
        for (int it = bx; it < 64; it += F.G) gla_item(F, a, layer, it);
        for (int it = bx; it < 1024; it += F.G) gmlp_item(F, a, layer, it);
    }
}

template <bool ROUTER>
__device__ __forceinline__ void ln_phase(Frame& F, const Args& a, const float* g, const float* b) {
    LOCAL_IDS;
    constexpr int RB = ROUTER ? 2 : 4;
    const int gw = blockIdx.x * NWAVES + wave, NGW = F.G * NWAVES;
    const bf16* Y = (const bf16*)F.out; bf16* XB = (bf16*)(F.ws + WS_XB);
    f32x4 gv[4], bv[4];
#pragma unroll
    for (int j = 0; j < 4; ++j) { gv[j] = *(const f32x4*)(g + 4 * lane + 256 * j); bv[j] = *(const f32x4*)(b + 4 * lane + 256 * j); }
    LAS unsigned* hist = (LAS unsigned*)(F.lds + 1024);
    f32x4 wq[ROUTER ? 32 : 1];
    if (ROUTER) {
        if (tid < 8) hist[tid] = 0u;
        int* rp = (int*)(F.ws + WS_RPAIR);
        for (int c = blockIdx.x; c < RMAX / 512; c += F.G) rp[c * 512 + tid] = -1;
        const float* wr = a.in[15];
#pragma unroll
        for (int j = 0; j < 4; ++j)
#pragma unroll
            for (int c = 0; c < 4; ++c) { const int k = 4 * lane + 256 * j + c; wq[(j * 4 + c) * 2] = *(const f32x4*)(wr + k * 8); wq[(j * 4 + c) * 2 + 1] = *(const f32x4*)(wr + k * 8 + 4); }
        __syncthreads();
    }
    for (int m0 = gw * RB; m0 < T; m0 += NGW * RB) {
        v2u raw[RB][4];
#pragma unroll
        for (int r = 0; r < RB; ++r) { const v2u* xr = (const v2u*)(Y + (size_t)(m0 + r) * D) + lane;
#pragma unroll
            for (int j = 0; j < 4; ++j) raw[r][j] = xr[64 * j]; }
#pragma unroll
        for (int r = 0; r < RB; ++r) { const int m = m0 + r;
            f32x4 v[4]; float s = 0.f;
#pragma unroll
            for (int j = 0; j < 4; ++j) { const v2u yy = raw[r][j]; v[j] = (f32x4){bflo(yy.x), bfhi(yy.x), bflo(yy.y), bfhi(yy.y)}; s += (v[j][0] + v[j][1]) + (v[j][2] + v[j][3]); }
            const float mean = wave_sum(s) * (1.f / D); float s2 = 0.f;
#pragma unroll
            for (int j = 0; j < 4; ++j) { v[j] = v[j] - mean; s2 += (v[j][0] * v[j][0] + v[j][1] * v[j][1]) + (v[j][2] * v[j][2] + v[j][3] * v[j][3]); }
            const float rstd = 1.f / sqrtf(wave_sum(s2) * (1.f / D) + LN_EPS);
            v2u* o8 = (v2u*)(XB + (size_t)m * D) + lane;
#pragma unroll
            for (int j = 0; j < 4; ++j) { v[j] = v[j] * rstd * gv[j] + bv[j]; v2u w; w.x = pk2(v[j][0], v[j][1]); w.y = pk2(v[j][2], v[j][3]); o8[64 * j] = w; }
            if (ROUTER) {
                float lg[8];
#pragma unroll
                for (int e = 0; e < 8; ++e) lg[e] = 0.f;
#pragma unroll
                for (int j = 0; j < 4; ++j)
#pragma unroll
                    for (int c = 0; c < 4; ++c) { const f32x4 w0 = wq[(j * 4 + c) * 2], w1 = wq[(j * 4 + c) * 2 + 1]; const float xv = v[j][c];
                        lg[0] += xv * w0[0]; lg[1] += xv * w0[1]; lg[2] += xv * w0[2]; lg[3] += xv * w0[3]; lg[4] += xv * w1[0]; lg[5] += xv * w1[1]; lg[6] += xv * w1[2]; lg[7] += xv * w1[3]; }
                float t4[4], t2[2], t1;
#pragma unroll
                for (int k = 0; k < 4; ++k) { const bool hi = (lane & 32) != 0; const float keep = hi ? lg[k + 4] : lg[k], send = hi ? lg[k] : lg[k + 4]; t4[k] = keep + __shfl_xor(send, 32); }
#pragma unroll
                for (int k = 0; k < 2; ++k) { const bool hi = (lane & 16) != 0; const float keep = hi ? t4[k + 2] : t4[k], send = hi ? t4[k] : t4[k + 2]; t2[k] = keep + __shfl_xor(send, 16); }
                { const bool hi = (lane & 8) != 0; const float keep = hi ? t2[1] : t2[0], send = hi ? t2[0] : t2[1]; t1 = keep + __shfl_xor(send, 8); }
                t1 += __shfl_xor(t1, 4); t1 += __shfl_xor(t1, 2); t1 += __shfl_xor(t1, 1);
#pragma unroll
                for (int e = 0; e < 8; ++e) lg[e] = __builtin_bit_cast(float, __builtin_amdgcn_readlane(__builtin_bit_cast(int, t1), 8 * e));
                int i0 = 0; float v0 = lg[0];
#pragma unroll
                for (int e = 1; e < 8; ++e) if (lg[e] > v0) { v0 = lg[e]; i0 = e; }
                int i1 = -1; float v1 = -3.0e38f;
#pragma unroll
                for (int e = 0; e < 8; ++e) if (e != i0 && lg[e] > v1) { v1 = lg[e]; i1 = e; }
                const float w0 = 1.0f / (1.0f + __expf(v1 - v0)), w1 = 1.0f - w0;
                if (lane == 0) { ((unsigned*)(F.ws + WS_TOKE))[m] = (unsigned)i0 | ((unsigned)i1 << 8); ((f32x2*)(F.ws + WS_TOKW))[m] = (f32x2){w0, w1};
                    __hip_atomic_fetch_add(hist + i0, 1u, __ATOMIC_RELAXED, __HIP_MEMORY_SCOPE_WORKGROUP); __hip_atomic_fetch_add(hist + i1, 1u, __ATOMIC_RELAXED, __HIP_MEMORY_SCOPE_WORKGROUP); }
            }
        }
    }
    if (ROUTER) { __syncthreads(); if (tid < 8) __hip_atomic_fetch_add(F.ctl + CW_CNT + tid, hist[tid], RLX_AGENT); }
}
__device__ __forceinline__ void moe_segments(Frame& F, int (&seg)[9]) {
    int acc = 0;
#pragma unroll
    for (int e = 0; e < 8; ++e) { seg[e] = acc; const unsigned c = __hip_atomic_load(F.ctl + CW_CNT + e, RLX_AGENT); acc += (int)((c + 255u) & ~255u); }
    seg[8] = acc;
}
__device__ __forceinline__ void scatter_phase(Frame& F) {
    LOCAL_IDS;
    int seg[9]; moe_segments(F, seg);
    LAS unsigned* lcnt = (LAS unsigned*)(F.lds + 1024); LAS unsigned* lbase = lcnt + 8; LAS int* lpos = (LAS int*)(F.lds + 2048);
    const unsigned* toke = (const unsigned*)(F.ws + WS_TOKE); const f32x2* tokw = (const f32x2*)(F.ws + WS_TOKW);
    int* rp = (int*)(F.ws + WS_RPAIR); float* rw = (float*)(F.ws + WS_RW);
    const bf16* XB = (const bf16*)(F.ws + WS_XB); bf16* XG = (bf16*)(F.ws + WS_XG);
    for (int base = blockIdx.x * 128; base < T; base += F.G * 128) {
        if (tid < 8) lcnt[tid] = 0u;
        __syncthreads();
        int e = 0, lrank = 0; float wgt = 0.f; const int t = base + (tid >> 1), slot = tid & 1;
        if (tid < 256) { const unsigned ee = toke[t]; e = slot ? (int)((ee >> 8) & 0xff) : (int)(ee & 0xff); const f32x2 ww = tokw[t]; wgt = slot ? ww.y : ww.x; lrank = (int)__hip_atomic_fetch_add(lcnt + e, 1u, __ATOMIC_RELAXED, __HIP_MEMORY_SCOPE_WORKGROUP); }
        __syncthreads();
        if (tid < 8) lbase[tid] = __hip_atomic_fetch_add(F.ctl + CW_CUR + tid, lcnt[tid], RLX_AGENT);
        __syncthreads();
        if (tid < 256) { int sg = 0;
#pragma unroll
            for (int j = 0; j < 8; ++j) sg = (e == j) ? seg[j] : sg;
            const int pos = sg + (int)lbase[e] + lrank; rp[pos] = 2 * t + slot; rw[pos] = wgt; lpos[tid] = pos; ((int*)(F.ws + WS_PPOS))[2 * t + slot] = pos; }
        __syncthreads();
        for (int p0 = wave * 4; p0 < 256; p0 += NWAVES * 4) { v4u t0[4], t1_[4]; int pos[4];
#pragma unroll
            for (int q = 0; q < 4; ++q) { const int p = p0 + q; pos[q] = lpos[p]; const v4u* src = (const v4u*)(XB + (size_t)(base + (p >> 1)) * D); t0[q] = src[lane]; t1_[q] = src[lane + 64]; }
#pragma unroll
            for (int q = 0; q < 4; ++q) { v4u* dst = (v4u*)(XG + (size_t)pos[q] * D); dst[lane] = t0[q]; dst[lane + 64] = t1_[q]; } }
        __syncthreads();
    }
    if (blockIdx.x == 0 && tid < RMAX / 256) { int e = 0;
#pragma unroll
        for (int j = 1; j < 8; ++j) e += (tid * 256 >= seg[j]) ? 1 : 0;
        ((unsigned char*)(F.ws + WS_PEXP))[tid] = (unsigned char)e; }
    if (blockIdx.x < 8) { const int e = blockIdx.x; const int c = (int)__hip_atomic_load(F.ctl + CW_CNT + e, RLX_AGENT); int sg = 0, sn = 0;
#pragma unroll
        for (int j = 0; j < 8; ++j) { sg = (e == j) ? seg[j] : sg; sn = (e == j) ? seg[j + 1] : sn; }
        const int r0 = sg + c, nr = sn - r0; v4u* dst = (v4u*)(XG + (size_t)r0 * D);
        for (int i = tid; i < nr * 128; i += 512) dst[i] = (v4u){0u, 0u, 0u, 0u}; }
}
__device__ __forceinline__ void pair_row(Frame& F, int pair, int lane, f32x4 (&y)[4]) {
    const v2u* yp = (const v2u*)((const bf16*)F.out + (size_t)pair * D) + lane;
    v2u a0[4];
#pragma unroll
    for (int j = 0; j < 4; ++j) a0[j] = yp[64 * j];
    const int pos = __builtin_amdgcn_readfirstlane(((const int*)(F.ws + WS_PPOS))[pair]);
#pragma unroll
    for (int j = 0; j < 4; ++j) y[j] = (f32x4){bflo(a0[j].x), bfhi(a0[j].x), bflo(a0[j].y), bfhi(a0[j].y)};
    if (pos >= REM_P0 * 256) { const float gw = ((const float*)(F.ws + WS_RW))[pos]; const f32x4* pp = (const f32x4*)((const float*)(F.ws + WS_PART) + (size_t)(pos - REM_P0 * 256) * D) + lane;
#pragma unroll
        for (int j = 0; j < 4; ++j) { f32x4 acc = pp[64 * j];
#pragma unroll
            for (int ks = 1; ks < KSPLIT; ++ks) acc += pp[(size_t)ks * REM_MAXP * 256 * (D / 4) + 64 * j];
            y[j] = acc * gw; } }
}
__device__ __forceinline__ void combine_phase(Frame& F, const float* g, const float* b) {
    LOCAL_IDS;
    const int gw = blockIdx.x * NWAVES + wave, NGW = F.G * NWAVES;
    const bf16* XB = (const bf16*)(F.ws + WS_XB);
    f32x4 gv[4], bv[4];
#pragma unroll
    for (int j = 0; j < 4; ++j) { gv[j] = *(const f32x4*)(g + 4 * lane + 256 * j); bv[j] = *(const f32x4*)(b + 4 * lane + 256 * j); }
    for (int m0 = gw * 2; m0 < T; m0 += NGW * 2) {
      v2u xraw[2][4]; f32x4 ya[2][4], yb[2][4];
#pragma unroll
      for (int r = 0; r < 2; ++r) { const v2u* xr = (const v2u*)(XB + (size_t)(m0 + r) * D) + lane;
#pragma unroll
          for (int j = 0; j < 4; ++j) xraw[r][j] = xr[64 * j]; }
#pragma unroll
      for (int r = 0; r < 2; ++r) { pair_row(F, 2 * (m0 + r), lane, ya[r]); pair_row(F, 2 * (m0 + r) + 1, lane, yb[r]); }
#pragma unroll
      for (int r = 0; r < 2; ++r) { const int m = m0 + r;
        f32x4 v[4]; float s = 0.f; const f32x4 (&y0)[4] = ya[r]; const f32x4 (&y1)[4] = yb[r];
#pragma unroll
        for (int j = 0; j < 4; ++j) { const v2u xx = xraw[r][j];
            v[j] = (f32x4){bflo(xx.x), bfhi(xx.x), bflo(xx.y), bfhi(xx.y)} * ALPHA + y0[j] + y1[j];
            s += (v[j][0] + v[j][1]) + (v[j][2] + v[j][3]); }
        const float mean = wave_sum(s) * (1.f / D); float s2 = 0.f;
#pragma unroll
        for (int j = 0; j < 4; ++j) { v[j] = v[j] - mean; s2 += (v[j][0] * v[j][0] + v[j][1] * v[j][1]) + (v[j][2] * v[j][2] + v[j][3] * v[j][3]); }
        const float rstd = 1.f / sqrtf(wave_sum(s2) * (1.f / D) + LN_EPS);
        f32x4* o = (f32x4*)(F.out + (size_t)m * D) + lane;
#pragma unroll
        for (int j = 0; j < 4; ++j) o[64 * j] = v[j] * rstd * gv[j] + bv[j];
      }
    }
}

template <bool ONE> __global__ void __launch_bounds__(NWAVES * 64, 2) fwd_kernel(Args args) {
    extern __shared__ __attribute__((aligned(16))) unsigned char lds[];
    Frame F;
    F.lds = (LAS unsigned char*)lds;
    F.MISC = (volatile LAS unsigned*)(F.lds + MISC_OFF);
    F.G = gridDim.x; F.ws = args.ws; F.out = args.out; F.ctl = (unsigned*)(args.ws + WS_CTL);
    for (int u = threadIdx.x; u < (LDS_BYTES - LDSCTL_OFF) / 4; u += NWAVES * 64) ((LAS unsigned*)(F.lds + LDSCTL_OFF))[u] = 0u;
    __syncthreads();
    const int lo = ONE ? 0 : args.ph_lo, hi = ONE ? NPHASE : args.ph_hi;
    XcdBarrier bar; bar.bar = F.ctl + CW_BAR; bar.x = 0; bar.st = nullptr;
    if (hi - lo > 1) bar = xcd_barrier_post(F.ctl + CW_BAR, F.MISC + 8);
    int pc = 0;
#define RUN_PHASE (ONE || (lo <= pc && pc < hi))
#define END_PHASE do { if (ONE || (RUN_PHASE && pc + 1 < hi)) xcd_barrier(bar); if (!ONE) ++pc; } while (0)
    bf16* XB = (bf16*)(args.ws + WS_XB);

    if (RUN_PHASE) p0_prologue(F, args);
    END_PHASE;

    for (int l = 0; l < 2; ++l) {
        if (RUN_PHASE) {
            pg8::Order S; S.init(T / 256, LDP / 256, F.G, (int)blockIdx.x, 0);
            S.A = (const char*)XB; S.a_t = (size_t)256 * D * 2; S.B = (const char*)(args.ws + WS_WIN) + (size_t)l * LDP * D * 2; S.b_t = (size_t)256 * D * 2;
            pg8::EpiProj E{(bf16*)(args.ws + WS_PROJ), LDP, 4};
            pg8::gemm_phase<pg8::EpiProj, pg8::Order, true, true>(F.lds, D, D, S, E);
        }
        END_PHASE;
        if (RUN_PHASE) mixer_phase(F, args, l);
        END_PHASE;
        if (RUN_PHASE) {
            pg8::Order S; S.init(T / 256, D / 256, F.G, (int)blockIdx.x, 0);
            S.A = (const char*)(args.ws + WS_CAT); S.a_t = (size_t)256 * D * 2; S.B = (const char*)(args.ws + WS_WOUT) + (size_t)l * D * D * 2; S.b_t = (size_t)256 * D * 2;
            { pg8::EpiRes E{(bf16*)args.out, XB, ALPHA}; pg8::gemm_phase<pg8::EpiRes, pg8::Order, true, true>(F.lds, D, D, S, E); }
        }
        END_PHASE;
        if (RUN_PHASE) { if (l == 0) ln_phase<false>(F, args, args.in[10], args.in[11]); else ln_phase<true>(F, args, args.in[10] + D, args.in[11] + D); }
        END_PHASE;
        if (l == 0) {
            if (RUN_PHASE) {
                pg8::Order S; S.init(T / 256, 2 * DFF / 256, F.G, (int)blockIdx.x, 0);
                S.A = (const char*)XB; S.a_t = (size_t)256 * D * 2; S.B = (const char*)(args.ws + WS_WGU); S.b_t = (size_t)256 * D * 2;
                pg8::EpiSwiGLU E{(bf16*)(args.ws + WS_HID), DFF, 0};
                pg8::gemm_phase<pg8::EpiSwiGLU, pg8::Order, true, true>(F.lds, D, D, S, E);
            }
            END_PHASE;
            if (RUN_PHASE) {
                pg8::Order S; S.init(T / 256, D / 256, F.G, (int)blockIdx.x, 0);
                S.A = (const char*)(args.ws + WS_HID); S.a_t = (size_t)256 * DFF * 2; S.B = (const char*)(args.ws + WS_WDN); S.b_t = (size_t)256 * DFF * 2;
                pg8::EpiRes E{(bf16*)args.out, XB, ALPHA};
                pg8::gemm_phase<pg8::EpiRes, pg8::Order, true, true>(F.lds, DFF, DFF, S, E);
            }
            END_PHASE;
            if (RUN_PHASE) ln_phase<false>(F, args, args.in[19], args.in[20]);
            END_PHASE;
        } else {
            if (RUN_PHASE) scatter_phase(F);
            END_PHASE;
            for (int s = 0; s < NSLAB; ++s) {
                if (RUN_PHASE) {
                    int seg[9]; moe_segments(F, seg); const int nP = seg[8] >> 8; const int p0 = s * SLAB_P; int np = nP - p0; np = np > SLAB_P ? SLAB_P : np;
                    if (np > 0) {
                        pg8::Order S; S.init(np, 2 * DFE / 256, F.G, (int)blockIdx.x, p0);
                        S.A = (const char*)(args.ws + WS_XG); S.a_t = (size_t)256 * D * 2; S.a_pm0 = 0; S.B = (const char*)(args.ws + WS_EGU); S.b_t = (size_t)256 * D * 2; S.grouped = 1; S.b_e = (size_t)2 * DFE * D * 2;
                        { unsigned long long pk_ = 0ull;
#pragma unroll
                          for (int j = 0; j < 7; ++j) pk_ |= (unsigned long long)(unsigned)(seg[j + 1] >> 8) << (9 * j);
                          S.pends = pk_; }
                        pg8::EpiSwiGLU E{(bf16*)(args.ws + WS_HSLAB), DFE, p0};
                        pg8::gemm_phase<pg8::EpiSwiGLU, pg8::Order, true, true>(F.lds, D, D, S, E);
                    }
                }
                END_PHASE;
                if (RUN_PHASE) {
                    int seg[9]; moe_segments(F, seg); const int nP = seg[8] >> 8; const int p0 = s * SLAB_P; int np = nP - p0; np = np > SLAB_P ? SLAB_P : np;
                    if (np > 0) {
                        pg8::Order S; S.init(np, D / 256, F.G, (int)blockIdx.x, p0);
                        S.A = (const char*)(args.ws + WS_HSLAB); S.a_t = (size_t)256 * DFE * 2; S.a_pm0 = p0; S.B = (const char*)(args.ws + WS_EDN); S.b_t = (size_t)256 * DFE * 2; S.grouped = 1; S.b_e = (size_t)D * DFE * 2;
                        { unsigned long long pk_ = 0ull;
#pragma unroll
                          for (int j = 0; j < 7; ++j) pk_ |= (unsigned long long)(unsigned)(seg[j + 1] >> 8) << (9 * j);
                          S.pends = pk_; }
                        if (s < 4) { pg8::EpiMoeDown E{(bf16*)args.out, (const int*)(args.ws + WS_RPAIR), (const float*)(args.ws + WS_RW)};
                            pg8::gemm_phase<pg8::EpiMoeDown, pg8::Order, true, true>(F.lds, DFE, DFE, S, E); }
                        else { S.ksplit = KSPLIT; S.kbytes = (size_t)KSLICE * 2; S.nwg = S.nM * S.nN;
                            pg8::EpiPart E{(float*)(args.ws + WS_PART), p0, REM_MAXP};
                            pg8::gemm_phase<pg8::EpiPart, pg8::Order, true, true>(F.lds, KSLICE, DFE, S, E); }
                    }
                }
                END_PHASE;
            }
            if (RUN_PHASE) combine_phase(F, args.in[19] + D, args.in[20] + D);
            if (!ONE) END_PHASE;
        }
    }
#undef RUN_PHASE
#undef END_PHASE
}


#if MK_PER_PHASE
#define FWD_KERNEL fwd_kernel<false>
#else
#define FWD_KERNEL fwd_kernel<true>
#endif
extern "C" void kernel_launch(void* const* d_in, const int* in_sizes, int n_in, void* d_out, int out_size, void* d_ws, size_t ws_size, hipStream_t stream) {
    static int grid = 0;
    if (grid == 0) {
        if (n_in != 21 || in_sizes[0] != T * D || out_size != T * D || ws_size < WS_END) { fprintf(stderr, "kernel_launch: unexpected shapes / workspace (%d inputs, ws %zu)\n", n_in, ws_size); grid = -1; return; }
        int dev = 0, cus = 0, per_cu = 0;
        if (hipGetDevice(&dev) != hipSuccess || hipDeviceGetAttribute(&cus, hipDeviceAttributeMultiprocessorCount, dev) != hipSuccess) { grid = -1; return; }
        if (hipFuncSetAttribute((const void*)FWD_KERNEL, hipFuncAttributeMaxDynamicSharedMemorySize, LDS_BYTES) != hipSuccess) { grid = -1; return; }
        if (hipOccupancyMaxActiveBlocksPerMultiprocessor(&per_cu, (const void*)FWD_KERNEL, NWAVES * 64, LDS_BYTES) != hipSuccess || per_cu < 1) { fprintf(stderr, "kernel_launch: occupancy query says %d\n", per_cu); }
        (void)hipGetLastError();
        grid = cus;
    }
    if (grid < 0) return;
    if (hipMemsetAsync((char*)d_ws + WS_CTL, 0, CTL_ZERO_BYTES, stream) != hipSuccess) return;
    Args a{};
    for (int i = 0; i < 21; ++i) a.in[i] = (const float*)d_in[i];
    a.out = (float*)d_out; a.ws = (unsigned char*)d_ws;
#if MK_PER_PHASE
    for (int p = 0; p < NPHASE; ++p) { a.ph_lo = p; a.ph_hi = p + 1; hipLaunchKernelGGL(FWD_KERNEL, dim3(grid), dim3(NWAVES * 64), LDS_BYTES, stream, a); }
#else
    a.ph_lo = 0; a.ph_hi = NPHASE;
    hipLaunchKernelGGL(FWD_KERNEL, dim3(grid), dim3(NWAVES * 64), LDS_BYTES, stream, a);
#endif
}
```
